# Optimizing an MI355X kernel written in HIP

```python
import math
import jax, jax.numpy as jnp
from jax import lax
import numpy as np

D_MODEL = 1024
BATCH = 4
SEQ = 8192
DEPTH = 2

MIX_WIDTH = D_MODEL
HEAD_DIM = 64
N_HEADS_DIFF = MIX_WIDTH // (4 * HEAD_DIM)
N_HEADS_FOX = MIX_WIDTH // (2 * HEAD_DIM)
DIFF_WIDTH = N_HEADS_DIFF * 2 * HEAD_DIM
FOX_WIDTH = N_HEADS_FOX * HEAD_DIM
IN_WIDTH = 3 * DIFF_WIDTH + 3 * FOX_WIDTH + N_HEADS_FOX
ROT_DIM = HEAD_DIM // 4
ROPE_THETA = 500000.0
Q_BLOCK = 128
D_FF = ((8 * D_MODEL // 3 + 255) // 256) * 256
EPS = 1e-6
NEG_INF = -1e30

kernel_name = "hymba_diff_fox_sandwich_block"


def rms_norm(x, g):
    xf = x.astype(jnp.float32)
    y = xf * lax.rsqrt(jnp.mean(xf * xf, axis=-1, keepdims=True) + EPS)
    return (y * g.astype(jnp.float32)).astype(x.dtype)


def rotary_tables(positions, dtype):
    inv_freq = 1.0 / (ROPE_THETA ** (jnp.arange(0, ROT_DIM, 2, dtype=jnp.float32) / ROT_DIM))
    ang = positions.astype(jnp.float32)[..., None] * inv_freq
    cos = jnp.cos(ang)[:, :, None, :].astype(dtype)
    sin = jnp.sin(ang)[:, :, None, :].astype(dtype)
    return cos, sin


def partial_rotary(t, cos, sin):
    half = ROT_DIM // 2
    t1, t2, rest = t[..., :half], t[..., half:ROT_DIM], t[..., ROT_DIM:]
    return jnp.concatenate([t1 * cos - t2 * sin, t2 * cos + t1 * sin, rest], axis=-1)


def diff_attention(q, k, v, lam):
    b, s = q.shape[0], q.shape[1]
    nb = s // Q_BLOCK
    scale = HEAD_DIM ** -0.5
    q_blocks = q.reshape(b, nb, Q_BLOCK, N_HEADS_DIFF, 2, HEAD_DIM).swapaxes(0, 1)
    k_pos = jnp.arange(s)

    def block(args):
        i, qi = args
        q_pos = i * Q_BLOCK + jnp.arange(Q_BLOCK)
        causal = q_pos[:, None] >= k_pos[None, :]
        logits = jnp.einsum('bqhmd,bkhmd->bhmqk', qi, k).astype(jnp.float32) * scale
        logits = jnp.where(causal, logits, NEG_INF)
        p = jax.nn.softmax(logits, axis=-1)
        p = p[:, :, 0] - lam * p[:, :, 1]
        return jnp.einsum('bhqk,bkhe->bqhe', p.astype(v.dtype), v)

    o = lax.map(block, (jnp.arange(nb), q_blocks))
    return o.swapaxes(0, 1).reshape(b, s, N_HEADS_DIFF, 2 * HEAD_DIM)


def forgetting_attention(q, k, v, log_f):
    b, s = q.shape[0], q.shape[1]
    nb = s // Q_BLOCK
    scale = HEAD_DIM ** -0.5
    c = jnp.cumsum(log_f, axis=1)
    c_k = c.transpose(0, 2, 1)[:, :, None, :]
    q_blocks = q.reshape(b, nb, Q_BLOCK, N_HEADS_FOX, HEAD_DIM).swapaxes(0, 1)
    c_blocks = c.reshape(b, nb, Q_BLOCK, N_HEADS_FOX).swapaxes(0, 1)
    k_pos = jnp.arange(s)

    def block(args):
        i, qi, ci = args
        q_pos = i * Q_BLOCK + jnp.arange(Q_BLOCK)
        causal = q_pos[:, None] >= k_pos[None, :]
        decay = ci.transpose(0, 2, 1)[..., None] - c_k
        logits = jnp.einsum('bqhd,bkhd->bhqk', qi, k).astype(jnp.float32) * scale + decay
        logits = jnp.where(causal, logits, NEG_INF)
        p = jax.nn.softmax(logits, axis=-1)
        return jnp.einsum('bhqk,bkhd->bqhd', p.astype(v.dtype), v)

    o = lax.map(block, (jnp.arange(nb), q_blocks, c_blocks))
    return o.swapaxes(0, 1).reshape(b, s, N_HEADS_FOX, HEAD_DIM)


def setup_inputs(seed: int = 0) -> dict:
    key = jax.random.key(seed)
    ks = jax.random.split(key, 16)
    f32 = jnp.float32

    def nrm(k, shape, scale):
        return jax.random.normal(k, shape, f32) * scale

    def gain(k, n):
        return 1.0 + 0.05 * jax.random.normal(k, (DEPTH, n), f32)

    return {
        "x": nrm(ks[0], (BATCH, SEQ, D_MODEL), 1.0),
        "positions": jnp.broadcast_to(jnp.arange(SEQ, dtype=jnp.int32), (BATCH, SEQ)),
        "attn_pre_g": gain(ks[1], D_MODEL),
        "w_in": nrm(ks[2], (DEPTH, D_MODEL, IN_WIDTH), D_MODEL ** -0.5),
        "forget_bias": jax.random.uniform(ks[3], (DEPTH, N_HEADS_FOX), f32, 1.0, 6.0),
        "lam_q1": nrm(ks[4], (DEPTH, HEAD_DIM), 0.1),
        "lam_k1": nrm(ks[5], (DEPTH, HEAD_DIM), 0.1),
        "lam_q2": nrm(ks[6], (DEPTH, HEAD_DIM), 0.1),
        "lam_k2": nrm(ks[7], (DEPTH, HEAD_DIM), 0.1),
        "diff_sub_g": gain(ks[8], 2 * HEAD_DIM),
        "w_out": nrm(ks[9], (DEPTH, MIX_WIDTH, D_MODEL), MIX_WIDTH ** -0.5),
        "attn_post_g": gain(ks[10], D_MODEL),
        "ffn_pre_g": gain(ks[11], D_MODEL),
        "w_gate": nrm(ks[12], (DEPTH, D_MODEL, D_FF), D_MODEL ** -0.5),
        "w_up": nrm(ks[13], (DEPTH, D_MODEL, D_FF), D_MODEL ** -0.5),
        "w_down": nrm(ks[14], (DEPTH, D_FF, D_MODEL), D_FF ** -0.5),
        "ffn_post_g": gain(ks[15], D_MODEL),
    }


def reference(x, positions, attn_pre_g, w_in, forget_bias, lam_q1, lam_k1, lam_q2, lam_k2,
              diff_sub_g, w_out, attn_post_g, ffn_pre_g, w_gate, w_up, w_down, ffn_post_g):
    b, s, _ = x.shape
    f32 = jnp.float32
    cos, sin = rotary_tables(positions, x.dtype)
    split_at = [DIFF_WIDTH, 2 * DIFF_WIDTH, 3 * DIFF_WIDTH,
                3 * DIFF_WIDTH + FOX_WIDTH, 3 * DIFF_WIDTH + 2 * FOX_WIDTH,
                3 * DIFF_WIDTH + 3 * FOX_WIDTH]
    for l in range(DEPTH):
        h = rms_norm(x, attn_pre_g[l])
        proj = h @ w_in[l]
        qa, ka, va, qb, kb, vb, f_logit = jnp.split(proj, split_at, axis=-1)

        qa = partial_rotary(qa.reshape(b, s, 2 * N_HEADS_DIFF, HEAD_DIM), cos, sin)
        ka = partial_rotary(ka.reshape(b, s, 2 * N_HEADS_DIFF, HEAD_DIM), cos, sin)
        qa = qa.reshape(b, s, N_HEADS_DIFF, 2, HEAD_DIM)
        ka = ka.reshape(b, s, N_HEADS_DIFF, 2, HEAD_DIM)
        va = va.reshape(b, s, N_HEADS_DIFF, 2 * HEAD_DIM)
        lam_init = 0.8 - 0.6 * math.exp(-0.3 * l)
        lam = (jnp.exp(jnp.sum(lam_q1[l].astype(f32) * lam_k1[l].astype(f32)))
               - jnp.exp(jnp.sum(lam_q2[l].astype(f32) * lam_k2[l].astype(f32)))
               + lam_init)
        oa = diff_attention(qa, ka, va, lam)
        oa = rms_norm(oa, diff_sub_g[l]) * (1.0 - lam_init)

        log_f = jax.nn.log_sigmoid(f_logit.astype(f32) + forget_bias[l].astype(f32))
        ob = forgetting_attention(qb.reshape(b, s, N_HEADS_FOX, HEAD_DIM),
                                  kb.reshape(b, s, N_HEADS_FOX, HEAD_DIM),
                                  vb.reshape(b, s, N_HEADS_FOX, HEAD_DIM), log_f)

        mixed = jnp.concatenate([oa.reshape(b, s, DIFF_WIDTH), ob.reshape(b, s, FOX_WIDTH)], axis=-1)
        x = x + rms_norm(mixed @ w_out[l], attn_post_g[l])

        h = rms_norm(x, ffn_pre_g[l])
        y = (jax.nn.silu(h @ w_gate[l]) * (h @ w_up[l])) @ w_down[l]
        x = x + rms_norm(y, ffn_post_g[l])
    return x
```

```cpp
#include <hip/hip_runtime.h>
#include <cstdio>
#include <cstdint>
namespace pg8 {
#define PG8_LAS __attribute__((address_space(3)))
typedef unsigned short bf16_t;
typedef short bf16x8 __attribute__((ext_vector_type(8)));
typedef float f32x4 __attribute__((ext_vector_type(4)));
typedef unsigned u32x4 __attribute__((ext_vector_type(4)));
constexpr int BM = 256, BK = 64, HALF = 128, HTB = HALF * BK * 2  , STAGE_BYTES = 8 * HTB, NXCD = 8, WGM = 2;

__host__ __device__ __forceinline__ int lds_byte(int r, int c) { const int st = (r >> 4) * 2 + (c >> 5), rr = r & 15, cc = c & 31, ob = rr * 64 + cc * 2; return st * 1024 + (ob ^ (((ob >> 9) & 1) << 5)); }
__host__ __device__ __forceinline__ void stage_rc(int b, int& R, int& C) { const int st = b / 1024, sb = b % 1024, swz = sb ^ (((sb >> 9) & 1) << 5); R = (st >> 1) * 16 + swz / 64; C = (st & 1) * 32 + (swz % 64) / 2; }
__host__ __device__ __forceinline__ int perm32(int rho) { const int n = rho >> 4, i = rho & 15; return 8 * (i >> 2) + 4 * n + (i & 3); }

struct Unit { int pm, pn; };
struct Gemm { const bf16_t* A; const bf16_t* Bt; int M, N, K; };

struct StaticOrder {
    int nM, nN, nwg, G, c;
    __host__ __device__ void init(int M, int N, int G_, int c_) { nM = M / BM; nN = N / BM; nwg = nM * nN; G = G_; c = c_; }
    __host__ __device__ bool next(int i, Unit& u) const {
        const long L = (long)i * G + c; if (L >= nwg) return false;
        int wgid = (int)L; { const int q = nwg / NXCD, r = nwg % NXCD, xcd = wgid % NXCD, off = wgid / NXCD; wgid = (xcd < r ? xcd * (q + 1) : r * (q + 1) + (xcd - r) * q) + off; }
        const int nig = WGM * nN, gid = wgid / nig, fm = gid * WGM, gsz = (nM - fm) < WGM ? (nM - fm) : WGM;
        u.pm = fm + ((wgid % nig) % gsz); u.pn = (wgid % nig) / gsz; return true;
    }
    __device__ __forceinline__ void a_ready(const Unit&) const {}
    __device__ __forceinline__ void done(const Unit&) const {}
};

__device__ __forceinline__ unsigned cvt_pk_bf16(float lo, float hi) { unsigned r; asm volatile("v_cvt_pk_bf16_f32 %0, %1, %2" : "=v"(r) : "v"(lo), "v"(hi)); return r; }
typedef float f32x2 __attribute__((ext_vector_type(2)));
constexpr float QSCALE = 0.125f * 1.4426950408889634f;
typedef unsigned u32x4 __attribute__((ext_vector_type(4)));
struct EpiQKV {
    static constexpr bool PERM = true, AFTER_DRAIN = false;
    bf16_t* O; const float* rot; const float* rs;
    __device__ __forceinline__ void pre(const Unit& u, int wr, int fr, float (&rsv)[8]) const {
#pragma unroll
        for (int i = 0; i < 8; ++i) rsv[i] = rs[u.pm * BM + wr * 64 + fr + (i >> 2) * HALF + (i & 3) * 16]; }
    __device__ __forceinline__ void operator()(const f32x4 (&acc)[2][2][4][2], const Unit& u, int wr, int wc, int fr, int fq, const float (&rsv)[8]) const {
        const int row0 = u.pm * BM + wr * 64 + fr, col0 = u.pn * BM + wc * 32 + 8 * fq;
        const bool isq = (u.pn < 2) || (u.pn == 6) || (u.pn == 7);
        const float sc = isq ? QSCALE : 1.f;
        const bool rotw = (u.pn < 4) && ((wc & 1) == 0);
        const float sgn = (fq == 0) ? -1.f : 1.f; const bool rotl = fq < 2; const int pidx = (((fq ^ 1) << 4) | fr) << 2;
#pragma unroll
        for (int ai = 0; ai < 2; ++ai)
#pragma unroll
            for (int m = 0; m < 4; ++m) { const int row = row0 + ai * HALF + m * 16; bf16_t* rowp = O + (size_t)row * 3072 + col0; const float scr_ = sc * rsv[ai * 4 + m];
                f32x4 c0 = {1.f, 1.f, 1.f, 1.f}, c1 = c0, s0 = {0.f, 0.f, 0.f, 0.f}, s1 = s0;
                if (rotw) { const f32x4* rp = (const f32x4*)(rot + (size_t)row * 16); c0 = rp[0]; c1 = rp[1]; s0 = rp[2]; s1 = rp[3]; }
#pragma unroll
                for (int bj = 0; bj < 2; ++bj) { f32x4 v0 = acc[ai][bj][m][0], v1 = acc[ai][bj][m][1];
                    if (rotw) { f32x4 p0, p1;
#pragma unroll
                        for (int j = 0; j < 4; ++j) { const float a0 = v0[j], a1 = v1[j]; p0[j] = __int_as_float(__builtin_amdgcn_ds_bpermute(pidx, __float_as_int(a0))); p1[j] = __int_as_float(__builtin_amdgcn_ds_bpermute(pidx, __float_as_int(a1))); }
                        if (rotl) { v0 = v0 * c0 + (p0 * s0) * sgn; v1 = v1 * c1 + (p1 * s1) * sgn; } }
                    v0 = v0 * scr_; v1 = v1 * scr_; u32x4 w; w.x = cvt_pk_bf16(v0[0], v0[1]); w.y = cvt_pk_bf16(v0[2], v0[3]); w.z = cvt_pk_bf16(v1[0], v1[1]); w.w = cvt_pk_bf16(v1[2], v1[3]);
                    *(u32x4*)(rowp + bj * HALF) = w; } }
    }
};
struct EpiY {
    static constexpr bool PERM = true, AFTER_DRAIN = false;
    bf16_t* O; int ldc;
    __device__ __forceinline__ void pre(const Unit&, int, int, float (&rsv)[8]) const {
#pragma unroll
        for (int i = 0; i < 8; ++i) rsv[i] = 1.f; }
    __device__ __forceinline__ void operator()(const f32x4 (&acc)[2][2][4][2], const Unit& u, int wr, int wc, int fr, int fq, const float (&rsv)[8]) const {
        const int row0 = u.pm * BM + wr * 64 + fr, col0 = u.pn * BM + wc * 32 + 8 * fq;
#pragma unroll
        for (int ai = 0; ai < 2; ++ai)
#pragma unroll
            for (int m = 0; m < 4; ++m) { bf16_t* rowp = O + (size_t)(row0 + ai * HALF + m * 16) * ldc + col0;
#pragma unroll
                for (int bj = 0; bj < 2; ++bj) { const f32x4 v0 = acc[ai][bj][m][0], v1 = acc[ai][bj][m][1];
                    u32x4 w; w.x = cvt_pk_bf16(v0[0], v0[1]); w.y = cvt_pk_bf16(v0[2], v0[3]); w.z = cvt_pk_bf16(v1[0], v1[1]); w.w = cvt_pk_bf16(v1[2], v1[3]);
                    *(u32x4*)(rowp + bj * HALF) = w; } }
    }
};
struct EpiSwiGLU {
    static constexpr bool PERM = true, AFTER_DRAIN = false;
    bf16_t* O; int ldc; const float* rs;
    __device__ __forceinline__ void pre(const Unit& u, int wr, int fr, float (&rsv)[8]) const {
#pragma unroll
        for (int i = 0; i < 8; ++i) rsv[i] = rs[u.pm * BM + wr * 64 + fr + (i >> 2) * HALF + (i & 3) * 16]; }
    __device__ __forceinline__ void operator()(const f32x4 (&acc)[2][2][4][2], const Unit& u, int wr, int wc, int fr, int fq, const float (&rsv)[8]) const {
        const int row0 = u.pm * BM + wr * 64 + fr, col0 = u.pn * HALF + wc * 32 + 8 * fq;
#pragma unroll
        for (int ai = 0; ai < 2; ++ai)
#pragma unroll
            for (int m = 0; m < 4; ++m) { bf16_t* rowp = O + (size_t)(row0 + ai * HALF + m * 16) * ldc + col0; float r[8]; const float rr = rsv[ai * 4 + m];
#pragma unroll
                for (int n = 0; n < 2; ++n)
#pragma unroll
                    for (int j = 0; j < 4; ++j) { const float g = acc[ai][0][m][n][j] * rr, up = acc[ai][1][m][n][j] * rr;
                        const float e = __builtin_amdgcn_exp2f(g * -1.4426950408889634f); r[n * 4 + j] = g * __builtin_amdgcn_rcpf(1.0f + e) * up; }
                u32x4 w; w.x = cvt_pk_bf16(r[0], r[1]); w.y = cvt_pk_bf16(r[2], r[3]); w.z = cvt_pk_bf16(r[4], r[5]); w.w = cvt_pk_bf16(r[6], r[7]);
                *(u32x4*)rowp = w; }
    }
};
template <class Epi, class Sched, bool ALIGN_EPI = false, bool SP2 = false>
__device__ __forceinline__ void gemm_phase(PG8_LAS unsigned char* lds, const Gemm g, const Sched& S, const Epi& E, const int tid_in) {
    int tid = tid_in; asm volatile("" : "+v"(tid)); const int wid = __builtin_amdgcn_readfirstlane(tid >> 6), lane = tid & 63, wr = wid >> 2, wc = wid & 3, fr = lane & 15, fq = lane >> 4;
    const int K = g.K, nt = K / BK;
    unsigned voffA[2], voffB[2];
#pragma unroll
    for (int i = 0; i < 2; ++i) { int R, C; stage_rc(tid * 16 + i * 8192, R, C); const int Rb = Epi::PERM ? ((R & ~31) + perm32(R & 31)) : R;
        voffA[i] = (unsigned)(R * K + C) * 2u; voffB[i] = (unsigned)(Rb * K + C) * 2u; }
    const size_t kstep = (size_t)(BK * 2);
    const size_t hstep = (size_t)HALF * K * 2;
    const size_t tstep = 2 * hstep;
    const unsigned ldsw = (unsigned)wid * 1024u;
    const int aoff = lds_byte(wr * 64 + fr, fq * 8), boff = lds_byte(wc * 32 + fr, fq * 8);
#define PG8_SA(b, h) (((b) * 2 + (h)) * HTB)
#define PG8_SB(b, h) ((4 + (b) * 2 + (h)) * HTB)
#define PG8_STAGE(bufoff, gbase, voff) do { _Pragma("unroll") for (int _i = 0; _i < 2; ++_i) \
        __builtin_amdgcn_global_load_lds((const unsigned*)((const char*)(gbase) + (voff)[_i]), (PG8_LAS unsigned*)(lds + (bufoff) + ldsw + _i * 8192), 16, 0, 0); } while (0)
#define PG8_LDA(dst, b, h) do { _Pragma("unroll") for (int m = 0; m < 4; ++m) _Pragma("unroll") for (int k = 0; k < 2; ++k) dst[m][k] = *(const PG8_LAS bf16x8*)(lds + PG8_SA(b, h) + aoff + m * 2048 + k * 1024); } while (0)
#define PG8_LDB(dst, b, h) do { _Pragma("unroll") for (int n = 0; n < 2; ++n) _Pragma("unroll") for (int k = 0; k < 2; ++k) dst[n][k] = *(const PG8_LAS bf16x8*)(lds + PG8_SB(b, h) + boff + n * 2048 + k * 1024); } while (0)
#define PG8_MMA(ai, bj, At, Bt) do { __builtin_amdgcn_s_setprio(1); _Pragma("unroll") for (int m = 0; m < 4; ++m) _Pragma("unroll") for (int n = 0; n < 2; ++n) _Pragma("unroll") for (int k = 0; k < 2; ++k) \
        acc[ai][bj][m][n] = __builtin_amdgcn_mfma_f32_16x16x32_bf16(Bt[n][k], At[m][k], acc[ai][bj][m][n], 0, 0, 0); __builtin_amdgcn_s_setprio(0); } while (0)
#define PG8_WAIT_V(n) asm volatile("s_waitcnt vmcnt(" #n ")" ::: "memory")
#define PG8_WAIT_L(n) asm volatile("s_waitcnt lgkmcnt(" #n ")" ::: "memory")
#define PG8_BAR __builtin_amdgcn_s_barrier()
#define PG8_SCHED __builtin_amdgcn_sched_barrier(0)
    Unit cur, nxt; int ui = 0;
    if (!S.next(0, cur)) return;
    f32x4 acc[2][2][4][2];
#pragma unroll
    for (int a = 0; a < 2; ++a)
#pragma unroll
        for (int b = 0; b < 2; ++b)
#pragma unroll
            for (int m = 0; m < 4; ++m)
#pragma unroll
                for (int n = 0; n < 2; ++n) acc[a][b][m][n] = (f32x4){0.f, 0.f, 0.f, 0.f};
    bf16x8 At[4][2], B0[2][2], B1[2][2];
    const char* cA = (const char*)g.A + (size_t)cur.pm * tstep; const char* cB = (const char*)g.Bt + (size_t)cur.pn * tstep;
    S.a_ready(cur);
    if constexpr (SP2) {
        PG8_STAGE(PG8_SB(0, 0), cB, voffB); PG8_STAGE(PG8_SB(0, 1), cB + hstep, voffB); PG8_STAGE(PG8_SA(0, 0), cA, voffA); PG8_STAGE(PG8_SA(0, 1), cA + hstep, voffA);
        if (wr == 1) PG8_BAR;
        PG8_WAIT_V(2); PG8_BAR;
        PG8_STAGE(PG8_SB(1, 0), cB + kstep, voffB); PG8_STAGE(PG8_SA(1, 0), cA + kstep, voffA); PG8_STAGE(PG8_SB(1, 1), cB + hstep + kstep, voffB);
        PG8_WAIT_V(6); PG8_BAR;
    } else {
        PG8_STAGE(PG8_SB(0, 0), cB, voffB); PG8_STAGE(PG8_SA(0, 0), cA, voffA); PG8_STAGE(PG8_SB(0, 1), cB + hstep, voffB); PG8_STAGE(PG8_SA(0, 1), cA + hstep, voffA);
        if (wr == 1) PG8_BAR;
        PG8_WAIT_V(4); PG8_BAR;
        PG8_STAGE(PG8_SB(1, 0), cB + kstep, voffB); PG8_STAGE(PG8_SA(1, 0), cA + kstep, voffA); PG8_STAGE(PG8_SB(1, 1), cB + hstep + kstep, voffB);
        PG8_WAIT_V(6); PG8_BAR;
    }
    for (;;) {
        float rsv[8]; E.pre(cur, wr, fr, rsv);
        const bool has_next = S.next(ui + 1, nxt);
        const char* nA = has_next ? (const char*)g.A + (size_t)nxt.pm * tstep : cA; const char* nB = has_next ? (const char*)g.Bt + (size_t)nxt.pn * tstep : cB;
        for (int t = 0; t < nt; t += 2) {
            const bool last = (t == nt - 2);
            const char* a1 = cA + (size_t)(t + 1) * kstep;
            const char* a2 = last ? nA : cA + (size_t)(t + 2) * kstep; const char* b2 = last ? nB : cB + (size_t)(t + 2) * kstep;
            const char* a3 = a2 + kstep; const char* b3 = b2 + kstep;
            if (last && has_next) S.a_ready(nxt);
            if constexpr (SP2) {
            PG8_LDB(B0, 0, 0); PG8_LDB(B1, 0, 1); PG8_SCHED; PG8_LDA(At, 0, 0); PG8_STAGE(PG8_SA(1, 1), a1 + hstep, voffA);
            PG8_WAIT_V(8); PG8_WAIT_L(0); PG8_BAR; PG8_MMA(0, 0, At, B0); PG8_MMA(0, 1, At, B1); PG8_BAR; PG8_SCHED;
            PG8_LDA(At, 0, 1); PG8_STAGE(PG8_SB(0, 0), b2, voffB); PG8_STAGE(PG8_SB(0, 1), b2 + hstep, voffB); PG8_STAGE(PG8_SA(0, 0), a2, voffA);
            PG8_WAIT_V(8); PG8_WAIT_L(0); PG8_BAR; PG8_MMA(1, 0, At, B0); PG8_MMA(1, 1, At, B1); PG8_BAR; PG8_SCHED;
            PG8_LDB(B0, 1, 0); PG8_LDB(B1, 1, 1); PG8_SCHED; PG8_LDA(At, 1, 0); PG8_STAGE(PG8_SA(0, 1), a2 + hstep, voffA);
            PG8_WAIT_V(8); PG8_WAIT_L(0); PG8_BAR; PG8_MMA(0, 0, At, B0); PG8_MMA(0, 1, At, B1); PG8_BAR; PG8_SCHED;
            PG8_LDA(At, 1, 1); PG8_STAGE(PG8_SB(1, 0), b3, voffB); PG8_STAGE(PG8_SB(1, 1), b3 + hstep, voffB); PG8_STAGE(PG8_SA(1, 0), a3, voffA);
            PG8_WAIT_V(8); PG8_WAIT_L(0); PG8_BAR; PG8_MMA(1, 0, At, B0); PG8_MMA(1, 1, At, B1); PG8_BAR; PG8_SCHED;
            } else {
            PG8_LDB(B0, 0, 0); PG8_SCHED; PG8_LDA(At, 0, 0); PG8_STAGE(PG8_SA(1, 1), a1 + hstep, voffA);
            PG8_WAIT_L(8); PG8_BAR; PG8_WAIT_L(0); PG8_MMA(0, 0, At, B0); PG8_BAR; PG8_SCHED;
            PG8_LDB(B1, 0, 1); PG8_STAGE(PG8_SB(0, 0), b2, voffB);
            PG8_BAR; PG8_WAIT_L(0); PG8_MMA(0, 1, At, B1); PG8_BAR;
            PG8_LDA(At, 0, 1); PG8_STAGE(PG8_SA(0, 0), a2, voffA);
            PG8_BAR; PG8_WAIT_L(0); PG8_MMA(1, 0, At, B0); PG8_BAR; PG8_SCHED;
            PG8_STAGE(PG8_SB(0, 1), b2 + hstep, voffB);
            PG8_WAIT_V(6); PG8_BAR; PG8_MMA(1, 1, At, B1); PG8_BAR;
            PG8_LDB(B0, 1, 0); PG8_SCHED; PG8_LDA(At, 1, 0); PG8_STAGE(PG8_SA(0, 1), a2 + hstep, voffA);
            PG8_WAIT_L(8); PG8_BAR; PG8_WAIT_L(0); PG8_MMA(0, 0, At, B0); PG8_BAR; PG8_SCHED;
            PG8_LDB(B1, 1, 1); PG8_STAGE(PG8_SB(1, 0), b3, voffB);
            PG8_BAR; PG8_WAIT_L(0); PG8_MMA(0, 1, At, B1); PG8_BAR;
            PG8_LDA(At, 1, 1); PG8_STAGE(PG8_SA(1, 0), a3, voffA);
            PG8_BAR; PG8_WAIT_L(0); PG8_MMA(1, 0, At, B0); PG8_BAR; PG8_SCHED;
            PG8_STAGE(PG8_SB(1, 1), b3 + hstep, voffB);
            PG8_WAIT_V(6); PG8_BAR; PG8_MMA(1, 1, At, B1); PG8_BAR;
            }
        }
        if constexpr (ALIGN_EPI) { if (wr == 0) PG8_BAR; }
        if constexpr (!Epi::AFTER_DRAIN) { E(acc, cur, wr, wc, fr, fq, rsv); S.done(cur); }
        if (!has_next) break;
#pragma unroll
        for (int a = 0; a < 2; ++a)
#pragma unroll
            for (int b = 0; b < 2; ++b)
#pragma unroll
                for (int m = 0; m < 4; ++m)
#pragma unroll
                    for (int n = 0; n < 2; ++n) acc[a][b][m][n] = (f32x4){0.f, 0.f, 0.f, 0.f};
        cur = nxt; cA = nA; cB = nB; ++ui;
        if constexpr (ALIGN_EPI) { if (wr == 1) PG8_BAR; }
    }
    PG8_WAIT_V(0);
    if constexpr (!ALIGN_EPI) { if (wr == 0) PG8_BAR; }
    PG8_BAR;
    if constexpr (Epi::AFTER_DRAIN) { E.fused(acc, cur, wr, wc, fr, fq, lds, wid, lane); S.done(cur); }
#undef PG8_SA
#undef PG8_SB
#undef PG8_STAGE
#undef PG8_LDA
#undef PG8_LDB
#undef PG8_MMA
#undef PG8_WAIT_V
#undef PG8_WAIT_L
#undef PG8_BAR
#undef PG8_SCHED
}
}

#ifndef PG8_SP2
#define PG8_SP2 true
#endif
#ifndef PG8_ALIGN
#define PG8_ALIGN true
#endif
#include <hip/hip_bf16.h>
#include <cmath>
namespace attn_body {
using bf16=__hip_bfloat16;
using bf16x8=__attribute__((ext_vector_type(8)))short;
using s16x4=__attribute__((ext_vector_type(4)))short;
using f32x16=__attribute__((ext_vector_type(16)))float;
using u32x4=__attribute__((ext_vector_type(4)))unsigned;
constexpr int BATCH=4,SEQ=8192,D=64,DMI=3072,DMO=1024;
constexpr int NW=8,QBLK=32,QB=QBLK*NW,KVBLK=64,NQB=SEQ/QB;
constexpr int ATTN_UNIT_ROWS=QB;
__device__ __forceinline__ int crow(int r,int hi){return (r&3)+8*(r>>2)+4*hi;}
#define SBAR() __builtin_amdgcn_sched_barrier(0)
__device__ __forceinline__ void cmask(f32x16&p0,f32x16&p1,int jb,int qrel,int hi){
  const float NEG=-INFINITY; int kb=64*jb+4*hi;
  #pragma unroll
  for(int r=0;r<16;++r){int kv=kb+(r&3)+8*(r>>2); if(kv>qrel)p0[r]=NEG; if(kv+32>qrel)p1[r]=NEG;}
}

constexpr int NSLOT=3, SLOTB=8192;
constexpr int LDS_K=0, LDS_V=NSLOT*SLOTB, LDS_WS=2*NSLOT*SLOTB, LDS_OST=LDS_WS+NW*64*4, LDS_BIAS=LDS_OST+NW*4096, LDS_BYTES=LDS_BIAS+SEQ*4;
constexpr float C2=0.125f*1.4426950408889634f;
__device__ __forceinline__ void glds16(const void*gsrc,unsigned lds_dst){unsigned keep;
  asm volatile("s_mov_b32 %0, m0\n\ts_mov_b32 m0, %2\n\ts_nop 0\n\tglobal_load_lds_dwordx4 %1, off\n\ts_mov_b32 m0, %0":"=&s"(keep):"v"(gsrc),"s"(lds_dst):"memory");}
__device__ __forceinline__ float max3f(float a,float b,float c){float r;asm("v_max3_f32 %0, %1, %2, %3":"=v"(r):"v"(a),"v"(b),"v"(c));return r;}
__device__ __forceinline__ float max2f(float a,float b){float r;asm("v_max_f32_e32 %0, %1, %2":"=v"(r):"v"(a),"v"(b));return r;}
__device__ __forceinline__ float fadd_s(float a,float b){float r;asm("v_add_f32_e32 %0, %1, %2":"=v"(r):"v"(a),"v"(b));return r;}
__device__ __forceinline__ float fsub_s(float a,float b){float r;asm("v_sub_f32_e32 %0, %1, %2":"=v"(r):"v"(a),"v"(b));return r;}
typedef float f32x2_t __attribute__((ext_vector_type(2))); typedef __bf16 bf16x2_t __attribute__((ext_vector_type(2)));
__device__ __forceinline__ unsigned cvtpk_s(float lo,float hi){f32x2_t v={lo,hi};bf16x2_t b=__builtin_convertvector(v,bf16x2_t);return __builtin_bit_cast(unsigned,b);}
#define WAIT_BAR(N) asm volatile("s_waitcnt vmcnt(" #N ") lgkmcnt(0)\n\ts_barrier":::"memory")

__device__ __forceinline__ void qkt(f32x16&p0,f32x16&p1,const char*Kslot,const bf16x8*qr,const f32x16&negm,int r32,int hi){
  const char*kb=Kslot+hi*1024+r32*16;
  #pragma unroll
  for(int d0=0;d0<4;++d0){
    const bf16x8 b0=*reinterpret_cast<const bf16x8*>(kb+d0*2048);
    const bf16x8 b1=*reinterpret_cast<const bf16x8*>(kb+d0*2048+512);
    if(d0==0){p0=__builtin_amdgcn_mfma_f32_32x32x16_bf16(b0,qr[0],negm,0,0,0);p1=__builtin_amdgcn_mfma_f32_32x32x16_bf16(b1,qr[0],negm,0,0,0);}
    else{p0=__builtin_amdgcn_mfma_f32_32x32x16_bf16(b0,qr[d0],p0,0,0,0);p1=__builtin_amdgcn_mfma_f32_32x32x16_bf16(b1,qr[d0],p1,0,0,0);}}
}
typedef __attribute__((address_space(3))) const char* lds_cptr;
typedef short v4i16_t __attribute__((ext_vector_type(4)));
__device__ __forceinline__ void kload8(bf16x8*kf,lds_cptr kp){
  kf[0]=*(const __attribute__((address_space(3))) bf16x8*)(kp);      kf[1]=*(const __attribute__((address_space(3))) bf16x8*)(kp+512);
  kf[2]=*(const __attribute__((address_space(3))) bf16x8*)(kp+2048); kf[3]=*(const __attribute__((address_space(3))) bf16x8*)(kp+2560);
  kf[4]=*(const __attribute__((address_space(3))) bf16x8*)(kp+4096); kf[5]=*(const __attribute__((address_space(3))) bf16x8*)(kp+4608);
  kf[6]=*(const __attribute__((address_space(3))) bf16x8*)(kp+6144); kf[7]=*(const __attribute__((address_space(3))) bf16x8*)(kp+6656);
}
__device__ __forceinline__ void kload2(bf16x8*kf,lds_cptr kp,int j){ kf[2*j]=*(const __attribute__((address_space(3))) bf16x8*)(kp+j*2048); kf[2*j+1]=*(const __attribute__((address_space(3))) bf16x8*)(kp+j*2048+512); }
__device__ __forceinline__ s16x4 vtr(lds_cptr p){ return __builtin_bit_cast(s16x4,__builtin_amdgcn_ds_read_tr16_b64_v4i16((__attribute__((address_space(3))) v4i16_t*)p)); }
__device__ __forceinline__ float rowmax(const f32x16&p0,const f32x16&p1){
  float a=max3f(p0[0],p0[1],p1[0]),b=max3f(p0[2],p0[3],p1[1]);a=max3f(a,p1[2],p1[3]);
  #pragma unroll
  for(int r=4;r<16;r+=4){a=max3f(a,p0[r],p0[r+1]);b=max3f(b,p0[r+2],p0[r+3]);a=max3f(a,p1[r],p1[r+1]);b=max3f(b,p1[r+2],p1[r+3]);}
  const float m=max2f(a,b);
  auto rr=__builtin_amdgcn_permlane32_swap(__float_as_uint(m),__float_as_uint(m),false,false);
  return max2f(__uint_as_float(rr[0]),__uint_as_float(rr[1]));
}
__device__ __forceinline__ void pv(f32x16*o,int vb,bf16x8 pa0,bf16x8 pa1,bf16x8 pa2,bf16x8 pa3){
  #pragma unroll
  for(int d0=0;d0<2;++d0){s16x4 lo[4],hi[4];
    #pragma unroll
    for(int ks=0;ks<4;++ks){
      asm volatile("ds_read_b64_tr_b16 %0,%1 offset:%c2":"=&v"(lo[ks]):"v"(vb),"i"(d0*4096+ks*1024):"memory");
      asm volatile("ds_read_b64_tr_b16 %0,%1 offset:%c2":"=&v"(hi[ks]):"v"(vb),"i"(d0*4096+ks*1024+512):"memory");}
    asm volatile("s_waitcnt lgkmcnt(0)":::"memory");SBAR();
    #define PK(k) (bf16x8){lo[k][0],lo[k][1],lo[k][2],lo[k][3],hi[k][0],hi[k][1],hi[k][2],hi[k][3]}
    o[d0]=__builtin_amdgcn_mfma_f32_32x32x16_bf16(pa0,PK(0),o[d0],0,0,0);
    o[d0]=__builtin_amdgcn_mfma_f32_32x32x16_bf16(pa1,PK(1),o[d0],0,0,0);
    o[d0]=__builtin_amdgcn_mfma_f32_32x32x16_bf16(pa2,PK(2),o[d0],0,0,0);
    o[d0]=__builtin_amdgcn_mfma_f32_32x32x16_bf16(pa3,PK(3),o[d0],0,0,0);
    #undef PK
  }
}

#ifndef ATTN_STORE16
#define ATTN_STORE16(p,v) (*(u32x4*)(p)=(v))
#endif
template<int THRL,bool BIAS> __device__ __forceinline__ void attn_unit(int b,int qb,const bf16*Q,const bf16*__restrict__ K,const bf16*__restrict__ V,bf16*O,const float*__restrict__ biasg,char*shm,const int tid_in){
  int tid=tid_in; asm volatile("":"+v"(tid)); const int lane=tid&63,r32=lane&31,hi=lane>>5; const int wid=__builtin_amdgcn_readfirstlane(tid>>6);
  const long rowbase=(long)b*SEQ; const int q0=qb*QB;
  const bf16*Qw=Q+(rowbase+q0+wid*QBLK)*DMI;
  int t0=0;
  if(BIAS){ const int NT0=(q0+QB)/KVBLK; const float bq=biasg[q0]; int cnt=0;
    _Pragma("unroll") for(int h2=0;h2<2;++h2){ const int T=lane+64*h2; const bool sk=(T<NT0-4)&&(biasg[64*(T<NT0?T:0)+63]-bq<-64.f); cnt+=__popcll(__ballot(sk)); }
    t0=__builtin_amdgcn_readfirstlane(cnt)&~1; }
  const float*bg=BIAS?biasg+t0*KVBLK:biasg;
  const bf16*Kh=K+(rowbase+t0*KVBLK)*DMI,*Vh=V+(rowbase+t0*KVBLK)*DMI;
  const unsigned lds0=(unsigned)(uintptr_t)shm;
  float*wsf=(float*)(shm+LDS_WS)+wid*64;
  const bf16*ksrc=Kh+(long)lane*DMI+wid*8;
  const bf16*vsrc=Vh+(long)(16*(wid&3)+(lane>>2))*DMI+(wid>>2)*32+(lane&3)*8;
  const unsigned kdst=lds0+LDS_K+wid*1024, vdst=lds0+LDS_V+wid*1024;
  #define DMA_K(t,slot) glds16(ksrc+(long)(t)*KVBLK*DMI,(unsigned)__builtin_amdgcn_readfirstlane(kdst+(slot)))
  #define DMA_V(t,slot) glds16(vsrc+(long)(t)*KVBLK*DMI,(unsigned)__builtin_amdgcn_readfirstlane(vdst+(slot)))
  const int vb0=(int)(lds0+LDS_V)+((lane>>4)&1)*32+(lane&3)*8+(4*hi+((lane&15)>>2))*64;
  const char*Kbase=shm+LDS_K; bf16x8 kf[8];
  const lds_cptr shm3=(lds_cptr)shm; const lds_cptr kp0=shm3+LDS_K+hi*1024+r32*16; const lds_cptr vp0=shm3+LDS_V+((lane>>4)&1)*32+(lane&3)*8+(4*hi+((lane&15)>>2))*64;
  const int NT=(q0+QB)/KVBLK-t0;
  typedef __attribute__((address_space(3))) const float* lds_fptr; typedef float f32x4_t __attribute__((ext_vector_type(4)));
  const lds_fptr biasl=(lds_fptr)(shm3+LDS_BIAS)+4*hi;
  if(BIAS){ __attribute__((address_space(3))) float* bw=(__attribute__((address_space(3))) float*)(shm3+LDS_BIAS); const int nb=NT*KVBLK;
    for(int i=tid*4;i<nb;i+=NW*64*4)*(__attribute__((address_space(3))) f32x4_t*)(bw+i)=*(const f32x4_t*)(bg+i); }
  #define BIASADD(P0,P1,t) do{ if(BIAS){ const lds_fptr bp_=biasl+KVBLK*(t); _Pragma("unroll") for(int i_=0;i_<4;++i_){ \
      const f32x4_t b0_=*(const __attribute__((address_space(3))) f32x4_t*)(bp_+8*i_), b1_=*(const __attribute__((address_space(3))) f32x4_t*)(bp_+32+8*i_); \
      _Pragma("unroll") for(int j_=0;j_<4;++j_){ P0[4*i_+j_]+=b0_[j_]; P1[4*i_+j_]+=b1_[j_]; } } } }while(0)
  DMA_K(0,0);DMA_V(0,0);DMA_K(1,SLOTB);
  bf16x8 qr[4];
  #pragma unroll
  for(int d0=0;d0<4;++d0)qr[d0]=*reinterpret_cast<const bf16x8*>(&Qw[(long)r32*DMI+d0*16+hi*8]);
  float mhat=0.f,l_reg=0.f;f32x16 o[2];o[0]=f32x16{};o[1]=f32x16{};f32x16 negm=f32x16{};asm volatile("":"+v"(negm));
  const int qrel=wid*QBLK+r32;
  #define CMASK(P0,P1,t) do{int jb_=(t)-(NT-4); if(jb_>=0)cmask(P0,P1,jb_,qrel,hi);}while(0)
  bool resc=false;
  #define START(P0,P1) do{ const float rm=rowmax(P0,P1); resc=false; \
    { const float dl=rm; mhat=fadd_s(mhat,dl); \
      _Pragma("unroll") for(int r=0;r<16;++r){P0[r]=fsub_s(P0[r],dl);P1[r]=fsub_s(P1[r],dl);} \
      _Pragma("unroll") for(int r=0;r<16;++r)negm[r]=-mhat; asm volatile("":"+v"(negm)); } \
    _Pragma("unroll") for(int r=0;r<16;++r)P0[r]=__builtin_amdgcn_exp2f(P0[r]); }while(0)
  #define RESC() do{ if(resc){ asm volatile("s_waitcnt lgkmcnt(0)":::"memory"); \
      _Pragma("unroll") for(int d_=0;d_<2;++d_) _Pragma("unroll") for(int r=0;r<16;++r)o[d_][r]*=wsf[crow(r,hi)]; } }while(0)
  f32x16 pA0,pA1,pB0,pB1;
  int sl_prev=0,sl_cur=0,sl_next=SLOTB;
  #define ROT() do{sl_prev=sl_cur;sl_cur=sl_next;sl_next=(sl_next==(NSLOT-1)*SLOTB)?0:sl_next+SLOTB;}while(0)
  DMA_K(2,2*SLOTB);
  WAIT_BAR(3);
  qkt(pA0,pA1,Kbase,qr,negm,r32,hi);asm volatile("s_nop 15\n\ts_nop 7":"+v"(pA0),"+v"(pA1));BIASADD(pA0,pA1,0);CMASK(pA0,pA1,0);
  START(pA0,pA1);
  _Pragma("unroll") for(int r=0;r<16;++r)pA1[r]=__builtin_amdgcn_exp2f(pA1[r]);
  WAIT_BAR(0);
  DMA_K(3,0);DMA_V(1,SLOTB);
  ROT();
  kload8(kf,kp0+sl_cur);
  WAIT_BAR(2);
  s16x4 vlo[8],vhi[8]; u32x4 pw0,pw1,pw2,pw3;
  #define PKW(P,B) cvtpk_s(P[B],P[B+1])
  #define PAF(k) __builtin_bit_cast(bf16x8,pw##k)
  #define VFR(i) (bf16x8){vlo[i][0],vlo[i][1],vlo[i][2],vlo[i][3],vhi[i][0],vhi[i][1],vhi[i][2],vhi[i][3]}
  #define PIN(x) asm volatile("":"+v"(x))
  #define MX3(a,b,c) __builtin_fmaxf(__builtin_fmaxf((a),(b)),(c))
  #define GAPA(MF,A0,A1,A2,A3,W0,W1,PW) do{ MF; sacc+=A0; sacc+=A1; sacc+=A2; sacc+=A3; PIN(sacc); W0; W1; PIN(PW); SBAR(); }while(0)
  #define EX(v) __builtin_amdgcn_exp2f(v)
  #define GAPB(MF,X,B) do{ MF; X[B]=EX(X[B]); X[B+1]=EX(X[B+1]); X[B+2]=EX(X[B+2]); X[B+3]=EX(X[B+3]); PIN(X); SBAR(); }while(0)
  #define VRD(i) do{ vlo[i]=vtr(vp_+(((i)>>2)*4096+((i)&3)*1024)); vhi[i]=vtr(vp_+(((i)>>2)*4096+((i)&3)*1024+512)); }while(0)
  #define KRD(G,j) do{ if(G){ kload2(kf,kp0+sl_next,j); SBAR(); } }while(0)
  #define STEP(C0,C1,P0,P1,t,GK,GV,GL) do{ SBAR(); \
    const lds_cptr vp_=vp0+sl_prev; \
    VRD(0); SBAR(); float sacc=(P0[0]+P0[1]); \
    GAPA(C0=__builtin_amdgcn_mfma_f32_32x32x16_bf16(kf[0],qr[0],negm,0,0,0), P0[2],P0[3],P0[4],P0[5],     pw0[0]=PKW(P0,0), pw0[1]=PKW(P0,2), pw0); \
    VRD(4); SBAR(); GAPA(C1=__builtin_amdgcn_mfma_f32_32x32x16_bf16(kf[1],qr[0],negm,0,0,0), P0[6],P0[7],P0[8],P0[9],     pw0[2]=PKW(P0,4), pw0[3]=PKW(P0,6), pw0); \
    VRD(1); SBAR(); GAPA(C0=__builtin_amdgcn_mfma_f32_32x32x16_bf16(kf[2],qr[1],C0,0,0,0),   P0[10],P0[11],P0[12],P0[13], pw1[0]=PKW(P0,8), pw1[1]=PKW(P0,10), pw1); \
    VRD(5); SBAR(); GAPA(C1=__builtin_amdgcn_mfma_f32_32x32x16_bf16(kf[3],qr[1],C1,0,0,0),   P0[14],P0[15],P1[0],P1[1],   pw1[2]=PKW(P0,12),pw1[3]=PKW(P0,14), pw1); \
    VRD(2); SBAR(); GAPA(C0=__builtin_amdgcn_mfma_f32_32x32x16_bf16(kf[4],qr[2],C0,0,0,0),   P1[2],P1[3],P1[4],P1[5],     pw2[0]=PKW(P1,0), pw2[1]=PKW(P1,2), pw2); \
    VRD(6); SBAR(); GAPA(C1=__builtin_amdgcn_mfma_f32_32x32x16_bf16(kf[5],qr[2],C1,0,0,0),   P1[6],P1[7],P1[8],P1[9],     pw2[2]=PKW(P1,4), pw2[3]=PKW(P1,6), pw2); \
    VRD(3); SBAR(); GAPA(C0=__builtin_amdgcn_mfma_f32_32x32x16_bf16(kf[6],qr[3],C0,0,0,0),   P1[10],P1[11],P1[12],P1[13], pw3[0]=PKW(P1,8), pw3[1]=PKW(P1,10), pw3); \
    VRD(7); SBAR(); GAPA(C1=__builtin_amdgcn_mfma_f32_32x32x16_bf16(kf[7],qr[3],C1,0,0,0),   P1[14],P1[15],0.f,0.f,       pw3[2]=PKW(P1,12),pw3[3]=PKW(P1,14), pw3); \
    l_reg+=sacc; \
    if(GK){DMA_K((t)+3,sl_cur);} if(GV){DMA_V((t)+1,sl_next);} \
    BIASADD(C0,C1,t); CMASK(C0,C1,t); \
    { float a=MX3(C0[0],C0[1],C1[0]),b=MX3(C0[2],C0[3],C1[1]); a=MX3(a,C1[2],C1[3]); \
      _Pragma("unroll") for(int r=4;r<16;r+=4){a=MX3(a,C0[r],C0[r+1]);b=MX3(b,C0[r+2],C0[r+3]);a=MX3(a,C1[r],C1[r+1]);b=MX3(b,C1[r+2],C1[r+3]);} \
      float rm=__builtin_fmaxf(a,b); { auto rr=__builtin_amdgcn_permlane32_swap(__float_as_uint(rm),__float_as_uint(rm),false,false); rm=__builtin_fmaxf(__uint_as_float(rr[0]),__uint_as_float(rr[1])); } \
      resc=false; \
      if(__builtin_expect(__any(rm>(float)THRL),0)){ const float dl=__builtin_fmaxf(rm,0.f); mhat+=dl; \
        _Pragma("unroll") for(int r=0;r<16;++r){C0[r]-=dl;C1[r]-=dl;} \
        _Pragma("unroll") for(int r=0;r<16;++r)negm[r]=-mhat; asm volatile("":"+v"(negm)); \
        const float f=__builtin_amdgcn_exp2f(-dl); l_reg*=f; if(hi==0)wsf[r32]=f; resc=true; } } \
    SBAR(); \
    GAPB(o[0]=__builtin_amdgcn_mfma_f32_32x32x16_bf16(PAF(0),VFR(0),o[0],0,0,0), C0,0); \
    GAPB(o[1]=__builtin_amdgcn_mfma_f32_32x32x16_bf16(PAF(0),VFR(4),o[1],0,0,0), C0,4); \
    KRD(GL,0); GAPB(o[0]=__builtin_amdgcn_mfma_f32_32x32x16_bf16(PAF(1),VFR(1),o[0],0,0,0), C0,8); \
    KRD(GL,1); GAPB(o[1]=__builtin_amdgcn_mfma_f32_32x32x16_bf16(PAF(1),VFR(5),o[1],0,0,0), C0,12); \
    KRD(GL,2); GAPB(o[0]=__builtin_amdgcn_mfma_f32_32x32x16_bf16(PAF(2),VFR(2),o[0],0,0,0), C1,0); \
    KRD(GL,3); GAPB(o[1]=__builtin_amdgcn_mfma_f32_32x32x16_bf16(PAF(2),VFR(6),o[1],0,0,0), C1,4); \
    GAPB(o[0]=__builtin_amdgcn_mfma_f32_32x32x16_bf16(PAF(3),VFR(3),o[0],0,0,0), C1,8); \
    GAPB(o[1]=__builtin_amdgcn_mfma_f32_32x32x16_bf16(PAF(3),VFR(7),o[1],0,0,0), C1,12); \
    }while(0)
  int t=1;
  #undef CMASK
  #define CMASK(P0,P1,t) do{}while(0)
  for(;t+5<NT;t+=2){
    STEP(pB0,pB1,pA0,pA1,t,true,true,true);     WAIT_BAR(2); RESC(); ROT();
    STEP(pA0,pA1,pB0,pB1,t+1,true,true,true);   WAIT_BAR(2); RESC(); ROT();
  }
  #undef CMASK
  #define CMASK(P0,P1,t) do{int jb_=(t)-(NT-4); if(jb_>=0)cmask(P0,P1,jb_,qrel,hi);}while(0)
  #define ENDW(tt) do{ if((tt)+3<NT){WAIT_BAR(2);} else if((tt)+2<NT){WAIT_BAR(1);} else {WAIT_BAR(0);} }while(0)
  for(;t+1<NT;t+=2){
    STEP(pB0,pB1,pA0,pA1,t,(t+3<NT),(t+1<NT),(t+1<NT));       ENDW(t);   RESC(); ROT();
    STEP(pA0,pA1,pB0,pB1,t+1,(t+4<NT),(t+2<NT),(t+2<NT));     ENDW(t+1); RESC(); ROT();
  }
  STEP(pB0,pB1,pA0,pA1,NT-1,false,false,false); RESC();
  { float sacc=pB0[0]+pB0[1]; _Pragma("unroll") for(int r=2;r<16;++r)sacc+=pB0[r]; _Pragma("unroll") for(int r=0;r<16;++r)sacc+=pB1[r]; l_reg+=sacc;
    pw0=(u32x4){PKW(pB0,0),PKW(pB0,2),PKW(pB0,4),PKW(pB0,6)};pw1=(u32x4){PKW(pB0,8),PKW(pB0,10),PKW(pB0,12),PKW(pB0,14)};pw2=(u32x4){PKW(pB1,0),PKW(pB1,2),PKW(pB1,4),PKW(pB1,6)};pw3=(u32x4){PKW(pB1,8),PKW(pB1,10),PKW(pB1,12),PKW(pB1,14)};
    SBAR(); pv(o,vb0+sl_cur,PAF(0),PAF(1),PAF(2),PAF(3)); }
  #undef PKW
  #undef PAF
  #undef VFR
  #undef PIN
  #undef MX3
  #undef GAPA
  #undef GAPB
  #undef EX
  #undef VRD
  #undef KRD
  #undef STEP
  #undef ENDW
  {auto rr=__builtin_amdgcn_permlane32_swap(__float_as_uint(l_reg),__float_as_uint(l_reg),false,false);l_reg=__uint_as_float(rr[0])+__uint_as_float(rr[1]);}
  if(hi==0)wsf[32+r32]=l_reg;asm volatile("s_waitcnt lgkmcnt(0)":::"memory");
  float rli[16];
  #pragma unroll
  for(int r=0;r<16;++r)rli[r]=__builtin_amdgcn_rcpf(wsf[32+crow(r,hi)]);
  bf16*Ow=O+(rowbase+q0+wid*QBLK)*DMO;
  { bf16*stg=(bf16*)(shm+LDS_OST)+wid*2048;
    #pragma unroll
    for(int r=0;r<16;++r){const int orow=crow(r,hi);
      #pragma unroll
      for(int d0=0;d0<2;++d0)stg[orow*64+d0*32+r32]=__float2bfloat16(o[d0][r]*rli[r]);}
    asm volatile("s_waitcnt lgkmcnt(0)":::"memory");
    #pragma unroll
    for(int i=0;i<4;++i){const int row=i*8+(lane>>3),ch=lane&7; const u32x4 v=*(const u32x4*)(stg+row*64+ch*8); ATTN_STORE16(Ow+(long)row*DMO+ch*8,v);} }
  asm volatile("s_waitcnt lgkmcnt(0)\n\ts_barrier":::"memory");
  #undef BIASADD
  #undef DMA_K
  #undef DMA_V
  #undef CMASK
  #undef START
  #undef RESC
  #undef ROT
}
constexpr int ATTN_LDS_BYTES=LDS_BYTES;
#undef SBAR
#undef WAIT_BAR
}
#include <hip/hip_bf16.h>
#include <cmath>
namespace attn128 {
using bf16=__hip_bfloat16;
using bf16x8=__attribute__((ext_vector_type(8)))short;
using s16x4=__attribute__((ext_vector_type(4)))short;
using f32x16=__attribute__((ext_vector_type(16)))float;
using u32x4=__attribute__((ext_vector_type(4)))unsigned;
constexpr int BATCH=4,SEQ=8192,D=64,DMI=3072,DMO=1024;
constexpr int NW=8,QBLK=32,QB=QBLK*NW,KVBLK=64,NQB=SEQ/QB;
constexpr int ATTN_UNIT_ROWS=QB;
__device__ __forceinline__ int crow(int r,int hi){return (r&3)+8*(r>>2)+4*hi;}
#define SBAR() __builtin_amdgcn_sched_barrier(0)
__device__ __forceinline__ void cmask(f32x16&p0,f32x16&p1,int jb,int qrel,int hi){
  const float NEG=-INFINITY; int kb=64*jb+4*hi;
  #pragma unroll
  for(int r=0;r<16;++r){int kv=kb+(r&3)+8*(r>>2); if(kv>qrel)p0[r]=NEG; if(kv+32>qrel)p1[r]=NEG;}
}

constexpr int NSLOT=3, SLOTB=8192;
constexpr int VSLOTB=2*SLOTB; constexpr int LDS_K=0, LDS_V=NSLOT*SLOTB, LDS_WS=LDS_V+NSLOT*VSLOTB, LDS_OST=LDS_WS+NW*64*4, LDS_BIAS=LDS_OST+NW*4096, LDS_BYTES=LDS_BIAS;
constexpr float C2=0.125f*1.4426950408889634f;
__device__ __forceinline__ void glds16(const void*gsrc,unsigned lds_dst){unsigned keep;
  asm volatile("s_mov_b32 %0, m0\n\ts_mov_b32 m0, %2\n\ts_nop 0\n\tglobal_load_lds_dwordx4 %1, off\n\ts_mov_b32 m0, %0":"=&s"(keep):"v"(gsrc),"s"(lds_dst):"memory");}
__device__ __forceinline__ float max3f(float a,float b,float c){float r;asm("v_max3_f32 %0, %1, %2, %3":"=v"(r):"v"(a),"v"(b),"v"(c));return r;}
__device__ __forceinline__ float max2f(float a,float b){float r;asm("v_max_f32_e32 %0, %1, %2":"=v"(r):"v"(a),"v"(b));return r;}
__device__ __forceinline__ float fadd_s(float a,float b){float r;asm("v_add_f32_e32 %0, %1, %2":"=v"(r):"v"(a),"v"(b));return r;}
__device__ __forceinline__ float fsub_s(float a,float b){float r;asm("v_sub_f32_e32 %0, %1, %2":"=v"(r):"v"(a),"v"(b));return r;}
typedef float f32x2_t __attribute__((ext_vector_type(2))); typedef __bf16 bf16x2_t __attribute__((ext_vector_type(2)));
__device__ __forceinline__ unsigned cvtpk_s(float lo,float hi){f32x2_t v={lo,hi};bf16x2_t b=__builtin_convertvector(v,bf16x2_t);return __builtin_bit_cast(unsigned,b);}
#define WAIT_BAR(N) asm volatile("s_waitcnt vmcnt(" #N ") lgkmcnt(0)\n\ts_barrier":::"memory")

__device__ __forceinline__ void qkt(f32x16&p0,f32x16&p1,const char*Kslot,const bf16x8*qr,const f32x16&negm,int r32,int hi){
  const char*kb=Kslot+hi*1024+r32*16;
  #pragma unroll
  for(int d0=0;d0<4;++d0){
    const bf16x8 b0=*reinterpret_cast<const bf16x8*>(kb+d0*2048);
    const bf16x8 b1=*reinterpret_cast<const bf16x8*>(kb+d0*2048+512);
    if(d0==0){p0=__builtin_amdgcn_mfma_f32_32x32x16_bf16(b0,qr[0],negm,0,0,0);p1=__builtin_amdgcn_mfma_f32_32x32x16_bf16(b1,qr[0],negm,0,0,0);}
    else{p0=__builtin_amdgcn_mfma_f32_32x32x16_bf16(b0,qr[d0],p0,0,0,0);p1=__builtin_amdgcn_mfma_f32_32x32x16_bf16(b1,qr[d0],p1,0,0,0);}}
}
typedef __attribute__((address_space(3))) const char* lds_cptr;
typedef short v4i16_t __attribute__((ext_vector_type(4)));
__device__ __forceinline__ void kload8(bf16x8*kf,lds_cptr kp){
  kf[0]=*(const __attribute__((address_space(3))) bf16x8*)(kp);      kf[1]=*(const __attribute__((address_space(3))) bf16x8*)(kp+512);
  kf[2]=*(const __attribute__((address_space(3))) bf16x8*)(kp+2048); kf[3]=*(const __attribute__((address_space(3))) bf16x8*)(kp+2560);
  kf[4]=*(const __attribute__((address_space(3))) bf16x8*)(kp+4096); kf[5]=*(const __attribute__((address_space(3))) bf16x8*)(kp+4608);
  kf[6]=*(const __attribute__((address_space(3))) bf16x8*)(kp+6144); kf[7]=*(const __attribute__((address_space(3))) bf16x8*)(kp+6656);
}
__device__ __forceinline__ void kload2(bf16x8*kf,lds_cptr kp,int j){ kf[2*j]=*(const __attribute__((address_space(3))) bf16x8*)(kp+j*2048); kf[2*j+1]=*(const __attribute__((address_space(3))) bf16x8*)(kp+j*2048+512); }
__device__ __forceinline__ s16x4 vtr(lds_cptr p){ return __builtin_bit_cast(s16x4,__builtin_amdgcn_ds_read_tr16_b64_v4i16((__attribute__((address_space(3))) v4i16_t*)p)); }
__device__ __forceinline__ float rowmax(const f32x16&p0,const f32x16&p1){
  float a=max3f(p0[0],p0[1],p1[0]),b=max3f(p0[2],p0[3],p1[1]);a=max3f(a,p1[2],p1[3]);
  #pragma unroll
  for(int r=4;r<16;r+=4){a=max3f(a,p0[r],p0[r+1]);b=max3f(b,p0[r+2],p0[r+3]);a=max3f(a,p1[r],p1[r+1]);b=max3f(b,p1[r+2],p1[r+3]);}
  const float m=max2f(a,b);
  auto rr=__builtin_amdgcn_permlane32_swap(__float_as_uint(m),__float_as_uint(m),false,false);
  return max2f(__uint_as_float(rr[0]),__uint_as_float(rr[1]));
}
__device__ __forceinline__ void pv(f32x16*o,int vb,bf16x8 pa0,bf16x8 pa1,bf16x8 pa2,bf16x8 pa3){
  #pragma unroll
  for(int d0=0;d0<2;++d0){s16x4 lo[4],hi[4];
    #pragma unroll
    for(int ks=0;ks<4;++ks){
      asm volatile("ds_read_b64_tr_b16 %0,%1 offset:%c2":"=&v"(lo[ks]):"v"(vb),"i"(d0*4096+ks*1024):"memory");
      asm volatile("ds_read_b64_tr_b16 %0,%1 offset:%c2":"=&v"(hi[ks]):"v"(vb),"i"(d0*4096+ks*1024+512):"memory");}
    asm volatile("s_waitcnt lgkmcnt(0)":::"memory");SBAR();
    #define PK(k) (bf16x8){lo[k][0],lo[k][1],lo[k][2],lo[k][3],hi[k][0],hi[k][1],hi[k][2],hi[k][3]}
    o[d0]=__builtin_amdgcn_mfma_f32_32x32x16_bf16(pa0,PK(0),o[d0],0,0,0);
    o[d0]=__builtin_amdgcn_mfma_f32_32x32x16_bf16(pa1,PK(1),o[d0],0,0,0);
    o[d0]=__builtin_amdgcn_mfma_f32_32x32x16_bf16(pa2,PK(2),o[d0],0,0,0);
    o[d0]=__builtin_amdgcn_mfma_f32_32x32x16_bf16(pa3,PK(3),o[d0],0,0,0);
    #undef PK
  }
}

#ifndef ATTN_STORE16
#define ATTN_STORE16(p,v) (*(u32x4*)(p)=(v))
#endif
template<int THRL,bool BIAS> __device__ __forceinline__ void attn_unit(int b,int qb,const bf16*Q,const bf16*__restrict__ K,const bf16*__restrict__ V,bf16*O,const float*__restrict__ biasg,char*shm,const int tid_in,const bool comb,const bf16*O0,const float lam,const float osc,const float*__restrict__ gsub){
  int tid=tid_in; asm volatile("":"+v"(tid)); const int lane=tid&63,r32=lane&31,hi=lane>>5; const int wid=__builtin_amdgcn_readfirstlane(tid>>6);
  const long rowbase=(long)b*SEQ; const int q0=qb*QB;
  const bf16*Qw=Q+(rowbase+q0+wid*QBLK)*DMI;
  int t0=0;
  if(BIAS){ const int NT0=(q0+QB)/KVBLK; const float bq=biasg[q0]; int cnt=0;
    _Pragma("unroll") for(int h2=0;h2<2;++h2){ const int T=lane+64*h2; const bool sk=(T<NT0-4)&&(biasg[64*(T<NT0?T:0)+63]-bq<-200.f); cnt+=__popcll(__ballot(sk)); }
    t0=__builtin_amdgcn_readfirstlane(cnt)&~1; }
  const float*bg=BIAS?biasg+t0*KVBLK:biasg;
  const bf16*Kh=K+(rowbase+t0*KVBLK)*DMI,*Vh=V+(rowbase+t0*KVBLK)*DMI;
  const unsigned lds0=(unsigned)(uintptr_t)shm;
  float*wsf=(float*)(shm+LDS_WS)+wid*64;
  const bf16*ksrc=Kh+(long)lane*DMI+wid*8;
  const bf16*vsrc=Vh+(long)(16*(wid&3)+(lane>>2))*DMI+(wid>>2)*32+(lane&3)*8;
  const unsigned kdst=lds0+LDS_K+wid*1024, vdst=lds0+LDS_V+wid*1024;
  #define DMA_K(t,slot) glds16(ksrc+(long)(t)*KVBLK*DMI,(unsigned)__builtin_amdgcn_readfirstlane(kdst+(slot)))
  #define DMA_V(t,slot) do{ glds16(vsrc+(long)(t)*KVBLK*DMI,(unsigned)__builtin_amdgcn_readfirstlane(vdst+2*(slot))); glds16(vsrc+64+(long)(t)*KVBLK*DMI,(unsigned)__builtin_amdgcn_readfirstlane(vdst+2*(slot)+8192)); }while(0)
  const int vb0=(int)(lds0+LDS_V)+((lane>>4)&1)*32+(lane&3)*8+(4*hi+((lane&15)>>2))*64;
  const char*Kbase=shm+LDS_K; bf16x8 kf[8];
  const lds_cptr shm3=(lds_cptr)shm; const lds_cptr kp0=shm3+LDS_K+hi*1024+r32*16; const lds_cptr vp0=shm3+LDS_V+((lane>>4)&1)*32+(lane&3)*8+(4*hi+((lane&15)>>2))*64;
  const int NT=(q0+QB)/KVBLK-t0;
  typedef __attribute__((address_space(3))) const float* lds_fptr; typedef float f32x4_t __attribute__((ext_vector_type(4)));
  const lds_fptr biasl=(lds_fptr)(shm3+LDS_BIAS)+4*hi;
  if(BIAS){ __attribute__((address_space(3))) float* bw=(__attribute__((address_space(3))) float*)(shm3+LDS_BIAS); const int nb=NT*KVBLK;
    for(int i=tid*4;i<nb;i+=NW*64*4)*(__attribute__((address_space(3))) f32x4_t*)(bw+i)=*(const f32x4_t*)(bg+i); }
  #define BIASADD(P0,P1,t) do{ if(BIAS){ const lds_fptr bp_=biasl+KVBLK*(t); _Pragma("unroll") for(int i_=0;i_<4;++i_){ \
      const f32x4_t b0_=*(const __attribute__((address_space(3))) f32x4_t*)(bp_+8*i_), b1_=*(const __attribute__((address_space(3))) f32x4_t*)(bp_+32+8*i_); \
      _Pragma("unroll") for(int j_=0;j_<4;++j_){ P0[4*i_+j_]+=b0_[j_]; P1[4*i_+j_]+=b1_[j_]; } } } }while(0)
  DMA_K(0,0);DMA_V(0,0);DMA_K(1,SLOTB);
  bf16x8 qr[4];
  #pragma unroll
  for(int d0=0;d0<4;++d0)qr[d0]=*reinterpret_cast<const bf16x8*>(&Qw[(long)r32*DMI+d0*16+hi*8]);
  float mhat=0.f,l_reg=0.f;f32x16 o[4];o[0]=f32x16{};o[1]=f32x16{};o[2]=f32x16{};o[3]=f32x16{};f32x16 negm=f32x16{};asm volatile("":"+v"(negm));
  const int qrel=wid*QBLK+r32;
  #define CMASK(P0,P1,t) do{int jb_=(t)-(NT-4); if(jb_>=0)cmask(P0,P1,jb_,qrel,hi);}while(0)
  bool resc=false;
  #define START(P0,P1) do{ const float rm=rowmax(P0,P1); resc=false; \
    { const float dl=rm; mhat=fadd_s(mhat,dl); \
      _Pragma("unroll") for(int r=0;r<16;++r){P0[r]=fsub_s(P0[r],dl);P1[r]=fsub_s(P1[r],dl);} \
      _Pragma("unroll") for(int r=0;r<16;++r)negm[r]=-mhat; asm volatile("":"+v"(negm)); } \
    _Pragma("unroll") for(int r=0;r<16;++r)P0[r]=__builtin_amdgcn_exp2f(P0[r]); }while(0)
  #define RESC() do{ if(resc){ asm volatile("s_waitcnt lgkmcnt(0)":::"memory"); \
      _Pragma("unroll") for(int d_=0;d_<4;++d_) _Pragma("unroll") for(int r=0;r<16;++r)o[d_][r]*=wsf[crow(r,hi)]; } }while(0)
  f32x16 pA0,pA1,pB0,pB1;
  int sl_prev=0,sl_cur=0,sl_next=SLOTB;
  #define ROT() do{sl_prev=sl_cur;sl_cur=sl_next;sl_next=(sl_next==(NSLOT-1)*SLOTB)?0:sl_next+SLOTB;}while(0)
  DMA_K(2,2*SLOTB);
  WAIT_BAR(3);
  qkt(pA0,pA1,Kbase,qr,negm,r32,hi);asm volatile("s_nop 15\n\ts_nop 7":"+v"(pA0),"+v"(pA1));BIASADD(pA0,pA1,0);CMASK(pA0,pA1,0);
  START(pA0,pA1);
  _Pragma("unroll") for(int r=0;r<16;++r)pA1[r]=__builtin_amdgcn_exp2f(pA1[r]);
  WAIT_BAR(0);
  DMA_K(3,0);DMA_V(1,SLOTB);
  ROT();
  kload8(kf,kp0+sl_cur);
  WAIT_BAR(3);
  s16x4 vlo[3],vhi[3]; u32x4 pw0,pw1,pw2,pw3;
  #define PKW(P,B) cvtpk_s(P[B],P[B+1])
  #define PAF(k) __builtin_bit_cast(bf16x8,pw##k)
  #define PIN(x) asm volatile("":"+v"(x))
  #define MX3(a,b,c) __builtin_fmaxf(__builtin_fmaxf((a),(b)),(c))
  #define GAPA(MF,A0,A1,A2,A3,W0,W1,PW) do{ MF; sacc+=A0; sacc+=A1; sacc+=A2; sacc+=A3; PIN(sacc); W0; W1; PIN(PW); SBAR(); }while(0)
  #define EX(v) __builtin_amdgcn_exp2f(v)
  #define GAPB(MF,X,B) do{ MF; X[B]=EX(X[B]); X[B+1]=EX(X[B+1]); PIN(X); SBAR(); }while(0)
  #define VRDW(w,i) do{ vlo[w]=vtr(vp_+(((i)>>2)*4096+((i)&3)*1024)); vhi[w]=vtr(vp_+(((i)>>2)*4096+((i)&3)*1024+512)); }while(0)
  #define VFW(w) (bf16x8){vlo[w][0],vlo[w][1],vlo[w][2],vlo[w][3],vhi[w][0],vhi[w][1],vhi[w][2],vhi[w][3]}
  #define KRD(G,j) do{ if(G){ kload2(kf,kp0+sl_next,j); SBAR(); } }while(0)
  #define PVM(a,k,w) o[a]=__builtin_amdgcn_mfma_f32_32x32x16_bf16(PAF(k),VFW(w),o[a],0,0,0)
  #define STEP(C0,C1,P0,P1,t,GK,GV,GL) do{ SBAR(); \
    const lds_cptr vp_=vp0+2*sl_prev; \
    float sacc=(P0[0]+P0[1]); \
    GAPA(C0=__builtin_amdgcn_mfma_f32_32x32x16_bf16(kf[0],qr[0],negm,0,0,0), P0[2],P0[3],P0[4],P0[5],     pw0[0]=PKW(P0,0), pw0[1]=PKW(P0,2), pw0); \
    GAPA(C1=__builtin_amdgcn_mfma_f32_32x32x16_bf16(kf[1],qr[0],negm,0,0,0), P0[6],P0[7],P0[8],P0[9],     pw0[2]=PKW(P0,4), pw0[3]=PKW(P0,6), pw0); \
    GAPA(C0=__builtin_amdgcn_mfma_f32_32x32x16_bf16(kf[2],qr[1],C0,0,0,0),   P0[10],P0[11],P0[12],P0[13], pw1[0]=PKW(P0,8), pw1[1]=PKW(P0,10), pw1); \
    GAPA(C1=__builtin_amdgcn_mfma_f32_32x32x16_bf16(kf[3],qr[1],C1,0,0,0),   P0[14],P0[15],P1[0],P1[1],   pw1[2]=PKW(P0,12),pw1[3]=PKW(P0,14), pw1); \
    GAPA(C0=__builtin_amdgcn_mfma_f32_32x32x16_bf16(kf[4],qr[2],C0,0,0,0),   P1[2],P1[3],P1[4],P1[5],     pw2[0]=PKW(P1,0), pw2[1]=PKW(P1,2), pw2); \
    GAPA(C1=__builtin_amdgcn_mfma_f32_32x32x16_bf16(kf[5],qr[2],C1,0,0,0),   P1[6],P1[7],P1[8],P1[9],     pw2[2]=PKW(P1,4), pw2[3]=PKW(P1,6), pw2); \
    VRDW(0,0); SBAR(); \
    GAPA(C0=__builtin_amdgcn_mfma_f32_32x32x16_bf16(kf[6],qr[3],C0,0,0,0),   P1[10],P1[11],P1[12],P1[13], pw3[0]=PKW(P1,8), pw3[1]=PKW(P1,10), pw3); \
    VRDW(1,4); SBAR(); \
    GAPA(C1=__builtin_amdgcn_mfma_f32_32x32x16_bf16(kf[7],qr[3],C1,0,0,0),   P1[14],P1[15],0.f,0.f,       pw3[2]=PKW(P1,12),pw3[3]=PKW(P1,14), pw3); \
    l_reg+=sacc; \
    if(GK){DMA_K((t)+3,sl_cur);} if(GV){DMA_V((t)+1,sl_next);} \
    BIASADD(C0,C1,t); CMASK(C0,C1,t); \
    { float a=MX3(C0[0],C0[1],C1[0]),b=MX3(C0[2],C0[3],C1[1]); a=MX3(a,C1[2],C1[3]); \
      _Pragma("unroll") for(int r=4;r<16;r+=4){a=MX3(a,C0[r],C0[r+1]);b=MX3(b,C0[r+2],C0[r+3]);a=MX3(a,C1[r],C1[r+1]);b=MX3(b,C1[r+2],C1[r+3]);} \
      float rm=__builtin_fmaxf(a,b); { auto rr=__builtin_amdgcn_permlane32_swap(__float_as_uint(rm),__float_as_uint(rm),false,false); rm=__builtin_fmaxf(__uint_as_float(rr[0]),__uint_as_float(rr[1])); } \
      resc=false; \
      if(__builtin_expect(__any(rm>(float)THRL),0)){ const float dl=__builtin_fmaxf(rm,0.f); mhat+=dl; \
        _Pragma("unroll") for(int r=0;r<16;++r){C0[r]-=dl;C1[r]-=dl;} \
        _Pragma("unroll") for(int r=0;r<16;++r)negm[r]=-mhat; asm volatile("":"+v"(negm)); \
        const float f=__builtin_amdgcn_exp2f(-dl); l_reg*=f; if(hi==0)wsf[r32]=f; resc=true; } } \
    SBAR(); \
    GAPB(PVM(0,0,0), C0,0);  VRDW(2,8);  SBAR(); \
    GAPB(PVM(1,0,1), C0,2);  VRDW(0,12); SBAR(); \
    KRD(GL,0); GAPB(PVM(2,0,2), C0,4);  VRDW(1,1);  SBAR(); \
    GAPB(PVM(3,0,0), C0,6);  VRDW(2,5);  SBAR(); \
    KRD(GL,1); GAPB(PVM(0,1,1), C0,8);  VRDW(0,9);  SBAR(); \
    GAPB(PVM(1,1,2), C0,10); VRDW(1,13); SBAR(); \
    KRD(GL,2); GAPB(PVM(2,1,0), C0,12); VRDW(2,2);  SBAR(); \
    GAPB(PVM(3,1,1), C0,14); VRDW(0,6);  SBAR(); \
    KRD(GL,3); GAPB(PVM(0,2,2), C1,0);  VRDW(1,10); SBAR(); \
    GAPB(PVM(1,2,0), C1,2);  VRDW(2,14); SBAR(); \
    GAPB(PVM(2,2,1), C1,4);  VRDW(0,3);  SBAR(); \
    GAPB(PVM(3,2,2), C1,6);  VRDW(1,7);  SBAR(); \
    GAPB(PVM(0,3,0), C1,8);  VRDW(2,11); SBAR(); \
    GAPB(PVM(1,3,1), C1,10); VRDW(0,15); SBAR(); \
    GAPB(PVM(2,3,2), C1,12); \
    GAPB(PVM(3,3,0), C1,14); \
    }while(0)
  int t=1;
  #undef CMASK
  #define CMASK(P0,P1,t) do{}while(0)
  for(;t+5<NT;t+=2){
    STEP(pB0,pB1,pA0,pA1,t,true,true,true);     WAIT_BAR(3); RESC(); ROT();
    STEP(pA0,pA1,pB0,pB1,t+1,true,true,true);   WAIT_BAR(3); RESC(); ROT();
  }
  #undef CMASK
  #define CMASK(P0,P1,t) do{int jb_=(t)-(NT-4); if(jb_>=0)cmask(P0,P1,jb_,qrel,hi);}while(0)
  #define ENDW(tt) do{ if((tt)+3<NT){WAIT_BAR(3);} else if((tt)+2<NT){WAIT_BAR(2);} else {WAIT_BAR(0);} }while(0)
  for(;t+1<NT;t+=2){
    STEP(pB0,pB1,pA0,pA1,t,(t+3<NT),(t+1<NT),(t+1<NT));       ENDW(t);   RESC(); ROT();
    STEP(pA0,pA1,pB0,pB1,t+1,(t+4<NT),(t+2<NT),(t+2<NT));     ENDW(t+1); RESC(); ROT();
  }
  STEP(pB0,pB1,pA0,pA1,NT-1,false,false,false); RESC();
  { float sacc=pB0[0]+pB0[1]; _Pragma("unroll") for(int r=2;r<16;++r)sacc+=pB0[r]; _Pragma("unroll") for(int r=0;r<16;++r)sacc+=pB1[r]; l_reg+=sacc;
    pw0=(u32x4){PKW(pB0,0),PKW(pB0,2),PKW(pB0,4),PKW(pB0,6)};pw1=(u32x4){PKW(pB0,8),PKW(pB0,10),PKW(pB0,12),PKW(pB0,14)};pw2=(u32x4){PKW(pB1,0),PKW(pB1,2),PKW(pB1,4),PKW(pB1,6)};pw3=(u32x4){PKW(pB1,8),PKW(pB1,10),PKW(pB1,12),PKW(pB1,14)};
    SBAR(); pv(o,vb0+2*sl_cur,PAF(0),PAF(1),PAF(2),PAF(3)); pv(o+2,vb0+2*sl_cur+8192,PAF(0),PAF(1),PAF(2),PAF(3)); }
  #undef PKW
  #undef PAF
  #undef PIN
  #undef MX3
  #undef GAPA
  #undef GAPB
  #undef VRDW
  #undef VFW
  #undef PVM
  #undef EX
  #undef KRD
  #undef STEP
  #undef ENDW
  {auto rr=__builtin_amdgcn_permlane32_swap(__float_as_uint(l_reg),__float_as_uint(l_reg),false,false);l_reg=__uint_as_float(rr[0])+__uint_as_float(rr[1]);}
  if(hi==0)wsf[32+r32]=l_reg;asm volatile("s_waitcnt lgkmcnt(0)":::"memory");
  float rli[16];
  #pragma unroll
  for(int r=0;r<16;++r)rli[r]=__builtin_amdgcn_rcpf(wsf[32+crow(r,hi)]);
  bf16*Ow=O+(rowbase+q0+wid*QBLK)*DMO;
  { bf16*stg=(bf16*)(shm+LDS_OST)+wid*2048;
    if(!comb){
    #pragma unroll
    for(int ps=0;ps<2;++ps){
      #pragma unroll
      for(int r=0;r<16;++r){const int orow=crow(r,hi);
        #pragma unroll
        for(int d0=0;d0<2;++d0)stg[orow*64+d0*32+r32]=__float2bfloat16(o[2*ps+d0][r]*rli[r]);}
      asm volatile("s_waitcnt lgkmcnt(0)":::"memory");
      #pragma unroll
      for(int i=0;i<4;++i){const int row=i*8+(lane>>3),ch=lane&7; const u32x4 v=*(const u32x4*)(stg+row*64+ch*8); ATTN_STORE16(Ow+(long)row*DMO+ps*64+ch*8,v);}
      asm volatile("s_waitcnt lgkmcnt(0)":::"memory"); }
    } else {
      __builtin_amdgcn_fence(__ATOMIC_ACQUIRE,"agent");
      const bf16*O0w=O0+(rowbase+q0+wid*QBLK)*DMO; const int ch=lane&7,rw=lane>>3;
      float dv[2][4][8]; float ssq[4]={0.f,0.f,0.f,0.f};
      #pragma unroll
      for(int ps=0;ps<2;++ps){
        #pragma unroll
        for(int r=0;r<16;++r){const int orow=crow(r,hi);
          #pragma unroll
          for(int d0=0;d0<2;++d0)stg[orow*64+d0*32+r32]=__float2bfloat16(o[2*ps+d0][r]*rli[r]);}
        asm volatile("s_waitcnt lgkmcnt(0)":::"memory");
        #pragma unroll
        for(int i=0;i<4;++i){const int row=i*8+rw; const u32x4 v1=*(const u32x4*)(stg+row*64+ch*8); const u32x4 v0=*(const u32x4*)(O0w+(long)row*DMO+ps*64+ch*8);
          #pragma unroll
          for(int c=0;c<4;++c){ const float a0=__uint_as_float(v0[c]<<16),a1=__uint_as_float(v0[c]&0xffff0000u),b0=__uint_as_float(v1[c]<<16),b1=__uint_as_float(v1[c]&0xffff0000u);
            const float e0=a0-lam*b0,e1=a1-lam*b1; dv[ps][i][2*c]=e0; dv[ps][i][2*c+1]=e1; ssq[i]+=e0*e0+e1*e1; } }
        asm volatile("s_waitcnt lgkmcnt(0)":::"memory"); }
      #pragma unroll
      for(int i=0;i<4;++i){ float s=ssq[i];
        s+=__int_as_float(__builtin_amdgcn_ds_swizzle(__float_as_int(s),(1<<10)|0x1f)); s+=__int_as_float(__builtin_amdgcn_ds_swizzle(__float_as_int(s),(2<<10)|0x1f)); s+=__int_as_float(__builtin_amdgcn_ds_swizzle(__float_as_int(s),(4<<10)|0x1f));
        ssq[i]=osc/sqrtf(s*(1.0f/128.0f)+1e-6f); }
      #pragma unroll
      for(int ps=0;ps<2;++ps){ typedef float f32x4_u __attribute__((ext_vector_type(4)));
        const f32x4_u g0=*(const f32x4_u*)(gsub+ps*64+ch*8),g1=*(const f32x4_u*)(gsub+ps*64+ch*8+4);
        #pragma unroll
        for(int i=0;i<4;++i){const int row=i*8+rw; const float rs=ssq[i]; u32x4 w;
          w.x=cvtpk_s(dv[ps][i][0]*rs*g0.x,dv[ps][i][1]*rs*g0.y); w.y=cvtpk_s(dv[ps][i][2]*rs*g0.z,dv[ps][i][3]*rs*g0.w);
          w.z=cvtpk_s(dv[ps][i][4]*rs*g1.x,dv[ps][i][5]*rs*g1.y); w.w=cvtpk_s(dv[ps][i][6]*rs*g1.z,dv[ps][i][7]*rs*g1.w);
          ATTN_STORE16(Ow+(long)row*DMO+ps*64+ch*8,w);} }
    } }
  asm volatile("s_waitcnt lgkmcnt(0)\n\ts_barrier":::"memory");
  #undef BIASADD
  #undef DMA_K
  #undef DMA_V
  #undef CMASK
  #undef START
  #undef RESC
  #undef ROT
}
constexpr int ATTN_LDS_BYTES=LDS_BYTES;
#undef SBAR
#undef WAIT_BAR
}
#include <hip/hip_cooperative_groups.h>
namespace cg = cooperative_groups;
#define GAS __attribute__((address_space(1)))
#define LAS __attribute__((address_space(3)))
typedef unsigned short bf16;
typedef unsigned v4u __attribute__((ext_vector_type(4)));
typedef unsigned v2u __attribute__((ext_vector_type(2)));
typedef float f32x4 __attribute__((ext_vector_type(4)));
constexpr int NWAVES = 8;
constexpr int BATCH = 4, SEQ = 8192, D = 1024, DEPTH = 2, M = BATCH * SEQ;
constexpr int INW = 3080, NQKV = 3072, DFF = 2816, NGU = 2 * DFF, NFOX = 8;
constexpr float EPS = 1e-6f;
constexpr size_t MiB = 1u << 20;
constexpr size_t WS_RS1 = 5 * MiB, WS_RS2 = 5 * MiB + 262144;
constexpr size_t WS_ROT = 1 * MiB, WS_LOGF = 3 * MiB, WS_CUM = 4 * MiB, WS_WIN = 6 * MiB, WS_WO = 18 * MiB, WS_WGU = 22 * MiB, WS_WD = 44 * MiB, WS_XN = 56 * MiB,
                 WS_QKV = 120 * MiB, WS_ACT = 120 * MiB, WS_Y1 = 120 * MiB, WS_OD = 312 * MiB, WS_MIX = 376 * MiB, WS_Y2 = 312 * MiB, WS_END = 440 * MiB;
constexpr int LDS_BYTES = 147456;
static_assert(attn_body::ATTN_LDS_BYTES <= 131072 && attn128::ATTN_LDS_BYTES <= 131072, "attention scratch fits");
#define LDS_WAIT() asm volatile("s_waitcnt lgkmcnt(0)" ::: "memory")
__device__ __forceinline__ unsigned f2bf(float f) { unsigned u = __builtin_bit_cast(unsigned, f); return (u + 0x7fffu + ((u >> 16) & 1u)) >> 16; }
__device__ __forceinline__ unsigned pk2(float lo, float hi) { return f2bf(lo) | (f2bf(hi) << 16); }
#define SWZ_XOR(v, m) __uint_as_float((unsigned)__builtin_amdgcn_ds_swizzle((int)__float_as_uint(v), ((m) << 10) | 0x1f))
__device__ __forceinline__ float wave_sum(float v) {
    v += SWZ_XOR(v, 1); v += SWZ_XOR(v, 2); v += SWZ_XOR(v, 4); v += SWZ_XOR(v, 8); v += SWZ_XOR(v, 16);
    const auto rr = __builtin_amdgcn_permlane32_swap(__float_as_uint(v), __float_as_uint(v), false, false);
    return __uint_as_float(rr[0]) + __uint_as_float(rr[1]);
}
__device__ __forceinline__ void transpose_item(const float* W, int ldw, int Kdim, bf16* WT, int dst_row0, int k0, int n0, LAS float* scr, int lane, const float* gk) {
#pragma unroll 8
    for (int i = 0; i < 32; ++i) { const int kk = 2 * i + (lane >> 5); scr[kk * 33 + (lane & 31)] = W[(size_t)(k0 + kk) * ldw + n0 + (lane & 31)]; }
    LDS_WAIT(); asm volatile("" ::: "memory");
    const int c = lane & 7;
    f32x4 ga = {1.f, 1.f, 1.f, 1.f}, gb = ga; if (gk) { ga = *(const f32x4*)(gk + k0 + 8 * c); gb = *(const f32x4*)(gk + k0 + 8 * c + 4); }
#pragma unroll
    for (int j = 0; j < 4; ++j) { const int n = (lane >> 3) + 8 * j; const LAS float* s = scr + (8 * c) * 33 + n;
        v4u o; o.x = pk2(s[0 * 33] * ga.x, s[1 * 33] * ga.y); o.y = pk2(s[2 * 33] * ga.z, s[3 * 33] * ga.w); o.z = pk2(s[4 * 33] * gb.x, s[5 * 33] * gb.y); o.w = pk2(s[6 * 33] * gb.z, s[7 * 33] * gb.w);
        *(GAS v4u*)(WT + (size_t)(dst_row0 + n) * Kdim + k0 + 8 * c) = o; }
    LDS_WAIT(); asm volatile("" ::: "memory");
}
__device__ __forceinline__ void load_row(const float* p, int lane, f32x4 (&v)[4]) {
    const f32x4* r = (const f32x4*)p + lane;
#pragma unroll
    for (int j = 0; j < 4; ++j) v[j] = r[64 * j];
}
__device__ __forceinline__ void load_row_bf16(const bf16* p, int lane, f32x4 (&v)[4]) {
    const v2u* r = (const v2u*)p + lane;
#pragma unroll
    for (int j = 0; j < 4; ++j) { const v2u w = r[64 * j]; v[j].x = __uint_as_float(w.x << 16); v[j].y = __uint_as_float(w.x & 0xffff0000u); v[j].z = __uint_as_float(w.y << 16); v[j].w = __uint_as_float(w.y & 0xffff0000u); }
}
__device__ __forceinline__ void store_row(float* p, int lane, const f32x4 (&v)[4]) {
    f32x4* r = (f32x4*)p + lane;
#pragma unroll
    for (int j = 0; j < 4; ++j) r[64 * j] = v[j];
}
__device__ __forceinline__ float row_rstd(const f32x4 (&v)[4]) {
    float s = 0.f;
#pragma unroll
    for (int j = 0; j < 4; ++j) s += (v[j].x * v[j].x + v[j].y * v[j].y) + (v[j].z * v[j].z + v[j].w * v[j].w);
    return 1.0f / sqrtf(wave_sum(s) * (1.0f / D) + EPS);
}
__device__ __forceinline__ void store_row_bf16(bf16* p, int lane, const f32x4 (&v)[4]) {
    v2u* o = (v2u*)p + lane;
#pragma unroll
    for (int j = 0; j < 4; ++j) { v2u w; w.x = pk2(v[j].x, v[j].y); w.y = pk2(v[j].z, v[j].w); o[64 * j] = w; }
}
constexpr int WFL_OFF = 0;
__device__ __forceinline__ void fill_forget_w(const float* win_l, LAS unsigned char* ldsl, int tid) {
    LAS float* wfl = (LAS float*)(ldsl + WFL_OFF);
    for (int idx = tid; idx < 8 * D; idx += NWAVES * 64) { const int k = idx >> 3, f = idx & 7; wfl[f * D + k] = win_l[(size_t)k * INW + NQKV + f]; }
    __syncthreads();
}
__device__ __forceinline__ void pre_norm_row(const f32x4 (&xv)[4], const f32x4 (&g)[4], bf16* xb_row, const LAS float* wfl, const float* fbias, float* logf, float* rs, int row, int lane) {
    const float rstd = row_rstd(xv); f32x4 h[4];
#pragma unroll
    for (int j = 0; j < 4; ++j) h[j] = xv[j] * rstd * g[j];
    if (xb_row) store_row_bf16(xb_row, lane, xv);
    if (lane == 0) rs[row] = rstd;
    float mine = 0.f;
#pragma unroll
    for (int f = 0; f < 8; ++f) { f32x4 a = {0.f, 0.f, 0.f, 0.f};
#pragma unroll
        for (int j = 0; j < 4; ++j) a += *(const LAS f32x4*)(wfl + f * D + 256 * j + 4 * lane) * h[j];
        const float t = wave_sum((a.x + a.y) + (a.z + a.w)); mine = (lane == f) ? t : mine; }
    if (lane < NFOX) { const float y = mine + fbias[lane]; const float e = __expf(-fabsf(y)), u = 1.0f + e, um = u - 1.0f; const float l1p = (um == 0.f) ? e : __logf(u) * (e / um); const float lf = fminf(y, 0.f) - l1p;
        const int b = row / SEQ, s = row % SEQ; logf[(size_t)(b * NFOX + lane) * SEQ + s] = lf; }
}

#define XB_TMO      128
#define XB_XCNT(j)  (256  + 64 * (j))
#define XB_XSUB(j)  (1280 + 64 * (j))
#define XB_XGEN(j)  (2304 + 64 * (j))
#define XB_TOP      3328
#define XB_TOPGEN   3392
#define XCD_BAR_WORDS 3456
#define XB_SPIN_CAP (1u << 22)

__device__ __forceinline__ unsigned xb_ld(unsigned* p)              { return __hip_atomic_load(p, __ATOMIC_RELAXED, __HIP_MEMORY_SCOPE_AGENT); }
__device__ __forceinline__ unsigned xb_add(unsigned* p, unsigned v) { return __hip_atomic_fetch_add(p, v, __ATOMIC_RELAXED, __HIP_MEMORY_SCOPE_AGENT); }
__device__ __forceinline__ unsigned xb_xcc_id() { return (unsigned)__builtin_amdgcn_s_getreg((3 << 11) | 20) & 0xFu; }
#define XB_SPIN(cond, bar) do { unsigned _sp = 0; while (cond) { __builtin_amdgcn_s_sleep(1); \
    if ((++_sp & 255u) == 0u) { if (xb_ld(&(bar)[XB_TMO])) break; if (_sp > XB_SPIN_CAP) { atomicAdd(&(bar)[XB_TMO], 1u); break; } } } } while (0)

struct XcdBarrier {
    unsigned* bar; unsigned x;
    volatile LAS unsigned* st;
};

__device__ __forceinline__ XcdBarrier xcd_barrier_post(unsigned* bar, volatile LAS unsigned* st, const int tid_in) {
    XcdBarrier b; b.bar = bar; b.x = xb_xcc_id(); b.st = st;
    if (tid_in == 0) (void)xb_add(&bar[XB_XCNT(b.x)], 1u);
    return b;
}
__device__ __forceinline__ void xcd_barrier_complete(unsigned* bar, unsigned x, unsigned& nloc, unsigned& nx) {
    const unsigned G = gridDim.x * gridDim.y * gridDim.z;
    unsigned sum, cnt, mine, sp = 0u;
    for (;;) {
        sum = 0u; cnt = 0u; mine = 0u;
#pragma unroll
        for (unsigned j = 0; j < 16; ++j) { const unsigned c = xb_ld(&bar[XB_XCNT(j)]); sum += c; cnt += (c > 0u) ? 1u : 0u; mine = (j == x) ? c : mine; }
        if (sum == G) break;
        __builtin_amdgcn_s_sleep(1);
        if ((++sp & 255u) == 0u) { if (xb_ld(&bar[XB_TMO])) break; if (sp > XB_SPIN_CAP) { atomicAdd(&bar[XB_TMO], 1u); break; } }
    }
    nloc = mine > 0u ? mine : 1u; nx = cnt > 0u ? cnt : 1u;
}

__device__ __forceinline__ void xcd_barrier(const XcdBarrier& b, const int tid_in) {
    asm volatile("s_waitcnt vmcnt(0)" ::: "memory");
    __syncthreads();
    if (tid_in == 0) {
        unsigned* bar = b.bar;
        __builtin_amdgcn_s_waitcnt(0);
        unsigned nloc = b.st[0], nx = b.st[1];
        if (nloc == 0u) { xcd_barrier_complete(bar, b.x, nloc, nx); b.st[0] = nloc; b.st[1] = nx; }
        const unsigned old = xb_add(&bar[XB_XSUB(b.x)], 1u);
        const unsigned gen = old / nloc;
        if (old + 1u == (gen + 1u) * nloc) {
            __builtin_amdgcn_fence(__ATOMIC_RELEASE, "agent");
            asm volatile("s_waitcnt vmcnt(0)" ::: "memory");
            const unsigned og = xb_add(&bar[XB_TOP], 1u);
            const unsigned tg = og / nx;
            if (og + 1u == (tg + 1u) * nx) xb_add(&bar[XB_TOPGEN], 1u);
            else XB_SPIN(xb_ld(&bar[XB_TOPGEN]) == tg, bar);
            __builtin_amdgcn_fence(__ATOMIC_ACQUIRE, "agent");
            xb_add(&bar[XB_XGEN(b.x)], 1u);
            asm volatile("s_waitcnt vmcnt(0)" ::: "memory");
        } else {
            XB_SPIN(xb_ld(&bar[XB_XGEN(b.x)]) == gen, bar);
            __builtin_amdgcn_fence(__ATOMIC_ACQUIRE, "agent");
            asm volatile("s_waitcnt vmcnt(0)" ::: "memory");
        }
    }
    __syncthreads();
}

constexpr size_t WS_CTL = 0, CTL_ZERO_BYTES = 65536; constexpr int CW_BAR = 4096;
constexpr int MISC_OFF = 131072 + 320;
struct Args { const void* in[17]; float* out; unsigned char* ws; };
typedef const __attribute__((address_space(4))) Args* KArgs;
#define KA() ([]() __attribute__((always_inline)) { KArgs p_ = (KArgs)__builtin_amdgcn_kernarg_segment_ptr(); asm volatile("" : "+s"(p_)); return p_; }())
#define IN_F(A, k) ((const float*)(A)->in[k])

__global__ void __launch_bounds__(NWAVES * 64, 2) hymba_fwd(Args args_unused) {
    extern __shared__ __attribute__((aligned(16))) unsigned char lds[];
    cg::grid_group grid = cg::this_grid();
#define TID_NOW() ({ unsigned ones_ = ~0u; asm volatile("" : "+s"(ones_)); (wave0 << 6) | (int)__builtin_amdgcn_mbcnt_hi(ones_, __builtin_amdgcn_mbcnt_lo(ones_, 0u)); })
    const int wave0 = __builtin_amdgcn_readfirstlane((int)threadIdx.x >> 6);
#define PH_IDS() int tid = TID_NOW(); asm volatile("" : "+v"(tid)); const int lane = tid & 63, wave = __builtin_amdgcn_readfirstlane(tid >> 6); int bx = blockIdx.x; asm volatile("" : "+s"(bx)); \
    const int G = gridDim.x, vcu = (G % 8 == 0) ? (bx % 8) * (G / 8) + bx / 8 : bx, gw = vcu * NWAVES + wave, NGW = G * NWAVES; (void)lane; (void)gw; (void)NGW; (void)vcu
#define BARRIER() do { KArgs Ab_ = KA(); XcdBarrier b_; b_.bar = (unsigned*)(Ab_->ws + WS_CTL) + CW_BAR; b_.x = xb_xcc_id(); b_.st = (volatile LAS unsigned*)(ldsl + MISC_OFF) + 8; int t_ = TID_NOW(); asm volatile("" : "+v"(t_)); xcd_barrier(b_, t_); } while (0)
    LAS unsigned char* ldsl = (LAS unsigned char*)lds;
    { const int t_ = TID_NOW(); for (int u = t_; u < (LDS_BYTES - 131072) / 4; u += NWAVES * 64) ((LAS unsigned*)(ldsl + 131072))[u] = 0u;
      __syncthreads();
      (void)xcd_barrier_post((unsigned*)(KA()->ws + WS_CTL) + CW_BAR, (volatile LAS unsigned*)(ldsl + MISC_OFF) + 8, t_); }

    {
        KArgs A = KA(); PH_IDS(); unsigned char* ws = A->ws;
        const float* attn_pre_g = IN_F(A, 2); const float* ffn_pre_g = IN_F(A, 12); const float* w_in = IN_F(A, 3); const float* w_out = IN_F(A, 10); const float* w_gate = IN_F(A, 13); const float* w_up = IN_F(A, 14); const float* w_down = IN_F(A, 15);
        bf16* WIN_T = (bf16*)(ws + WS_WIN); bf16* WO_T = (bf16*)(ws + WS_WO); bf16* WGU_T = (bf16*)(ws + WS_WGU); bf16* WD_T = (bf16*)(ws + WS_WD);
        LAS float* scr = (LAS float*)(ldsl + wave * 16384);
        constexpr int I_IN = 16 * (NQKV / 32), I_O = 16 * (D / 32), I_G = 16 * (DFF / 32), I_D = (DFF / 64) * (D / 32), I_L = I_IN + I_O + 2 * I_G + I_D;
        for (int it = gw; it < DEPTH * I_L; it += NGW) {
            const int l = it / I_L; int r = it % I_L;
            if (r < I_IN) { const int nb = NQKV / 32; transpose_item(w_in + (size_t)l * D * INW, INW, D, WIN_T + (size_t)l * NQKV * D, 32 * (r % nb), 64 * (r / nb), 32 * (r % nb), scr, lane, attn_pre_g + l * D); continue; } r -= I_IN;
            if (r < I_O) { const int nb = D / 32; transpose_item(w_out + (size_t)l * D * D, D, D, WO_T + (size_t)l * D * D, 32 * (r % nb), 64 * (r / nb), 32 * (r % nb), scr, lane, nullptr); continue; } r -= I_O;
            if (r < 2 * I_G) { const int up = r >= I_G; if (up) r -= I_G; const int nb = DFF / 32, n0 = 32 * (r % nb);
                transpose_item((up ? w_up : w_gate) + (size_t)l * D * DFF, DFF, D, WGU_T + (size_t)l * NGU * D, (n0 / 128) * 256 + up * 128 + (n0 % 128), 64 * (r / nb), n0, scr, lane, ffn_pre_g + l * D); continue; } r -= 2 * I_G;
            { const int nb = D / 32; transpose_item(w_down + (size_t)l * DFF * D, D, DFF, WD_T + (size_t)l * D * DFF, 32 * (r % nb), 64 * (r / nb), 32 * (r % nb), scr, lane, nullptr); }
        }
    }
    {
        KArgs A = KA(); PH_IDS(); const int* positions = (const int*)A->in[1]; float* ROT = (float*)(A->ws + WS_ROT);
        for (int e = bx * (NWAVES * 64) + tid; e < M * 8; e += G * NWAVES * 64) {
            const int row = e >> 3, i = e & 7;
            float fr = 1.000000000e+00f;
            fr = (i == 1) ? 1.939227581e-01f : fr; fr = (i == 2) ? 3.760603070e-02f : fr; fr = (i == 3) ? 7.292665076e-03f : fr; fr = (i == 4) ? 1.414213446e-03f : fr;
            fr = (i == 5) ? 2.742481884e-04f : fr; fr = (i == 6) ? 5.318296462e-05f : fr; fr = (i == 7) ? 1.031338525e-05f : fr;
            const float ang = (float)positions[row] * fr;
            const double xd = (double)ang, kq = rint(xd * 0.63661977236758134308), rr = fma(-kq, 6.123233995736766e-17, fma(-kq, 1.5707963267948966, xd)), r2 = rr * rr;
            const double sn = rr * (1.0 + r2 * (-1.0 / 6 + r2 * (1.0 / 120 + r2 * (-1.0 / 5040 + r2 * (1.0 / 362880 + r2 * (-1.0 / 39916800))))));
            const double cs = 1.0 + r2 * (-0.5 + r2 * (1.0 / 24 + r2 * (-1.0 / 720 + r2 * (1.0 / 40320 + r2 * (-1.0 / 3628800 + r2 * (1.0 / 479001600))))));
            const int q4 = (int)kq & 3;
            const double c = (q4 == 0) ? cs : (q4 == 1) ? -sn : (q4 == 2) ? -cs : sn, s = (q4 == 0) ? sn : (q4 == 1) ? cs : (q4 == 2) ? -sn : -cs;
            ROT[(size_t)row * 16 + i] = (float)c; ROT[(size_t)row * 16 + 8 + i] = (float)s;
        }
    }
    {
        KArgs A = KA(); PH_IDS(); const float* x_in = IN_F(A, 0); bf16* XN = (bf16*)(A->ws + WS_XN); float* LOGF = (float*)(A->ws + WS_LOGF); const float* fbias = IN_F(A, 4);
        __syncthreads();
        fill_forget_w(IN_F(A, 3), ldsl, tid);
        f32x4 g[4]; load_row(IN_F(A, 2), lane, g);
        {
            f32x4 xv[4]; load_row(x_in + (size_t)gw * D, lane, xv);
            for (int m = gw; m < M; m += NGW) { f32x4 xn[4]; const int mn = (m + NGW < M) ? m + NGW : m; load_row(x_in + (size_t)mn * D, lane, xn);
                pre_norm_row(xv, g, XN + (size_t)m * D, (const LAS float*)(ldsl + WFL_OFF), fbias, LOGF, (float*)(A->ws + WS_RS1), m, lane);
#pragma unroll
                for (int j = 0; j < 4; ++j) xv[j] = xn[j]; } }
    }
    grid.sync();

#pragma unroll 1
    for (int l = 0; l < DEPTH; ++l) {
        {
            KArgs A = KA(); PH_IDS(); const float* LOGF = (const float*)(A->ws + WS_LOGF); float* CUM = (float*)(A->ws + WS_CUM);
            for (int ch = bx; ch < BATCH * NFOX; ch += G) {
                LAS float* wt = (LAS float*)ldsl;
                const f32x4* src = (const f32x4*)(LOGF + (size_t)ch * SEQ + tid * 16); f32x4 v[4]; float run = 0.f;
#pragma unroll
                for (int j = 0; j < 4; ++j) { v[j] = src[j]; v[j].x += run; v[j].y += v[j].x; v[j].z += v[j].y; v[j].w += v[j].z; run = v[j].w; }
                float inc = run;
#pragma unroll
                for (int o = 1; o < 64; o <<= 1) { const float t = __uint_as_float((unsigned)__builtin_amdgcn_ds_bpermute(((lane - o) & 63) << 2, (int)__float_as_uint(inc))); if (lane >= o) inc += t; }
                if (lane == 63) wt[wave] = inc;
                __syncthreads();
                float off = inc - run;
                for (int w = 0; w < wave; ++w) off += wt[w];
                f32x4* dst = (f32x4*)(CUM + (size_t)ch * SEQ + tid * 16);
#pragma unroll
                for (int j = 0; j < 4; ++j) dst[j] = (v[j] + off) * -1.4426950408889634f;
                __syncthreads();
            }
        }
        {
            KArgs A = KA(); PH_IDS(); unsigned char* ws = A->ws;
            pg8::Gemm g{(const bf16*)(ws + WS_XN), (const bf16*)(ws + WS_WIN) + (size_t)l * NQKV * D, M, NQKV, D}; pg8::StaticOrder S; S.init(M, NQKV, G, bx);
            pg8::EpiQKV E{(bf16*)(ws + WS_QKV), (const float*)(ws + WS_ROT), (const float*)(ws + WS_RS1)};
            pg8::gemm_phase<pg8::EpiQKV, pg8::StaticOrder, PG8_ALIGN, PG8_SP2>(ldsl, g, S, E, tid);
        }
        BARRIER();
        {
            KArgs A = KA(); PH_IDS(); unsigned char* ws = A->ws;
            const float lam_init = 0.8f - 0.6f * __expf(-0.3f * (float)l);
            const float e1 = __expf(wave_sum(IN_F(A, 5)[l * 64 + lane] * IN_F(A, 6)[l * 64 + lane])), e2 = __expf(wave_sum(IN_F(A, 7)[l * 64 + lane] * IN_F(A, 8)[l * 64 + lane]));
            const float lam = __uint_as_float((unsigned)__builtin_amdgcn_readfirstlane((int)__float_as_uint(e1 - e2 + lam_init))), osc = __uint_as_float((unsigned)__builtin_amdgcn_readfirstlane((int)__float_as_uint(1.0f - lam_init)));
            const float* gsub = IN_F(A, 9) + l * 128;
            unsigned* qcnt = (unsigned*)(ws + WS_CTL) + 64 * (1 + 8 * l);
            volatile LAS unsigned* qs = (volatile LAS unsigned*)(ldsl + MISC_OFF) + 16;
            const attn_body::bf16* Qb = (const attn_body::bf16*)(ws + WS_QKV);
            int k = 0;
            while (k < 8) {
                const int x = (bx + k) & 7;
                if (tid == 0) *qs = __hip_atomic_fetch_add(qcnt + 64 * x, 1u, __ATOMIC_RELAXED, __HIP_MEMORY_SCOPE_AGENT);
                __syncthreads();
                const unsigned e = (unsigned)__builtin_amdgcn_readfirstlane(*qs);
                __syncthreads();
                if (e >= 192u) { ++k; continue; }
                const int qb = (e < 64u) ? 31 - (int)(e >> 1) : 31 - (int)((e - 64u) >> 2), j = (e < 64u) ? (int)(e & 1u) : 2 + (int)((e - 64u) & 3u);
                if (j < 2) { const int idx = 2 * x + j, b = idx >> 2, h = idx & 3;
#pragma unroll 1
                    for (int mp = 0; mp < 2; ++mp) { const int hm = 2 * h + mp;
                        attn128::attn_unit<8, false>(b, qb, (const attn128::bf16*)Qb + hm * 64, (const attn128::bf16*)Qb + 512 + hm * 64, (const attn128::bf16*)Qb + 1024 + h * 128,
                            (mp ? (attn128::bf16*)(ws + WS_MIX) : (attn128::bf16*)(ws + WS_OD)) + h * 128, nullptr, (char*)lds, tid, mp != 0, (const attn128::bf16*)(ws + WS_OD) + h * 128, lam, osc, gsub); }
                } else { const int b = j - 2, f = (x - 2 * b) & 7;
                    attn_body::attn_unit<8, true>(b, qb, Qb + 1536 + f * 64, Qb + 2048 + f * 64, Qb + 2560 + f * 64, (attn_body::bf16*)(ws + WS_MIX) + 512 + f * 64, (const float*)(ws + WS_CUM) + (size_t)(b * NFOX + f) * SEQ, (char*)lds, tid); }
            }
        }
        BARRIER();
        {
            KArgs A = KA(); PH_IDS(); unsigned char* ws = A->ws;
            pg8::Gemm g{(const bf16*)(ws + WS_MIX), (const bf16*)(ws + WS_WO) + (size_t)l * D * D, M, D, D}; pg8::StaticOrder S; S.init(M, D, G, bx);
            pg8::EpiY E{(bf16*)(ws + WS_Y1), D};
            pg8::gemm_phase<pg8::EpiY, pg8::StaticOrder, PG8_ALIGN, PG8_SP2>(ldsl, g, S, E, tid);
        }
        BARRIER();
        {
            KArgs A = KA(); PH_IDS(); const bf16* Y1 = (const bf16*)(A->ws + WS_Y1); bf16* XB = (bf16*)(A->ws + WS_XN); float* RS2 = (float*)(A->ws + WS_RS2); const float* x_in = IN_F(A, 0);
            f32x4 gp[4]; load_row(IN_F(A, 11) + l * D, lane, gp);
            f32x4 y[4], xv[4];
            load_row_bf16(Y1 + (size_t)gw * D, lane, y); if (l == 0) load_row(x_in + (size_t)gw * D, lane, xv); else load_row_bf16(XB + (size_t)gw * D, lane, xv);
            for (int m = gw; m < M; m += NGW) { f32x4 yn[4], xn[4];
                const int mn = (m + NGW < M) ? m + NGW : m;
                load_row_bf16(Y1 + (size_t)mn * D, lane, yn); if (l == 0) load_row(x_in + (size_t)mn * D, lane, xn); else load_row_bf16(XB + (size_t)mn * D, lane, xn);
                const float ry = row_rstd(y);
#pragma unroll
                for (int j = 0; j < 4; ++j) xv[j] += y[j] * ry * gp[j];
                store_row_bf16(XB + (size_t)m * D, lane, xv);
                const float rx = row_rstd(xv);
                if (lane == 0) RS2[m] = rx;
#pragma unroll
                for (int j = 0; j < 4; ++j) { y[j] = yn[j]; xv[j] = xn[j]; }
            }
        }
        BARRIER();
        {
            KArgs A = KA(); PH_IDS(); unsigned char* ws = A->ws;
            pg8::Gemm g{(const bf16*)(ws + WS_XN), (const bf16*)(ws + WS_WGU) + (size_t)l * NGU * D, M, NGU, D}; pg8::StaticOrder S; S.init(M, NGU, G, bx);
            pg8::EpiSwiGLU E{(bf16*)(ws + WS_ACT), DFF, (const float*)(ws + WS_RS2)};
            pg8::gemm_phase<pg8::EpiSwiGLU, pg8::StaticOrder, PG8_ALIGN, PG8_SP2>(ldsl, g, S, E, tid);
        }
        BARRIER();
        {
            KArgs A = KA(); PH_IDS(); unsigned char* ws = A->ws;
            pg8::Gemm g{(const bf16*)(ws + WS_ACT), (const bf16*)(ws + WS_WD) + (size_t)l * D * DFF, M, D, DFF}; pg8::StaticOrder S; S.init(M, D, G, bx);
            pg8::EpiY E{(bf16*)(ws + WS_Y2), D};
            pg8::gemm_phase<pg8::EpiY, pg8::StaticOrder, PG8_ALIGN, PG8_SP2>(ldsl, g, S, E, tid);
        }
        BARRIER();
        {
            KArgs A = KA(); PH_IDS(); const bf16* Y2 = (const bf16*)(A->ws + WS_Y2); bf16* XB = (bf16*)(A->ws + WS_XN);
            f32x4 gp[4]; load_row(IN_F(A, 16) + l * D, lane, gp);
            if (l + 1 < DEPTH) {
                float* LOGF = (float*)(A->ws + WS_LOGF); float* RS1 = (float*)(A->ws + WS_RS1); const float* fbias = IN_F(A, 4) + (l + 1) * NFOX;
                fill_forget_w(IN_F(A, 3) + (size_t)(l + 1) * D * INW, ldsl, tid);
                f32x4 g[4]; load_row(IN_F(A, 2) + (l + 1) * D, lane, g);
                f32x4 y[4], xv[4];
                load_row_bf16(Y2 + (size_t)gw * D, lane, y); load_row_bf16(XB + (size_t)gw * D, lane, xv);
                for (int m = gw; m < M; m += NGW) { f32x4 yn[4], xn[4];
                    const int mn = (m + NGW < M) ? m + NGW : m;
                    load_row_bf16(Y2 + (size_t)mn * D, lane, yn); load_row_bf16(XB + (size_t)mn * D, lane, xn);
                    const float ry = row_rstd(y);
#pragma unroll
                    for (int j = 0; j < 4; ++j) xv[j] += y[j] * ry * gp[j];
                    pre_norm_row(xv, g, XB + (size_t)m * D, (const LAS float*)(ldsl + WFL_OFF), fbias, LOGF, RS1, m, lane);
#pragma unroll
                    for (int j = 0; j < 4; ++j) { y[j] = yn[j]; xv[j] = xn[j]; }
                }
                BARRIER();
            } else {
                float* xout = A->out;
                f32x4 y[4], xv[4];
                load_row_bf16(Y2 + (size_t)gw * D, lane, y); load_row_bf16(XB + (size_t)gw * D, lane, xv);
                for (int m = gw; m < M; m += NGW) { f32x4 yn[4], xn[4];
                    const int mn = (m + NGW < M) ? m + NGW : m;
                    load_row_bf16(Y2 + (size_t)mn * D, lane, yn); load_row_bf16(XB + (size_t)mn * D, lane, xn);
                    const float ry = row_rstd(y);
#pragma unroll
                    for (int j = 0; j < 4; ++j) xv[j] += y[j] * ry * gp[j];
                    store_row(xout + (size_t)m * D, lane, xv);
#pragma unroll
                    for (int j = 0; j < 4; ++j) { y[j] = yn[j]; xv[j] = xn[j]; }
                }
            }
        }
    }
}

extern "C" void kernel_launch(void* const* d_in, const int* in_sizes, int n_in, void* d_out, int out_size, void* d_ws, size_t ws_size, hipStream_t stream) {
    static int grid = 0;
    if (grid == 0) {
        if (n_in != 17 || in_sizes[0] != M * D || out_size != M * D || ws_size < WS_END) { fprintf(stderr, "kernel_launch: shape/workspace mismatch (n_in %d in0 %d out %d ws %zu)\n", n_in, n_in > 0 ? in_sizes[0] : -1, out_size, ws_size); grid = -1; return; }
        int dev = 0, cus = 0, per_cu = 0;
        if (hipGetDevice(&dev) != hipSuccess || hipDeviceGetAttribute(&cus, hipDeviceAttributeMultiprocessorCount, dev) != hipSuccess) { grid = -1; return; }
        if (hipFuncSetAttribute((const void*)hymba_fwd, hipFuncAttributeMaxDynamicSharedMemorySize, LDS_BYTES) != hipSuccess) { fprintf(stderr, "kernel_launch: hipFuncSetAttribute failed\n"); grid = -1; return; }
        if (hipOccupancyMaxActiveBlocksPerMultiprocessor(&per_cu, (const void*)hymba_fwd, NWAVES * 64, LDS_BYTES) != hipSuccess || per_cu < 1) { fprintf(stderr, "kernel_launch: occupancy query says %d\n", per_cu); per_cu = 1; }
        (void)hipGetLastError();
        grid = cus;
    }
    if (grid < 0) return;
    if (hipMemsetAsync((char*)d_ws + WS_CTL, 0, CTL_ZERO_BYTES, stream) != hipSuccess) { fprintf(stderr, "kernel_launch: hipMemsetAsync failed\n"); return; }
    Args a{};
    for (int i = 0; i < 17; ++i) a.in[i] = d_in[i];
    a.out = (float*)d_out; a.ws = (unsigned char*)d_ws;
    void* kargs[] = {&a};
    const hipError_t le = hipLaunchCooperativeKernel((const void*)hymba_fwd, dim3(grid), dim3(NWAVES * 64), kargs, LDS_BYTES, stream);
    if (le != hipSuccess) fprintf(stderr, "kernel_launch: cooperative launch failed: %s (grid %d)\n", hipGetErrorName(le), grid);
}
```

```cpp
#include <hip/hip_runtime.h>
#include <cstdio>
#include <cstdint>
namespace pg8 {
#define PG8_LAS __attribute__((address_space(3)))
typedef unsigned short bf16_t;
typedef short bf16x8 __attribute__((ext_vector_type(8)));
typedef float f32x4 __attribute__((ext_vector_type(4)));
typedef unsigned u32x4 __attribute__((ext_vector_type(4)));
constexpr int BM = 256, BK = 64, HALF = 128, HTB = HALF * BK * 2  , STAGE_BYTES = 8 * HTB, NXCD = 8, WGM = 4;

__host__ __device__ __forceinline__ int lds_byte(int r, int c) { const int st = (r >> 4) * 2 + (c >> 5), rr = r & 15, cc = c & 31, ob = rr * 64 + cc * 2; return st * 1024 + (ob ^ (((ob >> 9) & 1) << 5)); }
__host__ __device__ __forceinline__ void stage_rc(int b, int& R, int& C) { const int st = b / 1024, sb = b % 1024, swz = sb ^ (((sb >> 9) & 1) << 5); R = (st >> 1) * 16 + swz / 64; C = (st & 1) * 32 + (swz % 64) / 2; }
__host__ __device__ __forceinline__ int perm32(int rho) { const int n = rho >> 4, i = rho & 15; return 8 * (i >> 2) + 4 * n + (i & 3); }

struct Unit { int pm, pn; };
struct Gemm { const bf16_t* A; const bf16_t* Bt; int M, N, K; };

struct StaticOrder {
    int nM, nN, nwg, G, c;
    __host__ __device__ void init(int M, int N, int G_, int c_) { nM = M / BM; nN = N / BM; nwg = nM * nN; G = G_; c = c_; }
    __host__ __device__ bool next(int i, Unit& u) const {
        const long L = (long)i * G + c; if (L >= nwg) return false;
        int wgid = (int)L; { const int q = nwg / NXCD, r = nwg % NXCD, xcd = wgid % NXCD, off = wgid / NXCD; wgid = (xcd < r ? xcd * (q + 1) : r * (q + 1) + (xcd - r) * q) + off; }
        const int nig = WGM * nN, gid = wgid / nig, fm = gid * WGM, gsz = (nM - fm) < WGM ? (nM - fm) : WGM;
        u.pm = fm + ((wgid % nig) % gsz); u.pn = (wgid % nig) / gsz; return true;
    }
    __device__ __forceinline__ void a_ready(const Unit&) const {}
    __device__ __forceinline__ void done(const Unit&) const {}
};

__device__ __forceinline__ unsigned cvt_pk_bf16(float lo, float hi) { unsigned r; asm volatile("v_cvt_pk_bf16_f32 %0, %1, %2" : "=v"(r) : "v"(lo), "v"(hi)); return r; }
typedef float f32x2 __attribute__((ext_vector_type(2)));
constexpr float QSCALE = 0.125f * 1.4426950408889634f;
typedef unsigned u32x4 __attribute__((ext_vector_type(4)));
struct EpiQKV {
    static constexpr bool PERM = true, AFTER_DRAIN = false;
    bf16_t* O; const float* rot; const float* rs;
    __device__ __forceinline__ void pre(const Unit& u, int wr, int fr, float (&rsv)[8]) const {
#pragma unroll
        for (int i = 0; i < 8; ++i) rsv[i] = rs[u.pm * BM + wr * 64 + fr + (i >> 2) * HALF + (i & 3) * 16]; }
    __device__ __forceinline__ void operator()(const f32x4 (&acc)[2][2][4][2], const Unit& u, int wr, int wc, int fr, int fq, const float (&rsv)[8]) const {
        const int row0 = u.pm * BM + wr * 64 + fr, col0 = u.pn * BM + wc * 32 + 8 * fq;
        const bool isq = (u.pn < 2) || (u.pn == 6) || (u.pn == 7);
        const float sc = isq ? QSCALE : 1.f;
        const bool rotw = (u.pn < 4) && ((wc & 1) == 0);
        const float sgn = (fq == 0) ? -1.f : 1.f; const bool rotl = fq < 2; const int pidx = (((fq ^ 1) << 4) | fr) << 2;
#pragma unroll
        for (int ai = 0; ai < 2; ++ai)
#pragma unroll
            for (int m = 0; m < 4; ++m) { const int row = row0 + ai * HALF + m * 16; bf16_t* rowp = O + (size_t)row * 3072 + col0; const float scr_ = sc * rsv[ai * 4 + m];
                f32x4 c0 = {1.f, 1.f, 1.f, 1.f}, c1 = c0, s0 = {0.f, 0.f, 0.f, 0.f}, s1 = s0;
                if (rotw) { const f32x4* rp = (const f32x4*)(rot + (size_t)row * 16); c0 = rp[0]; c1 = rp[1]; s0 = rp[2]; s1 = rp[3]; }
#pragma unroll
                for (int bj = 0; bj < 2; ++bj) { f32x4 v0 = acc[ai][bj][m][0], v1 = acc[ai][bj][m][1];
                    if (rotw) { f32x4 p0, p1;
#pragma unroll
                        for (int j = 0; j < 4; ++j) { const float a0 = v0[j], a1 = v1[j]; p0[j] = __int_as_float(__builtin_amdgcn_ds_bpermute(pidx, __float_as_int(a0))); p1[j] = __int_as_float(__builtin_amdgcn_ds_bpermute(pidx, __float_as_int(a1))); }
                        if (rotl) { v0 = v0 * c0 + (p0 * s0) * sgn; v1 = v1 * c1 + (p1 * s1) * sgn; } }
                    v0 = v0 * scr_; v1 = v1 * scr_; u32x4 w; w.x = cvt_pk_bf16(v0[0], v0[1]); w.y = cvt_pk_bf16(v0[2], v0[3]); w.z = cvt_pk_bf16(v1[0], v1[1]); w.w = cvt_pk_bf16(v1[2], v1[3]);
                    *(u32x4*)(rowp + bj * HALF) = w; } }
    }
};
struct EpiY {
    static constexpr bool PERM = true, AFTER_DRAIN = false;
    bf16_t* O; int ldc;
    __device__ __forceinline__ void pre(const Unit&, int, int, float (&rsv)[8]) const {
#pragma unroll
        for (int i = 0; i < 8; ++i) rsv[i] = 1.f; }
    __device__ __forceinline__ void operator()(const f32x4 (&acc)[2][2][4][2], const Unit& u, int wr, int wc, int fr, int fq, const float (&rsv)[8]) const {
        const int row0 = u.pm * BM + wr * 64 + fr, col0 = u.pn * BM + wc * 32 + 8 * fq;
#pragma unroll
        for (int ai = 0; ai < 2; ++ai)
#pragma unroll
            for (int m = 0; m < 4; ++m) { bf16_t* rowp = O + (size_t)(row0 + ai * HALF + m * 16) * ldc + col0;
#pragma unroll
                for (int bj = 0; bj < 2; ++bj) { const f32x4 v0 = acc[ai][bj][m][0], v1 = acc[ai][bj][m][1];
                    u32x4 w; w.x = cvt_pk_bf16(v0[0], v0[1]); w.y = cvt_pk_bf16(v0[2], v0[3]); w.z = cvt_pk_bf16(v1[0], v1[1]); w.w = cvt_pk_bf16(v1[2], v1[3]);
                    *(u32x4*)(rowp + bj * HALF) = w; } }
    }
};
struct EpiSwiGLU {
    static constexpr bool PERM = true, AFTER_DRAIN = false;
    bf16_t* O; int ldc; const float* rs;
    __device__ __forceinline__ void pre(const Unit& u, int wr, int fr, float (&rsv)[8]) const {
#pragma unroll
        for (int i = 0; i < 8; ++i) rsv[i] = rs[u.pm * BM + wr * 64 + fr + (i >> 2) * HALF + (i & 3) * 16]; }
    __device__ __forceinline__ void operator()(const f32x4 (&acc)[2][2][4][2], const Unit& u, int wr, int wc, int fr, int fq, const float (&rsv)[8]) const {
        const int row0 = u.pm * BM + wr * 64 + fr, col0 = u.pn * HALF + wc * 32 + 8 * fq;
#pragma unroll
        for (int ai = 0; ai < 2; ++ai)
#pragma unroll
            for (int m = 0; m < 4; ++m) { bf16_t* rowp = O + (size_t)(row0 + ai * HALF + m * 16) * ldc + col0; float r[8]; const float rr = rsv[ai * 4 + m];
#pragma unroll
                for (int n = 0; n < 2; ++n)
#pragma unroll
                    for (int j = 0; j < 4; ++j) { const float g = acc[ai][0][m][n][j] * rr, up = acc[ai][1][m][n][j] * rr;
                        const float e = __builtin_amdgcn_exp2f(g * -1.4426950408889634f); r[n * 4 + j] = g * __builtin_amdgcn_rcpf(1.0f + e) * up; }
                u32x4 w; w.x = cvt_pk_bf16(r[0], r[1]); w.y = cvt_pk_bf16(r[2], r[3]); w.z = cvt_pk_bf16(r[4], r[5]); w.w = cvt_pk_bf16(r[6], r[7]);
                *(u32x4*)rowp = w; }
    }
};
template <class Epi, class Sched, bool ALIGN_EPI = false, bool SP2 = false>
__device__ __forceinline__ void gemm_phase(PG8_LAS unsigned char* lds, const Gemm g, const Sched& S, const Epi& E, const int tid_in) {
    int tid = tid_in; asm volatile("" : "+v"(tid)); const int wid = __builtin_amdgcn_readfirstlane(tid >> 6), lane = tid & 63, wr = wid >> 2, wc = wid & 3, fr = lane & 15, fq = lane >> 4;
    const int K = g.K, nt = K / BK;
    unsigned voffA[2], voffB[2];
#pragma unroll
    for (int i = 0; i < 2; ++i) { int R, C; stage_rc(tid * 16 + i * 8192, R, C); const int Rb = Epi::PERM ? ((R & ~31) + perm32(R & 31)) : R;
        voffA[i] = (unsigned)(R * K + C) * 2u; voffB[i] = (unsigned)(Rb * K + C) * 2u; }
    const size_t kstep = (size_t)(BK * 2);
    const size_t hstep = (size_t)HALF * K * 2;
    const size_t tstep = 2 * hstep;
    const unsigned ldsw = (unsigned)wid * 1024u;
    const int aoff = lds_byte(wr * 64 + fr, fq * 8), boff = lds_byte(wc * 32 + fr, fq * 8);
#define PG8_SA(b, h) (((b) * 2 + (h)) * HTB)
#define PG8_SB(b, h) ((4 + (b) * 2 + (h)) * HTB)
#define PG8_STAGE(bufoff, gbase, voff) do { _Pragma("unroll") for (int _i = 0; _i < 2; ++_i) \
        __builtin_amdgcn_global_load_lds((const unsigned*)((const char*)(gbase) + (voff)[_i]), (PG8_LAS unsigned*)(lds + (bufoff) + ldsw + _i * 8192), 16, 0, 0); } while (0)
#define PG8_LDA(dst, b, h) do { _Pragma("unroll") for (int m = 0; m < 4; ++m) _Pragma("unroll") for (int k = 0; k < 2; ++k) dst[m][k] = *(const PG8_LAS bf16x8*)(lds + PG8_SA(b, h) + aoff + m * 2048 + k * 1024); } while (0)
#define PG8_LDB(dst, b, h) do { _Pragma("unroll") for (int n = 0; n < 2; ++n) _Pragma("unroll") for (int k = 0; k < 2; ++k) dst[n][k] = *(const PG8_LAS bf16x8*)(lds + PG8_SB(b, h) + boff + n * 2048 + k * 1024); } while (0)
#define PG8_MMA(ai, bj, At, Bt) do { __builtin_amdgcn_s_setprio(1); _Pragma("unroll") for (int m = 0; m < 4; ++m) _Pragma("unroll") for (int n = 0; n < 2; ++n) _Pragma("unroll") for (int k = 0; k < 2; ++k) \
        acc[ai][bj][m][n] = __builtin_amdgcn_mfma_f32_16x16x32_bf16(Bt[n][k], At[m][k], acc[ai][bj][m][n], 0, 0, 0); __builtin_amdgcn_s_setprio(0); } while (0)
#define PG8_WAIT_V(n) asm volatile("s_waitcnt vmcnt(" #n ")" ::: "memory")
#define PG8_WAIT_L(n) asm volatile("s_waitcnt lgkmcnt(" #n ")" ::: "memory")
#define PG8_BAR __builtin_amdgcn_s_barrier()
#define PG8_SCHED __builtin_amdgcn_sched_barrier(0)
    Unit cur, nxt; int ui = 0;
    if (!S.next(0, cur)) return;
    f32x4 acc[2][2][4][2];
#pragma unroll
    for (int a = 0; a < 2; ++a)
#pragma unroll
        for (int b = 0; b < 2; ++b)
#pragma unroll
            for (int m = 0; m < 4; ++m)
#pragma unroll
                for (int n = 0; n < 2; ++n) acc[a][b][m][n] = (f32x4){0.f, 0.f, 0.f, 0.f};
    bf16x8 At[4][2], B0[2][2], B1[2][2];
    const char* cA = (const char*)g.A + (size_t)cur.pm * tstep; const char* cB = (const char*)g.Bt + (size_t)cur.pn * tstep;
    S.a_ready(cur);
    if constexpr (SP2) {
        PG8_STAGE(PG8_SB(0, 0), cB, voffB); PG8_STAGE(PG8_SB(0, 1), cB + hstep, voffB); PG8_STAGE(PG8_SA(0, 0), cA, voffA); PG8_STAGE(PG8_SA(0, 1), cA + hstep, voffA);
        if (wr == 1) PG8_BAR;
        PG8_WAIT_V(2); PG8_BAR;
        PG8_STAGE(PG8_SB(1, 0), cB + kstep, voffB); PG8_STAGE(PG8_SA(1, 0), cA + kstep, voffA); PG8_STAGE(PG8_SB(1, 1), cB + hstep + kstep, voffB);
        PG8_WAIT_V(6); PG8_BAR;
    } else {
        PG8_STAGE(PG8_SB(0, 0), cB, voffB); PG8_STAGE(PG8_SA(0, 0), cA, voffA); PG8_STAGE(PG8_SB(0, 1), cB + hstep, voffB); PG8_STAGE(PG8_SA(0, 1), cA + hstep, voffA);
        if (wr == 1) PG8_BAR;
        PG8_WAIT_V(4); PG8_BAR;
        PG8_STAGE(PG8_SB(1, 0), cB + kstep, voffB); PG8_STAGE(PG8_SA(1, 0), cA + kstep, voffA); PG8_STAGE(PG8_SB(1, 1), cB + hstep + kstep, voffB);
        PG8_WAIT_V(6); PG8_BAR;
    }
    for (;;) {
        float rsv[8]; E.pre(cur, wr, fr, rsv);
        const bool has_next = S.next(ui + 1, nxt);
        const char* nA = has_next ? (const char*)g.A + (size_t)nxt.pm * tstep : cA; const char* nB = has_next ? (const char*)g.Bt + (size_t)nxt.pn * tstep : cB;
        for (int t = 0; t < nt; t += 2) {
            const bool last = (t == nt - 2);
            const char* a1 = cA + (size_t)(t + 1) * kstep;
            const char* a2 = last ? nA : cA + (size_t)(t + 2) * kstep; const char* b2 = last ? nB : cB + (size_t)(t + 2) * kstep;
            const char* a3 = a2 + kstep; const char* b3 = b2 + kstep;
            if (last && has_next) S.a_ready(nxt);
            if constexpr (SP2) {
            PG8_LDB(B0, 0, 0); PG8_LDB(B1, 0, 1); PG8_SCHED; PG8_LDA(At, 0, 0); PG8_STAGE(PG8_SA(1, 1), a1 + hstep, voffA);
            PG8_WAIT_V(8); PG8_WAIT_L(0); PG8_BAR; PG8_MMA(0, 0, At, B0); PG8_MMA(0, 1, At, B1); PG8_BAR; PG8_SCHED;
            PG8_LDA(At, 0, 1); PG8_STAGE(PG8_SB(0, 0), b2, voffB); PG8_STAGE(PG8_SB(0, 1), b2 + hstep, voffB); PG8_STAGE(PG8_SA(0, 0), a2, voffA);
            PG8_WAIT_V(8); PG8_WAIT_L(0); PG8_BAR; PG8_MMA(1, 0, At, B0); PG8_MMA(1, 1, At, B1); PG8_BAR; PG8_SCHED;
            PG8_LDB(B0, 1, 0); PG8_LDB(B1, 1, 1); PG8_SCHED; PG8_LDA(At, 1, 0); PG8_STAGE(PG8_SA(0, 1), a2 + hstep, voffA);
            PG8_WAIT_V(8); PG8_WAIT_L(0); PG8_BAR; PG8_MMA(0, 0, At, B0); PG8_MMA(0, 1, At, B1); PG8_BAR; PG8_SCHED;
            PG8_LDA(At, 1, 1); PG8_STAGE(PG8_SB(1, 0), b3, voffB); PG8_STAGE(PG8_SB(1, 1), b3 + hstep, voffB); PG8_STAGE(PG8_SA(1, 0), a3, voffA);
            PG8_WAIT_V(8); PG8_WAIT_L(0); PG8_BAR; PG8_MMA(1, 0, At, B0); PG8_MMA(1, 1, At, B1); PG8_BAR; PG8_SCHED;
            } else {
            PG8_LDB(B0, 0, 0); PG8_SCHED; PG8_LDA(At, 0, 0); PG8_STAGE(PG8_SA(1, 1), a1 + hstep, voffA);
            PG8_WAIT_L(8); PG8_BAR; PG8_WAIT_L(0); PG8_MMA(0, 0, At, B0); PG8_BAR; PG8_SCHED;
            PG8_LDB(B1, 0, 1); PG8_STAGE(PG8_SB(0, 0), b2, voffB);
            PG8_BAR; PG8_WAIT_L(0); PG8_MMA(0, 1, At, B1); PG8_BAR;
            PG8_LDA(At, 0, 1); PG8_STAGE(PG8_SA(0, 0), a2, voffA);
            PG8_BAR; PG8_WAIT_L(0); PG8_MMA(1, 0, At, B0); PG8_BAR; PG8_SCHED;
            PG8_STAGE(PG8_SB(0, 1), b2 + hstep, voffB);
            PG8_WAIT_V(6); PG8_BAR; PG8_MMA(1, 1, At, B1); PG8_BAR;
            PG8_LDB(B0, 1, 0); PG8_SCHED; PG8_LDA(At, 1, 0); PG8_STAGE(PG8_SA(0, 1), a2 + hstep, voffA);
            PG8_WAIT_L(8); PG8_BAR; PG8_WAIT_L(0); PG8_MMA(0, 0, At, B0); PG8_BAR; PG8_SCHED;
            PG8_LDB(B1, 1, 1); PG8_STAGE(PG8_SB(1, 0), b3, voffB);
            PG8_BAR; PG8_WAIT_L(0); PG8_MMA(0, 1, At, B1); PG8_BAR;
            PG8_LDA(At, 1, 1); PG8_STAGE(PG8_SA(1, 0), a3, voffA);
            PG8_BAR; PG8_WAIT_L(0); PG8_MMA(1, 0, At, B0); PG8_BAR; PG8_SCHED;
            PG8_STAGE(PG8_SB(1, 1), b3 + hstep, voffB);
            PG8_WAIT_V(6); PG8_BAR; PG8_MMA(1, 1, At, B1); PG8_BAR;
            }
        }
        if constexpr (ALIGN_EPI) { if (wr == 0) PG8_BAR; }
        if constexpr (!Epi::AFTER_DRAIN) { E(acc, cur, wr, wc, fr, fq, rsv); S.done(cur); }
        if (!has_next) break;
#pragma unroll
        for (int a = 0; a < 2; ++a)
#pragma unroll
            for (int b = 0; b < 2; ++b)
#pragma unroll
                for (int m = 0; m < 4; ++m)
#pragma unroll
                    for (int n = 0; n < 2; ++n) acc[a][b][m][n] = (f32x4){0.f, 0.f, 0.f, 0.f};
        cur = nxt; cA = nA; cB = nB; ++ui;
        if constexpr (ALIGN_EPI) { if (wr == 1) PG8_BAR; }
    }
    PG8_WAIT_V(0);
    if constexpr (!ALIGN_EPI) { if (wr == 0) PG8_BAR; }
    PG8_BAR;
    if constexpr (Epi::AFTER_DRAIN) { E.fused(acc, cur, wr, wc, fr, fq, lds, wid, lane); S.done(cur); }
#undef PG8_SA
#undef PG8_SB
#undef PG8_STAGE
#undef PG8_LDA
#undef PG8_LDB
#undef PG8_MMA
#undef PG8_WAIT_V
#undef PG8_WAIT_L
#undef PG8_BAR
#undef PG8_SCHED
}
}

#ifndef PG8_SP2
#define PG8_SP2 true
#endif
#ifndef PG8_ALIGN
#define PG8_ALIGN true
#endif
#include <hip/hip_bf16.h>
#include <cmath>
namespace attn_body {
using bf16=__hip_bfloat16;
using bf16x8=__attribute__((ext_vector_type(8)))short;
using s16x4=__attribute__((ext_vector_type(4)))short;
using f32x16=__attribute__((ext_vector_type(16)))float;
using u32x4=__attribute__((ext_vector_type(4)))unsigned;
constexpr int BATCH=4,SEQ=8192,D=64,DMI=3072,DMO=1024;
constexpr int NW=8,QBLK=32,QB=QBLK*NW,KVBLK=64,NQB=SEQ/QB;
constexpr int ATTN_UNIT_ROWS=QB;
__device__ __forceinline__ int crow(int r,int hi){return (r&3)+8*(r>>2)+4*hi;}
#define SBAR() __builtin_amdgcn_sched_barrier(0)
__device__ __forceinline__ void cmask(f32x16&p0,f32x16&p1,int jb,int qrel,int hi){
  const float NEG=-INFINITY; int kb=64*jb+4*hi;
  #pragma unroll
  for(int r=0;r<16;++r){int kv=kb+(r&3)+8*(r>>2); if(kv>qrel)p0[r]=NEG; if(kv+32>qrel)p1[r]=NEG;}
}

constexpr int NSLOT=3, SLOTB=8192;
constexpr int LDS_K=0, LDS_V=NSLOT*SLOTB, LDS_WS=2*NSLOT*SLOTB, LDS_OST=LDS_WS+NW*64*4, LDS_BIAS=LDS_OST+NW*4096, LDS_BYTES=LDS_BIAS+SEQ*4;
constexpr float C2=0.125f*1.4426950408889634f;
__device__ __forceinline__ void glds16(const void*gsrc,unsigned lds_dst){unsigned keep;
  asm volatile("s_mov_b32 %0, m0\n\ts_mov_b32 m0, %2\n\ts_nop 0\n\tglobal_load_lds_dwordx4 %1, off\n\ts_mov_b32 m0, %0":"=&s"(keep):"v"(gsrc),"s"(lds_dst):"memory");}
__device__ __forceinline__ float max3f(float a,float b,float c){float r;asm("v_max3_f32 %0, %1, %2, %3":"=v"(r):"v"(a),"v"(b),"v"(c));return r;}
__device__ __forceinline__ float max2f(float a,float b){float r;asm("v_max_f32_e32 %0, %1, %2":"=v"(r):"v"(a),"v"(b));return r;}
__device__ __forceinline__ float fadd_s(float a,float b){float r;asm("v_add_f32_e32 %0, %1, %2":"=v"(r):"v"(a),"v"(b));return r;}
__device__ __forceinline__ float fsub_s(float a,float b){float r;asm("v_sub_f32_e32 %0, %1, %2":"=v"(r):"v"(a),"v"(b));return r;}
typedef float f32x2_t __attribute__((ext_vector_type(2))); typedef __bf16 bf16x2_t __attribute__((ext_vector_type(2)));
__device__ __forceinline__ unsigned cvtpk_s(float lo,float hi){f32x2_t v={lo,hi};bf16x2_t b=__builtin_convertvector(v,bf16x2_t);return __builtin_bit_cast(unsigned,b);}
#define WAIT_BAR(N) asm volatile("s_waitcnt vmcnt(" #N ") lgkmcnt(0)\n\ts_barrier":::"memory")

__device__ __forceinline__ void qkt(f32x16&p0,f32x16&p1,const char*Kslot,const bf16x8*qr,const f32x16&negm,int r32,int hi){
  const char*kb=Kslot+hi*1024+r32*16;
  #pragma unroll
  for(int d0=0;d0<4;++d0){
    const bf16x8 b0=*reinterpret_cast<const bf16x8*>(kb+d0*2048);
    const bf16x8 b1=*reinterpret_cast<const bf16x8*>(kb+d0*2048+512);
    if(d0==0){p0=__builtin_amdgcn_mfma_f32_32x32x16_bf16(b0,qr[0],negm,0,0,0);p1=__builtin_amdgcn_mfma_f32_32x32x16_bf16(b1,qr[0],negm,0,0,0);}
    else{p0=__builtin_amdgcn_mfma_f32_32x32x16_bf16(b0,qr[d0],p0,0,0,0);p1=__builtin_amdgcn_mfma_f32_32x32x16_bf16(b1,qr[d0],p1,0,0,0);}}
}
typedef __attribute__((address_space(3))) const char* lds_cptr;
typedef short v4i16_t __attribute__((ext_vector_type(4)));
__device__ __forceinline__ void kload8(bf16x8*kf,lds_cptr kp){
  kf[0]=*(const __attribute__((address_space(3))) bf16x8*)(kp);      kf[1]=*(const __attribute__((address_space(3))) bf16x8*)(kp+512);
  kf[2]=*(const __attribute__((address_space(3))) bf16x8*)(kp+2048); kf[3]=*(const __attribute__((address_space(3))) bf16x8*)(kp+2560);
  kf[4]=*(const __attribute__((address_space(3))) bf16x8*)(kp+4096); kf[5]=*(const __attribute__((address_space(3))) bf16x8*)(kp+4608);
  kf[6]=*(const __attribute__((address_space(3))) bf16x8*)(kp+6144); kf[7]=*(const __attribute__((address_space(3))) bf16x8*)(kp+6656);
}
__device__ __forceinline__ void kload2(bf16x8*kf,lds_cptr kp,int j){ kf[2*j]=*(const __attribute__((address_space(3))) bf16x8*)(kp+j*2048); kf[2*j+1]=*(const __attribute__((address_space(3))) bf16x8*)(kp+j*2048+512); }
__device__ __forceinline__ s16x4 vtr(lds_cptr p){ return __builtin_bit_cast(s16x4,__builtin_amdgcn_ds_read_tr16_b64_v4i16((__attribute__((address_space(3))) v4i16_t*)p)); }
__device__ __forceinline__ float rowmax(const f32x16&p0,const f32x16&p1){
  float a=max3f(p0[0],p0[1],p1[0]),b=max3f(p0[2],p0[3],p1[1]);a=max3f(a,p1[2],p1[3]);
  #pragma unroll
  for(int r=4;r<16;r+=4){a=max3f(a,p0[r],p0[r+1]);b=max3f(b,p0[r+2],p0[r+3]);a=max3f(a,p1[r],p1[r+1]);b=max3f(b,p1[r+2],p1[r+3]);}
  const float m=max2f(a,b);
  auto rr=__builtin_amdgcn_permlane32_swap(__float_as_uint(m),__float_as_uint(m),false,false);
  return max2f(__uint_as_float(rr[0]),__uint_as_float(rr[1]));
}
__device__ __forceinline__ void pv(f32x16*o,int vb,bf16x8 pa0,bf16x8 pa1,bf16x8 pa2,bf16x8 pa3){
  #pragma unroll
  for(int d0=0;d0<2;++d0){s16x4 lo[4],hi[4];
    #pragma unroll
    for(int ks=0;ks<4;++ks){
      asm volatile("ds_read_b64_tr_b16 %0,%1 offset:%c2":"=&v"(lo[ks]):"v"(vb),"i"(d0*4096+ks*1024):"memory");
      asm volatile("ds_read_b64_tr_b16 %0,%1 offset:%c2":"=&v"(hi[ks]):"v"(vb),"i"(d0*4096+ks*1024+512):"memory");}
    asm volatile("s_waitcnt lgkmcnt(0)":::"memory");SBAR();
    #define PK(k) (bf16x8){lo[k][0],lo[k][1],lo[k][2],lo[k][3],hi[k][0],hi[k][1],hi[k][2],hi[k][3]}
    o[d0]=__builtin_amdgcn_mfma_f32_32x32x16_bf16(pa0,PK(0),o[d0],0,0,0);
    o[d0]=__builtin_amdgcn_mfma_f32_32x32x16_bf16(pa1,PK(1),o[d0],0,0,0);
    o[d0]=__builtin_amdgcn_mfma_f32_32x32x16_bf16(pa2,PK(2),o[d0],0,0,0);
    o[d0]=__builtin_amdgcn_mfma_f32_32x32x16_bf16(pa3,PK(3),o[d0],0,0,0);
    #undef PK
  }
}

#ifndef ATTN_STORE16
#define ATTN_STORE16(p,v) (*(u32x4*)(p)=(v))
#endif
template<int THRL,bool BIAS> __device__ __forceinline__ void attn_unit(int b,int qb,const bf16*Q,const bf16*__restrict__ K,const bf16*__restrict__ V,bf16*O,const float*__restrict__ biasg,char*shm,const int tid_in){
  int tid=tid_in; asm volatile("":"+v"(tid)); const int lane=tid&63,r32=lane&31,hi=lane>>5; const int wid=__builtin_amdgcn_readfirstlane(tid>>6);
  const long rowbase=(long)b*SEQ; const int q0=qb*QB;
  const bf16*Qw=Q+(rowbase+q0+wid*QBLK)*DMI;
  int t0=0;
  if(BIAS){ const int NT0=(q0+QB)/KVBLK; const float bq=biasg[q0]; int cnt=0;
    _Pragma("unroll") for(int h2=0;h2<2;++h2){ const int T=lane+64*h2; const bool sk=(T<NT0-4)&&(biasg[64*(T<NT0?T:0)+63]-bq<-64.f); cnt+=__popcll(__ballot(sk)); }
    t0=__builtin_amdgcn_readfirstlane(cnt)&~1; }
  const float*bg=BIAS?biasg+t0*KVBLK:biasg;
  const bf16*Kh=K+(rowbase+t0*KVBLK)*DMI,*Vh=V+(rowbase+t0*KVBLK)*DMI;
  const unsigned lds0=(unsigned)(uintptr_t)shm;
  float*wsf=(float*)(shm+LDS_WS)+wid*64;
  const bf16*ksrc=Kh+(long)lane*DMI+wid*8;
  const bf16*vsrc=Vh+(long)(16*(wid&3)+(lane>>2))*DMI+(wid>>2)*32+(lane&3)*8;
  const unsigned kdst=lds0+LDS_K+wid*1024, vdst=lds0+LDS_V+wid*1024;
  #define DMA_K(t,slot) glds16(ksrc+(long)(t)*KVBLK*DMI,(unsigned)__builtin_amdgcn_readfirstlane(kdst+(slot)))
  #define DMA_V(t,slot) glds16(vsrc+(long)(t)*KVBLK*DMI,(unsigned)__builtin_amdgcn_readfirstlane(vdst+(slot)))
  const int vb0=(int)(lds0+LDS_V)+((lane>>4)&1)*32+(lane&3)*8+(4*hi+((lane&15)>>2))*64;
  const char*Kbase=shm+LDS_K; bf16x8 kf[8];
  const lds_cptr shm3=(lds_cptr)shm; const lds_cptr kp0=shm3+LDS_K+hi*1024+r32*16; const lds_cptr vp0=shm3+LDS_V+((lane>>4)&1)*32+(lane&3)*8+(4*hi+((lane&15)>>2))*64;
  const int NT=(q0+QB)/KVBLK-t0;
  typedef __attribute__((address_space(3))) const float* lds_fptr; typedef float f32x4_t __attribute__((ext_vector_type(4)));
  const lds_fptr biasl=(lds_fptr)(shm3+LDS_BIAS)+4*hi;
  if(BIAS){ __attribute__((address_space(3))) float* bw=(__attribute__((address_space(3))) float*)(shm3+LDS_BIAS); const int nb=NT*KVBLK;
    for(int i=tid*4;i<nb;i+=NW*64*4)*(__attribute__((address_space(3))) f32x4_t*)(bw+i)=*(const f32x4_t*)(bg+i); }
  #define BIASADD(P0,P1,t) do{ if(BIAS){ const lds_fptr bp_=biasl+KVBLK*(t); _Pragma("unroll") for(int i_=0;i_<4;++i_){ \
      const f32x4_t b0_=*(const __attribute__((address_space(3))) f32x4_t*)(bp_+8*i_), b1_=*(const __attribute__((address_space(3))) f32x4_t*)(bp_+32+8*i_); \
      _Pragma("unroll") for(int j_=0;j_<4;++j_){ P0[4*i_+j_]+=b0_[j_]; P1[4*i_+j_]+=b1_[j_]; } } } }while(0)
  DMA_K(0,0);DMA_V(0,0);DMA_K(1,SLOTB);
  bf16x8 qr[4];
  #pragma unroll
  for(int d0=0;d0<4;++d0)qr[d0]=*reinterpret_cast<const bf16x8*>(&Qw[(long)r32*DMI+d0*16+hi*8]);
  float mhat=0.f,l_reg=0.f;f32x16 o[2];o[0]=f32x16{};o[1]=f32x16{};f32x16 negm=f32x16{};asm volatile("":"+v"(negm));
  const int qrel=wid*QBLK+r32;
  #define CMASK(P0,P1,t) do{int jb_=(t)-(NT-4); if(jb_>=0)cmask(P0,P1,jb_,qrel,hi);}while(0)
  bool resc=false;
  #define START(P0,P1) do{ const float rm=rowmax(P0,P1); resc=false; \
    { const float dl=rm; mhat=fadd_s(mhat,dl); \
      _Pragma("unroll") for(int r=0;r<16;++r){P0[r]=fsub_s(P0[r],dl);P1[r]=fsub_s(P1[r],dl);} \
      _Pragma("unroll") for(int r=0;r<16;++r)negm[r]=-mhat; asm volatile("":"+v"(negm)); } \
    _Pragma("unroll") for(int r=0;r<16;++r)P0[r]=__builtin_amdgcn_exp2f(P0[r]); }while(0)
  #define RESC() do{ if(resc){ asm volatile("s_waitcnt lgkmcnt(0)":::"memory"); \
      _Pragma("unroll") for(int d_=0;d_<2;++d_) _Pragma("unroll") for(int r=0;r<16;++r)o[d_][r]*=wsf[crow(r,hi)]; } }while(0)
  f32x16 pA0,pA1,pB0,pB1;
  int sl_prev=0,sl_cur=0,sl_next=SLOTB;
  #define ROT() do{sl_prev=sl_cur;sl_cur=sl_next;sl_next=(sl_next==(NSLOT-1)*SLOTB)?0:sl_next+SLOTB;}while(0)
  DMA_K(2,2*SLOTB);
  WAIT_BAR(3);
  qkt(pA0,pA1,Kbase,qr,negm,r32,hi);asm volatile("s_nop 15\n\ts_nop 7":"+v"(pA0),"+v"(pA1));BIASADD(pA0,pA1,0);CMASK(pA0,pA1,0);
  START(pA0,pA1);
  _Pragma("unroll") for(int r=0;r<16;++r)pA1[r]=__builtin_amdgcn_exp2f(pA1[r]);
  WAIT_BAR(0);
  DMA_K(3,0);DMA_V(1,SLOTB);
  ROT();
  kload8(kf,kp0+sl_cur);
  WAIT_BAR(2);
  s16x4 vlo[8],vhi[8]; u32x4 pw0,pw1,pw2,pw3;
  #define PKW(P,B) cvtpk_s(P[B],P[B+1])
  #define PAF(k) __builtin_bit_cast(bf16x8,pw##k)
  #define VFR(i) (bf16x8){vlo[i][0],vlo[i][1],vlo[i][2],vlo[i][3],vhi[i][0],vhi[i][1],vhi[i][2],vhi[i][3]}
  #define PIN(x) asm volatile("":"+v"(x))
  #define MX3(a,b,c) __builtin_fmaxf(__builtin_fmaxf((a),(b)),(c))
  #define GAPA(MF,A0,A1,A2,A3,W0,W1,PW) do{ MF; sacc+=A0; sacc+=A1; sacc+=A2; sacc+=A3; PIN(sacc); W0; W1; PIN(PW); SBAR(); }while(0)
  #define EX(v) __builtin_amdgcn_exp2f(v)
  #define GAPB(MF,X,B) do{ MF; X[B]=EX(X[B]); X[B+1]=EX(X[B+1]); X[B+2]=EX(X[B+2]); X[B+3]=EX(X[B+3]); PIN(X); SBAR(); }while(0)
  #define VRD(i) do{ vlo[i]=vtr(vp_+(((i)>>2)*4096+((i)&3)*1024)); vhi[i]=vtr(vp_+(((i)>>2)*4096+((i)&3)*1024+512)); }while(0)
  #define KRD(G,j) do{ if(G){ kload2(kf,kp0+sl_next,j); SBAR(); } }while(0)
  #define STEP(C0,C1,P0,P1,t,GK,GV,GL) do{ SBAR(); \
    const lds_cptr vp_=vp0+sl_prev; \
    VRD(0); SBAR(); float sacc=(P0[0]+P0[1]); \
    GAPA(C0=__builtin_amdgcn_mfma_f32_32x32x16_bf16(kf[0],qr[0],negm,0,0,0), P0[2],P0[3],P0[4],P0[5],     pw0[0]=PKW(P0,0), pw0[1]=PKW(P0,2), pw0); \
    VRD(4); SBAR(); GAPA(C1=__builtin_amdgcn_mfma_f32_32x32x16_bf16(kf[1],qr[0],negm,0,0,0), P0[6],P0[7],P0[8],P0[9],     pw0[2]=PKW(P0,4), pw0[3]=PKW(P0,6), pw0); \
    VRD(1); SBAR(); GAPA(C0=__builtin_amdgcn_mfma_f32_32x32x16_bf16(kf[2],qr[1],C0,0,0,0),   P0[10],P0[11],P0[12],P0[13], pw1[0]=PKW(P0,8), pw1[1]=PKW(P0,10), pw1); \
    VRD(5); SBAR(); GAPA(C1=__builtin_amdgcn_mfma_f32_32x32x16_bf16(kf[3],qr[1],C1,0,0,0),   P0[14],P0[15],P1[0],P1[1],   pw1[2]=PKW(P0,12),pw1[3]=PKW(P0,14), pw1); \
    VRD(2); SBAR(); GAPA(C0=__builtin_amdgcn_mfma_f32_32x32x16_bf16(kf[4],qr[2],C0,0,0,0),   P1[2],P1[3],P1[4],P1[5],     pw2[0]=PKW(P1,0), pw2[1]=PKW(P1,2), pw2); \
    VRD(6); SBAR(); GAPA(C1=__builtin_amdgcn_mfma_f32_32x32x16_bf16(kf[5],qr[2],C1,0,0,0),   P1[6],P1[7],P1[8],P1[9],     pw2[2]=PKW(P1,4), pw2[3]=PKW(P1,6), pw2); \
    VRD(3); SBAR(); GAPA(C0=__builtin_amdgcn_mfma_f32_32x32x16_bf16(kf[6],qr[3],C0,0,0,0),   P1[10],P1[11],P1[12],P1[13], pw3[0]=PKW(P1,8), pw3[1]=PKW(P1,10), pw3); \
    VRD(7); SBAR(); GAPA(C1=__builtin_amdgcn_mfma_f32_32x32x16_bf16(kf[7],qr[3],C1,0,0,0),   P1[14],P1[15],0.f,0.f,       pw3[2]=PKW(P1,12),pw3[3]=PKW(P1,14), pw3); \
    l_reg+=sacc; \
    if(GK){DMA_K((t)+3,sl_cur);} if(GV){DMA_V((t)+1,sl_next);} \
    BIASADD(C0,C1,t); CMASK(C0,C1,t); \
    { float a=MX3(C0[0],C0[1],C1[0]),b=MX3(C0[2],C0[3],C1[1]); a=MX3(a,C1[2],C1[3]); \
      _Pragma("unroll") for(int r=4;r<16;r+=4){a=MX3(a,C0[r],C0[r+1]);b=MX3(b,C0[r+2],C0[r+3]);a=MX3(a,C1[r],C1[r+1]);b=MX3(b,C1[r+2],C1[r+3]);} \
      float rm=__builtin_fmaxf(a,b); { auto rr=__builtin_amdgcn_permlane32_swap(__float_as_uint(rm),__float_as_uint(rm),false,false); rm=__builtin_fmaxf(__uint_as_float(rr[0]),__uint_as_float(rr[1])); } \
      resc=false; \
      if(__builtin_expect(__any(rm>(float)THRL),0)){ const float dl=__builtin_fmaxf(rm,0.f); mhat+=dl; \
        _Pragma("unroll") for(int r=0;r<16;++r){C0[r]-=dl;C1[r]-=dl;} \
        _Pragma("unroll") for(int r=0;r<16;++r)negm[r]=-mhat; asm volatile("":"+v"(negm)); \
        const float f=__builtin_amdgcn_exp2f(-dl); l_reg*=f; if(hi==0)wsf[r32]=f; resc=true; } } \
    SBAR(); \
    GAPB(o[0]=__builtin_amdgcn_mfma_f32_32x32x16_bf16(PAF(0),VFR(0),o[0],0,0,0), C0,0); \
    GAPB(o[1]=__builtin_amdgcn_mfma_f32_32x32x16_bf16(PAF(0),VFR(4),o[1],0,0,0), C0,4); \
    KRD(GL,0); GAPB(o[0]=__builtin_amdgcn_mfma_f32_32x32x16_bf16(PAF(1),VFR(1),o[0],0,0,0), C0,8); \
    KRD(GL,1); GAPB(o[1]=__builtin_amdgcn_mfma_f32_32x32x16_bf16(PAF(1),VFR(5),o[1],0,0,0), C0,12); \
    KRD(GL,2); GAPB(o[0]=__builtin_amdgcn_mfma_f32_32x32x16_bf16(PAF(2),VFR(2),o[0],0,0,0), C1,0); \
    KRD(GL,3); GAPB(o[1]=__builtin_amdgcn_mfma_f32_32x32x16_bf16(PAF(2),VFR(6),o[1],0,0,0), C1,4); \
    GAPB(o[0]=__builtin_amdgcn_mfma_f32_32x32x16_bf16(PAF(3),VFR(3),o[0],0,0,0), C1,8); \
    GAPB(o[1]=__builtin_amdgcn_mfma_f32_32x32x16_bf16(PAF(3),VFR(7),o[1],0,0,0), C1,12); \
    }while(0)
  int t=1;
  #undef CMASK
  #define CMASK(P0,P1,t) do{}while(0)
  for(;t+5<NT;t+=2){
    STEP(pB0,pB1,pA0,pA1,t,true,true,true);     WAIT_BAR(2); RESC(); ROT();
    STEP(pA0,pA1,pB0,pB1,t+1,true,true,true);   WAIT_BAR(2); RESC(); ROT();
  }
  #undef CMASK
  #define CMASK(P0,P1,t) do{int jb_=(t)-(NT-4); if(jb_>=0)cmask(P0,P1,jb_,qrel,hi);}while(0)
  #define ENDW(tt) do{ if((tt)+3<NT){WAIT_BAR(2);} else if((tt)+2<NT){WAIT_BAR(1);} else {WAIT_BAR(0);} }while(0)
  for(;t+1<NT;t+=2){
    STEP(pB0,pB1,pA0,pA1,t,(t+3<NT),(t+1<NT),(t+1<NT));       ENDW(t);   RESC(); ROT();
    STEP(pA0,pA1,pB0,pB1,t+1,(t+4<NT),(t+2<NT),(t+2<NT));     ENDW(t+1); RESC(); ROT();
  }
  STEP(pB0,pB1,pA0,pA1,NT-1,false,false,false); RESC();
  { float sacc=pB0[0]+pB0[1]; _Pragma("unroll") for(int r=2;r<16;++r)sacc+=pB0[r]; _Pragma("unroll") for(int r=0;r<16;++r)sacc+=pB1[r]; l_reg+=sacc;
    pw0=(u32x4){PKW(pB0,0),PKW(pB0,2),PKW(pB0,4),PKW(pB0,6)};pw1=(u32x4){PKW(pB0,8),PKW(pB0,10),PKW(pB0,12),PKW(pB0,14)};pw2=(u32x4){PKW(pB1,0),PKW(pB1,2),PKW(pB1,4),PKW(pB1,6)};pw3=(u32x4){PKW(pB1,8),PKW(pB1,10),PKW(pB1,12),PKW(pB1,14)};
    SBAR(); pv(o,vb0+sl_cur,PAF(0),PAF(1),PAF(2),PAF(3)); }
  #undef PKW
  #undef PAF
  #undef VFR
  #undef PIN
  #undef MX3
  #undef GAPA
  #undef GAPB
  #undef EX
  #undef VRD
  #undef KRD
  #undef STEP
  #undef ENDW
  {auto rr=__builtin_amdgcn_permlane32_swap(__float_as_uint(l_reg),__float_as_uint(l_reg),false,false);l_reg=__uint_as_float(rr[0])+__uint_as_float(rr[1]);}
  if(hi==0)wsf[32+r32]=l_reg;asm volatile("s_waitcnt lgkmcnt(0)":::"memory");
  float rli[16];
  #pragma unroll
  for(int r=0;r<16;++r)rli[r]=__builtin_amdgcn_rcpf(wsf[32+crow(r,hi)]);
  bf16*Ow=O+(rowbase+q0+wid*QBLK)*DMO;
  { bf16*stg=(bf16*)(shm+LDS_OST)+wid*2048;
    #pragma unroll
    for(int r=0;r<16;++r){const int orow=crow(r,hi);
      #pragma unroll
      for(int d0=0;d0<2;++d0)stg[orow*64+d0*32+r32]=__float2bfloat16(o[d0][r]*rli[r]);}
    asm volatile("s_waitcnt lgkmcnt(0)":::"memory");
    #pragma unroll
    for(int i=0;i<4;++i){const int row=i*8+(lane>>3),ch=lane&7; const u32x4 v=*(const u32x4*)(stg+row*64+ch*8); ATTN_STORE16(Ow+(long)row*DMO+ch*8,v);} }
  asm volatile("s_waitcnt lgkmcnt(0)\n\ts_barrier":::"memory");
  #undef BIASADD
  #undef DMA_K
  #undef DMA_V
  #undef CMASK
  #undef START
  #undef RESC
  #undef ROT
}
constexpr int ATTN_LDS_BYTES=LDS_BYTES;
#undef SBAR
#undef WAIT_BAR
}
#include <hip/hip_bf16.h>
#include <cmath>
namespace attn128 {
using bf16=__hip_bfloat16;
using bf16x8=__attribute__((ext_vector_type(8)))short;
using s16x4=__attribute__((ext_vector_type(4)))short;
using f32x16=__attribute__((ext_vector_type(16)))float;
using u32x4=__attribute__((ext_vector_type(4)))unsigned;
constexpr int BATCH=4,SEQ=8192,D=64,DMI=3072,DMO=1024;
constexpr int NW=8,QBLK=32,QB=QBLK*NW,KVBLK=64,NQB=SEQ/QB;
constexpr int ATTN_UNIT_ROWS=QB;
__device__ __forceinline__ int crow(int r,int hi){return (r&3)+8*(r>>2)+4*hi;}
#define SBAR() __builtin_amdgcn_sched_barrier(0)
__device__ __forceinline__ void cmask(f32x16&p0,f32x16&p1,int jb,int qrel,int hi){
  const float NEG=-INFINITY; int kb=64*jb+4*hi;
  #pragma unroll
  for(int r=0;r<16;++r){int kv=kb+(r&3)+8*(r>>2); if(kv>qrel)p0[r]=NEG; if(kv+32>qrel)p1[r]=NEG;}
}

constexpr int NSLOT=3, SLOTB=8192;
constexpr int VSLOTB=2*SLOTB; constexpr int LDS_K=0, LDS_V=NSLOT*SLOTB, LDS_WS=LDS_V+NSLOT*VSLOTB, LDS_OST=LDS_WS+NW*64*4, LDS_BIAS=LDS_OST+NW*4096, LDS_BYTES=LDS_BIAS;
constexpr float C2=0.125f*1.4426950408889634f;
__device__ __forceinline__ void glds16(const void*gsrc,unsigned lds_dst){unsigned keep;
  asm volatile("s_mov_b32 %0, m0\n\ts_mov_b32 m0, %2\n\ts_nop 0\n\tglobal_load_lds_dwordx4 %1, off\n\ts_mov_b32 m0, %0":"=&s"(keep):"v"(gsrc),"s"(lds_dst):"memory");}
__device__ __forceinline__ float max3f(float a,float b,float c){float r;asm("v_max3_f32 %0, %1, %2, %3":"=v"(r):"v"(a),"v"(b),"v"(c));return r;}
__device__ __forceinline__ float max2f(float a,float b){float r;asm("v_max_f32_e32 %0, %1, %2":"=v"(r):"v"(a),"v"(b));return r;}
__device__ __forceinline__ float fadd_s(float a,float b){float r;asm("v_add_f32_e32 %0, %1, %2":"=v"(r):"v"(a),"v"(b));return r;}
__device__ __forceinline__ float fsub_s(float a,float b){float r;asm("v_sub_f32_e32 %0, %1, %2":"=v"(r):"v"(a),"v"(b));return r;}
typedef float f32x2_t __attribute__((ext_vector_type(2))); typedef __bf16 bf16x2_t __attribute__((ext_vector_type(2)));
__device__ __forceinline__ unsigned cvtpk_s(float lo,float hi){f32x2_t v={lo,hi};bf16x2_t b=__builtin_convertvector(v,bf16x2_t);return __builtin_bit_cast(unsigned,b);}
#define WAIT_BAR(N) asm volatile("s_waitcnt vmcnt(" #N ") lgkmcnt(0)\n\ts_barrier":::"memory")

__device__ __forceinline__ void qkt(f32x16&p0,f32x16&p1,const char*Kslot,const bf16x8*qr,const f32x16&negm,int r32,int hi){
  const char*kb=Kslot+hi*1024+r32*16;
  #pragma unroll
  for(int d0=0;d0<4;++d0){
    const bf16x8 b0=*reinterpret_cast<const bf16x8*>(kb+d0*2048);
    const bf16x8 b1=*reinterpret_cast<const bf16x8*>(kb+d0*2048+512);
    if(d0==0){p0=__builtin_amdgcn_mfma_f32_32x32x16_bf16(b0,qr[0],negm,0,0,0);p1=__builtin_amdgcn_mfma_f32_32x32x16_bf16(b1,qr[0],negm,0,0,0);}
    else{p0=__builtin_amdgcn_mfma_f32_32x32x16_bf16(b0,qr[d0],p0,0,0,0);p1=__builtin_amdgcn_mfma_f32_32x32x16_bf16(b1,qr[d0],p1,0,0,0);}}
}
typedef __attribute__((address_space(3))) const char* lds_cptr;
typedef short v4i16_t __attribute__((ext_vector_type(4)));
__device__ __forceinline__ void kload8(bf16x8*kf,lds_cptr kp){
  kf[0]=*(const __attribute__((address_space(3))) bf16x8*)(kp);      kf[1]=*(const __attribute__((address_space(3))) bf16x8*)(kp+512);
  kf[2]=*(const __attribute__((address_space(3))) bf16x8*)(kp+2048); kf[3]=*(const __attribute__((address_space(3))) bf16x8*)(kp+2560);
  kf[4]=*(const __attribute__((address_space(3))) bf16x8*)(kp+4096); kf[5]=*(const __attribute__((address_space(3))) bf16x8*)(kp+4608);
  kf[6]=*(const __attribute__((address_space(3))) bf16x8*)(kp+6144); kf[7]=*(const __attribute__((address_space(3))) bf16x8*)(kp+6656);
}
__device__ __forceinline__ void kload2(bf16x8*kf,lds_cptr kp,int j){ kf[2*j]=*(const __attribute__((address_space(3))) bf16x8*)(kp+j*2048); kf[2*j+1]=*(const __attribute__((address_space(3))) bf16x8*)(kp+j*2048+512); }
__device__ __forceinline__ s16x4 vtr(lds_cptr p){ return __builtin_bit_cast(s16x4,__builtin_amdgcn_ds_read_tr16_b64_v4i16((__attribute__((address_space(3))) v4i16_t*)p)); }
__device__ __forceinline__ float rowmax(const f32x16&p0,const f32x16&p1){
  float a=max3f(p0[0],p0[1],p1[0]),b=max3f(p0[2],p0[3],p1[1]);a=max3f(a,p1[2],p1[3]);
  #pragma unroll
  for(int r=4;r<16;r+=4){a=max3f(a,p0[r],p0[r+1]);b=max3f(b,p0[r+2],p0[r+3]);a=max3f(a,p1[r],p1[r+1]);b=max3f(b,p1[r+2],p1[r+3]);}
  const float m=max2f(a,b);
  auto rr=__builtin_amdgcn_permlane32_swap(__float_as_uint(m),__float_as_uint(m),false,false);
  return max2f(__uint_as_float(rr[0]),__uint_as_float(rr[1]));
}
__device__ __forceinline__ void pv(f32x16*o,int vb,bf16x8 pa0,bf16x8 pa1,bf16x8 pa2,bf16x8 pa3){
  #pragma unroll
  for(int d0=0;d0<2;++d0){s16x4 lo[4],hi[4];
    #pragma unroll
    for(int ks=0;ks<4;++ks){
      asm volatile("ds_read_b64_tr_b16 %0,%1 offset:%c2":"=&v"(lo[ks]):"v"(vb),"i"(d0*4096+ks*1024):"memory");
      asm volatile("ds_read_b64_tr_b16 %0,%1 offset:%c2":"=&v"(hi[ks]):"v"(vb),"i"(d0*4096+ks*1024+512):"memory");}
    asm volatile("s_waitcnt lgkmcnt(0)":::"memory");SBAR();
    #define PK(k) (bf16x8){lo[k][0],lo[k][1],lo[k][2],lo[k][3],hi[k][0],hi[k][1],hi[k][2],hi[k][3]}
    o[d0]=__builtin_amdgcn_mfma_f32_32x32x16_bf16(pa0,PK(0),o[d0],0,0,0);
    o[d0]=__builtin_amdgcn_mfma_f32_32x32x16_bf16(pa1,PK(1),o[d0],0,0,0);
    o[d0]=__builtin_amdgcn_mfma_f32_32x32x16_bf16(pa2,PK(2),o[d0],0,0,0);
    o[d0]=__builtin_amdgcn_mfma_f32_32x32x16_bf16(pa3,PK(3),o[d0],0,0,0);
    #undef PK
  }
}

#ifndef ATTN_STORE16
#define ATTN_STORE16(p,v) (*(u32x4*)(p)=(v))
#endif
template<int THRL,bool BIAS> __device__ __forceinline__ void attn_unit(int b,int qb,const bf16*Q,const bf16*__restrict__ K,const bf16*__restrict__ V,bf16*O,const float*__restrict__ biasg,char*shm,const int tid_in,const bool comb,const bf16*O0,const float lam,const float osc,const float*__restrict__ gsub){
  int tid=tid_in; asm volatile("":"+v"(tid)); const int lane=tid&63,r32=lane&31,hi=lane>>5; const int wid=__builtin_amdgcn_readfirstlane(tid>>6);
  const long rowbase=(long)b*SEQ; const int q0=qb*QB;
  const bf16*Qw=Q+(rowbase+q0+wid*QBLK)*DMI;
  int t0=0;
  if(BIAS){ const int NT0=(q0+QB)/KVBLK; const float bq=biasg[q0]; int cnt=0;
    _Pragma("unroll") for(int h2=0;h2<2;++h2){ const int T=lane+64*h2; const bool sk=(T<NT0-4)&&(biasg[64*(T<NT0?T:0)+63]-bq<-200.f); cnt+=__popcll(__ballot(sk)); }
    t0=__builtin_amdgcn_readfirstlane(cnt)&~1; }
  const float*bg=BIAS?biasg+t0*KVBLK:biasg;
  const bf16*Kh=K+(rowbase+t0*KVBLK)*DMI,*Vh=V+(rowbase+t0*KVBLK)*DMI;
  const unsigned lds0=(unsigned)(uintptr_t)shm;
  float*wsf=(float*)(shm+LDS_WS)+wid*64;
  const bf16*ksrc=Kh+(long)lane*DMI+wid*8;
  const bf16*vsrc=Vh+(long)(16*(wid&3)+(lane>>2))*DMI+(wid>>2)*32+(lane&3)*8;
  const unsigned kdst=lds0+LDS_K+wid*1024, vdst=lds0+LDS_V+wid*1024;
  #define DMA_K(t,slot) glds16(ksrc+(long)(t)*KVBLK*DMI,(unsigned)__builtin_amdgcn_readfirstlane(kdst+(slot)))
  #define DMA_V(t,slot) do{ glds16(vsrc+(long)(t)*KVBLK*DMI,(unsigned)__builtin_amdgcn_readfirstlane(vdst+2*(slot))); glds16(vsrc+64+(long)(t)*KVBLK*DMI,(unsigned)__builtin_amdgcn_readfirstlane(vdst+2*(slot)+8192)); }while(0)
  const int vb0=(int)(lds0+LDS_V)+((lane>>4)&1)*32+(lane&3)*8+(4*hi+((lane&15)>>2))*64;
  const char*Kbase=shm+LDS_K; bf16x8 kf[8];
  const lds_cptr shm3=(lds_cptr)shm; const lds_cptr kp0=shm3+LDS_K+hi*1024+r32*16; const lds_cptr vp0=shm3+LDS_V+((lane>>4)&1)*32+(lane&3)*8+(4*hi+((lane&15)>>2))*64;
  const int NT=(q0+QB)/KVBLK-t0;
  typedef __attribute__((address_space(3))) const float* lds_fptr; typedef float f32x4_t __attribute__((ext_vector_type(4)));
  const lds_fptr biasl=(lds_fptr)(shm3+LDS_BIAS)+4*hi;
  if(BIAS){ __attribute__((address_space(3))) float* bw=(__attribute__((address_space(3))) float*)(shm3+LDS_BIAS); const int nb=NT*KVBLK;
    for(int i=tid*4;i<nb;i+=NW*64*4)*(__attribute__((address_space(3))) f32x4_t*)(bw+i)=*(const f32x4_t*)(bg+i); }
  #define BIASADD(P0,P1,t) do{ if(BIAS){ const lds_fptr bp_=biasl+KVBLK*(t); _Pragma("unroll") for(int i_=0;i_<4;++i_){ \
      const f32x4_t b0_=*(const __attribute__((address_space(3))) f32x4_t*)(bp_+8*i_), b1_=*(const __attribute__((address_space(3))) f32x4_t*)(bp_+32+8*i_); \
      _Pragma("unroll") for(int j_=0;j_<4;++j_){ P0[4*i_+j_]+=b0_[j_]; P1[4*i_+j_]+=b1_[j_]; } } } }while(0)
  DMA_K(0,0);DMA_V(0,0);DMA_K(1,SLOTB);
  bf16x8 qr[4];
  #pragma unroll
  for(int d0=0;d0<4;++d0)qr[d0]=*reinterpret_cast<const bf16x8*>(&Qw[(long)r32*DMI+d0*16+hi*8]);
  float mhat=0.f,l_reg=0.f;f32x16 o[4];o[0]=f32x16{};o[1]=f32x16{};o[2]=f32x16{};o[3]=f32x16{};f32x16 negm=f32x16{};asm volatile("":"+v"(negm));
  const int qrel=wid*QBLK+r32;
  #define CMASK(P0,P1,t) do{int jb_=(t)-(NT-4); if(jb_>=0)cmask(P0,P1,jb_,qrel,hi);}while(0)
  bool resc=false;
  #define START(P0,P1) do{ const float rm=rowmax(P0,P1); resc=false; \
    { const float dl=rm; mhat=fadd_s(mhat,dl); \
      _Pragma("unroll") for(int r=0;r<16;++r){P0[r]=fsub_s(P0[r],dl);P1[r]=fsub_s(P1[r],dl);} \
      _Pragma("unroll") for(int r=0;r<16;++r)negm[r]=-mhat; asm volatile("":"+v"(negm)); } \
    _Pragma("unroll") for(int r=0;r<16;++r)P0[r]=__builtin_amdgcn_exp2f(P0[r]); }while(0)
  #define RESC() do{ if(resc){ asm volatile("s_waitcnt lgkmcnt(0)":::"memory"); \
      _Pragma("unroll") for(int d_=0;d_<4;++d_) _Pragma("unroll") for(int r=0;r<16;++r)o[d_][r]*=wsf[crow(r,hi)]; } }while(0)
  f32x16 pA0,pA1,pB0,pB1;
  int sl_prev=0,sl_cur=0,sl_next=SLOTB;
  #define ROT() do{sl_prev=sl_cur;sl_cur=sl_next;sl_next=(sl_next==(NSLOT-1)*SLOTB)?0:sl_next+SLOTB;}while(0)
  DMA_K(2,2*SLOTB);
  WAIT_BAR(3);
  qkt(pA0,pA1,Kbase,qr,negm,r32,hi);asm volatile("s_nop 15\n\ts_nop 7":"+v"(pA0),"+v"(pA1));BIASADD(pA0,pA1,0);CMASK(pA0,pA1,0);
  START(pA0,pA1);
  _Pragma("unroll") for(int r=0;r<16;++r)pA1[r]=__builtin_amdgcn_exp2f(pA1[r]);
  WAIT_BAR(0);
  DMA_K(3,0);DMA_V(1,SLOTB);
  ROT();
  kload8(kf,kp0+sl_cur);
  WAIT_BAR(3);
  s16x4 vlo[3],vhi[3]; u32x4 pw0,pw1,pw2,pw3;
  #define PKW(P,B) cvtpk_s(P[B],P[B+1])
  #define PAF(k) __builtin_bit_cast(bf16x8,pw##k)
  #define PIN(x) asm volatile("":"+v"(x))
  #define MX3(a,b,c) __builtin_fmaxf(__builtin_fmaxf((a),(b)),(c))
  #define GAPA(MF,A0,A1,A2,A3,W0,W1,PW) do{ MF; sacc+=A0; sacc+=A1; sacc+=A2; sacc+=A3; PIN(sacc); W0; W1; PIN(PW); SBAR(); }while(0)
  #define EX(v) __builtin_amdgcn_exp2f(v)
  #define GAPB(MF,X,B) do{ MF; X[B]=EX(X[B]); X[B+1]=EX(X[B+1]); PIN(X); SBAR(); }while(0)
  #define VRDW(w,i) do{ vlo[w]=vtr(vp_+(((i)>>2)*4096+((i)&3)*1024)); vhi[w]=vtr(vp_+(((i)>>2)*4096+((i)&3)*1024+512)); }while(0)
  #define VFW(w) (bf16x8){vlo[w][0],vlo[w][1],vlo[w][2],vlo[w][3],vhi[w][0],vhi[w][1],vhi[w][2],vhi[w][3]}
  #define KRD(G,j) do{ if(G){ kload2(kf,kp0+sl_next,j); SBAR(); } }while(0)
  #define PVM(a,k,w) o[a]=__builtin_amdgcn_mfma_f32_32x32x16_bf16(PAF(k),VFW(w),o[a],0,0,0)
  #define STEP(C0,C1,P0,P1,t,GK,GV,GL) do{ SBAR(); \
    const lds_cptr vp_=vp0+2*sl_prev; \
    float sacc=(P0[0]+P0[1]); \
    GAPA(C0=__builtin_amdgcn_mfma_f32_32x32x16_bf16(kf[0],qr[0],negm,0,0,0), P0[2],P0[3],P0[4],P0[5],     pw0[0]=PKW(P0,0), pw0[1]=PKW(P0,2), pw0); \
    GAPA(C1=__builtin_amdgcn_mfma_f32_32x32x16_bf16(kf[1],qr[0],negm,0,0,0), P0[6],P0[7],P0[8],P0[9],     pw0[2]=PKW(P0,4), pw0[3]=PKW(P0,6), pw0); \
    GAPA(C0=__builtin_amdgcn_mfma_f32_32x32x16_bf16(kf[2],qr[1],C0,0,0,0),   P0[10],P0[11],P0[12],P0[13], pw1[0]=PKW(P0,8), pw1[1]=PKW(P0,10), pw1); \
    GAPA(C1=__builtin_amdgcn_mfma_f32_32x32x16_bf16(kf[3],qr[1],C1,0,0,0),   P0[14],P0[15],P1[0],P1[1],   pw1[2]=PKW(P0,12),pw1[3]=PKW(P0,14), pw1); \
    GAPA(C0=__builtin_amdgcn_mfma_f32_32x32x16_bf16(kf[4],qr[2],C0,0,0,0),   P1[2],P1[3],P1[4],P1[5],     pw2[0]=PKW(P1,0), pw2[1]=PKW(P1,2), pw2); \
    GAPA(C1=__builtin_amdgcn_mfma_f32_32x32x16_bf16(kf[5],qr[2],C1,0,0,0),   P1[6],P1[7],P1[8],P1[9],     pw2[2]=PKW(P1,4), pw2[3]=PKW(P1,6), pw2); \
    VRDW(0,0); SBAR(); \
    GAPA(C0=__builtin_amdgcn_mfma_f32_32x32x16_bf16(kf[6],qr[3],C0,0,0,0),   P1[10],P1[11],P1[12],P1[13], pw3[0]=PKW(P1,8), pw3[1]=PKW(P1,10), pw3); \
    VRDW(1,4); SBAR(); \
    GAPA(C1=__builtin_amdgcn_mfma_f32_32x32x16_bf16(kf[7],qr[3],C1,0,0,0),   P1[14],P1[15],0.f,0.f,       pw3[2]=PKW(P1,12),pw3[3]=PKW(P1,14), pw3); \
    l_reg+=sacc; \
    if(GK){DMA_K((t)+3,sl_cur);} if(GV){DMA_V((t)+1,sl_next);} \
    BIASADD(C0,C1,t); CMASK(C0,C1,t); \
    { float a=MX3(C0[0],C0[1],C1[0]),b=MX3(C0[2],C0[3],C1[1]); a=MX3(a,C1[2],C1[3]); \
      _Pragma("unroll") for(int r=4;r<16;r+=4){a=MX3(a,C0[r],C0[r+1]);b=MX3(b,C0[r+2],C0[r+3]);a=MX3(a,C1[r],C1[r+1]);b=MX3(b,C1[r+2],C1[r+3]);} \
      float rm=__builtin_fmaxf(a,b); { auto rr=__builtin_amdgcn_permlane32_swap(__float_as_uint(rm),__float_as_uint(rm),false,false); rm=__builtin_fmaxf(__uint_as_float(rr[0]),__uint_as_float(rr[1])); } \
      resc=false; \
      if(__builtin_expect(__any(rm>(float)THRL),0)){ const float dl=__builtin_fmaxf(rm,0.f); mhat+=dl; \
        _Pragma("unroll") for(int r=0;r<16;++r){C0[r]-=dl;C1[r]-=dl;} \
        _Pragma("unroll") for(int r=0;r<16;++r)negm[r]=-mhat; asm volatile("":"+v"(negm)); \
        const float f=__builtin_amdgcn_exp2f(-dl); l_reg*=f; if(hi==0)wsf[r32]=f; resc=true; } } \
    SBAR(); \
    GAPB(PVM(0,0,0), C0,0);  VRDW(2,8);  SBAR(); \
    GAPB(PVM(1,0,1), C0,2);  VRDW(0,12); SBAR(); \
    KRD(GL,0); GAPB(PVM(2,0,2), C0,4);  VRDW(1,1);  SBAR(); \
    GAPB(PVM(3,0,0), C0,6);  VRDW(2,5);  SBAR(); \
    KRD(GL,1); GAPB(PVM(0,1,1), C0,8);  VRDW(0,9);  SBAR(); \
    GAPB(PVM(1,1,2), C0,10); VRDW(1,13); SBAR(); \
    KRD(GL,2); GAPB(PVM(2,1,0), C0,12); VRDW(2,2);  SBAR(); \
    GAPB(PVM(3,1,1), C0,14); VRDW(0,6);  SBAR(); \
    KRD(GL,3); GAPB(PVM(0,2,2), C1,0);  VRDW(1,10); SBAR(); \
    GAPB(PVM(1,2,0), C1,2);  VRDW(2,14); SBAR(); \
    GAPB(PVM(2,2,1), C1,4);  VRDW(0,3);  SBAR(); \
    GAPB(PVM(3,2,2), C1,6);  VRDW(1,7);  SBAR(); \
    GAPB(PVM(0,3,0), C1,8);  VRDW(2,11); SBAR(); \
    GAPB(PVM(1,3,1), C1,10); VRDW(0,15); SBAR(); \
    GAPB(PVM(2,3,2), C1,12); \
    GAPB(PVM(3,3,0), C1,14); \
    }while(0)
  int t=1;
  #undef CMASK
  #define CMASK(P0,P1,t) do{}while(0)
  for(;t+5<NT;t+=2){
    STEP(pB0,pB1,pA0,pA1,t,true,true,true);     WAIT_BAR(3); RESC(); ROT();
    STEP(pA0,pA1,pB0,pB1,t+1,true,true,true);   WAIT_BAR(3); RESC(); ROT();
  }
  #undef CMASK
  #define CMASK(P0,P1,t) do{int jb_=(t)-(NT-4); if(jb_>=0)cmask(P0,P1,jb_,qrel,hi);}while(0)
  #define ENDW(tt) do{ if((tt)+3<NT){WAIT_BAR(3);} else if((tt)+2<NT){WAIT_BAR(2);} else {WAIT_BAR(0);} }while(0)
  for(;t+1<NT;t+=2){
    STEP(pB0,pB1,pA0,pA1,t,(t+3<NT),(t+1<NT),(t+1<NT));       ENDW(t);   RESC(); ROT();
    STEP(pA0,pA1,pB0,pB1,t+1,(t+4<NT),(t+2<NT),(t+2<NT));     ENDW(t+1); RESC(); ROT();
  }
  STEP(pB0,pB1,pA0,pA1,NT-1,false,false,false); RESC();
  { float sacc=pB0[0]+pB0[1]; _Pragma("unroll") for(int r=2;r<16;++r)sacc+=pB0[r]; _Pragma("unroll") for(int r=0;r<16;++r)sacc+=pB1[r]; l_reg+=sacc;
    pw0=(u32x4){PKW(pB0,0),PKW(pB0,2),PKW(pB0,4),PKW(pB0,6)};pw1=(u32x4){PKW(pB0,8),PKW(pB0,10),PKW(pB0,12),PKW(pB0,14)};pw2=(u32x4){PKW(pB1,0),PKW(pB1,2),PKW(pB1,4),PKW(pB1,6)};pw3=(u32x4){PKW(pB1,8),PKW(pB1,10),PKW(pB1,12),PKW(pB1,14)};
    SBAR(); pv(o,vb0+2*sl_cur,PAF(0),PAF(1),PAF(2),PAF(3)); pv(o+2,vb0+2*sl_cur+8192,PAF(0),PAF(1),PAF(2),PAF(3)); }
  #undef PKW
  #undef PAF
  #undef PIN
  #undef MX3
  #undef GAPA
  #undef GAPB
  #undef VRDW
  #undef VFW
  #undef PVM
  #undef EX
  #undef KRD
  #undef STEP
  #undef ENDW
  {auto rr=__builtin_amdgcn_permlane32_swap(__float_as_uint(l_reg),__float_as_uint(l_reg),false,false);l_reg=__uint_as_float(rr[0])+__uint_as_float(rr[1]);}
  if(hi==0)wsf[32+r32]=l_reg;asm volatile("s_waitcnt lgkmcnt(0)":::"memory");
  float rli[16];
  #pragma unroll
  for(int r=0;r<16;++r)rli[r]=__builtin_amdgcn_rcpf(wsf[32+crow(r,hi)]);
  bf16*Ow=O+(rowbase+q0+wid*QBLK)*DMO;
  { bf16*stg=(bf16*)(shm+LDS_OST)+wid*2048;
    if(!comb){
    #pragma unroll
    for(int ps=0;ps<2;++ps){
      #pragma unroll
      for(int r=0;r<16;++r){const int orow=crow(r,hi);
        #pragma unroll
        for(int d0=0;d0<2;++d0)stg[orow*64+d0*32+r32]=__float2bfloat16(o[2*ps+d0][r]*rli[r]);}
      asm volatile("s_waitcnt lgkmcnt(0)":::"memory");
      #pragma unroll
      for(int i=0;i<4;++i){const int row=i*8+(lane>>3),ch=lane&7; const u32x4 v=*(const u32x4*)(stg+row*64+ch*8); ATTN_STORE16(Ow+(long)row*DMO+ps*64+ch*8,v);}
      asm volatile("s_waitcnt lgkmcnt(0)":::"memory"); }
    } else {
      __builtin_amdgcn_fence(__ATOMIC_ACQUIRE,"agent");
      const bf16*O0w=O0+(rowbase+q0+wid*QBLK)*DMO; const int ch=lane&7,rw=lane>>3;
      float dv[2][4][8]; float ssq[4]={0.f,0.f,0.f,0.f};
      #pragma unroll
      for(int ps=0;ps<2;++ps){
        #pragma unroll
        for(int r=0;r<16;++r){const int orow=crow(r,hi);
          #pragma unroll
          for(int d0=0;d0<2;++d0)stg[orow*64+d0*32+r32]=__float2bfloat16(o[2*ps+d0][r]*rli[r]);}
        asm volatile("s_waitcnt lgkmcnt(0)":::"memory");
        #pragma unroll
        for(int i=0;i<4;++i){const int row=i*8+rw; const u32x4 v1=*(const u32x4*)(stg+row*64+ch*8); const u32x4 v0=*(const u32x4*)(O0w+(long)row*DMO+ps*64+ch*8);
          #pragma unroll
          for(int c=0;c<4;++c){ const float a0=__uint_as_float(v0[c]<<16),a1=__uint_as_float(v0[c]&0xffff0000u),b0=__uint_as_float(v1[c]<<16),b1=__uint_as_float(v1[c]&0xffff0000u);
            const float e0=a0-lam*b0,e1=a1-lam*b1; dv[ps][i][2*c]=e0; dv[ps][i][2*c+1]=e1; ssq[i]+=e0*e0+e1*e1; } }
        asm volatile("s_waitcnt lgkmcnt(0)":::"memory"); }
      #pragma unroll
      for(int i=0;i<4;++i){ float s=ssq[i];
        s+=__int_as_float(__builtin_amdgcn_ds_swizzle(__float_as_int(s),(1<<10)|0x1f)); s+=__int_as_float(__builtin_amdgcn_ds_swizzle(__float_as_int(s),(2<<10)|0x1f)); s+=__int_as_float(__builtin_amdgcn_ds_swizzle(__float_as_int(s),(4<<10)|0x1f));
        ssq[i]=osc/sqrtf(s*(1.0f/128.0f)+1e-6f); }
      #pragma unroll
      for(int ps=0;ps<2;++ps){ typedef float f32x4_u __attribute__((ext_vector_type(4)));
        const f32x4_u g0=*(const f32x4_u*)(gsub+ps*64+ch*8),g1=*(const f32x4_u*)(gsub+ps*64+ch*8+4);
        #pragma unroll
        for(int i=0;i<4;++i){const int row=i*8+rw; const float rs=ssq[i]; u32x4 w;
          w.x=cvtpk_s(dv[ps][i][0]*rs*g0.x,dv[ps][i][1]*rs*g0.y); w.y=cvtpk_s(dv[ps][i][2]*rs*g0.z,dv[ps][i][3]*rs*g0.w);
          w.z=cvtpk_s(dv[ps][i][4]*rs*g1.x,dv[ps][i][5]*rs*g1.y); w.w=cvtpk_s(dv[ps][i][6]*rs*g1.z,dv[ps][i][7]*rs*g1.w);
          ATTN_STORE16(Ow+(long)row*DMO+ps*64+ch*8,w);} }
    } }
  asm volatile("s_waitcnt lgkmcnt(0)\n\ts_barrier":::"memory");
  #undef BIASADD
  #undef DMA_K
  #undef DMA_V
  #undef CMASK
  #undef START
  #undef RESC
  #undef ROT
}
constexpr int ATTN_LDS_BYTES=LDS_BYTES;
#undef SBAR
#undef WAIT_BAR
}
#include <hip/hip_cooperative_groups.h>
namespace cg = cooperative_groups;
#define GAS __attribute__((address_space(1)))
#define LAS __attribute__((address_space(3)))
typedef unsigned short bf16;
typedef unsigned v4u __attribute__((ext_vector_type(4)));
typedef unsigned v2u __attribute__((ext_vector_type(2)));
typedef float f32x4 __attribute__((ext_vector_type(4)));
constexpr int NWAVES = 8;
constexpr int BATCH = 4, SEQ = 8192, D = 1024, DEPTH = 2, M = BATCH * SEQ;
constexpr int INW = 3080, NQKV = 3072, DFF = 2816, NGU = 2 * DFF, NFOX = 8;
constexpr float EPS = 1e-6f;
constexpr size_t MiB = 1u << 20;
constexpr size_t WS_RS1 = 5 * MiB, WS_RS2 = 5 * MiB + 262144;
constexpr size_t WS_ROT = 1 * MiB, WS_LOGF = 3 * MiB, WS_CUM = 4 * MiB, WS_WIN = 6 * MiB, WS_WO = 18 * MiB, WS_WGU = 22 * MiB, WS_WD = 44 * MiB, WS_XN = 56 * MiB,
                 WS_QKV = 120 * MiB, WS_ACT = 120 * MiB, WS_Y1 = 120 * MiB, WS_OD = 312 * MiB, WS_MIX = 376 * MiB, WS_Y2 = 312 * MiB, WS_END = 440 * MiB;
constexpr int LDS_BYTES = 147456;
static_assert(attn_body::ATTN_LDS_BYTES <= 131072 && attn128::ATTN_LDS_BYTES <= 131072, "attention scratch fits");
#define LDS_WAIT() asm volatile("s_waitcnt lgkmcnt(0)" ::: "memory")
__device__ __forceinline__ unsigned f2bf(float f) { unsigned u = __builtin_bit_cast(unsigned, f); return (u + 0x7fffu + ((u >> 16) & 1u)) >> 16; }
__device__ __forceinline__ unsigned pk2(float lo, float hi) { return f2bf(lo) | (f2bf(hi) << 16); }
#define SWZ_XOR(v, m) __uint_as_float((unsigned)__builtin_amdgcn_ds_swizzle((int)__float_as_uint(v), ((m) << 10) | 0x1f))
__device__ __forceinline__ float wave_sum(float v) {
    v += SWZ_XOR(v, 1); v += SWZ_XOR(v, 2); v += SWZ_XOR(v, 4); v += SWZ_XOR(v, 8); v += SWZ_XOR(v, 16);
    const auto rr = __builtin_amdgcn_permlane32_swap(__float_as_uint(v), __float_as_uint(v), false, false);
    return __uint_as_float(rr[0]) + __uint_as_float(rr[1]);
}
__device__ __forceinline__ void transpose_item(const float* W, int ldw, int Kdim, bf16* WT, int dst_row0, int k0, int n0, LAS float* scr, int lane, const float* gk) {
#pragma unroll 8
    for (int i = 0; i < 32; ++i) { const int kk = 2 * i + (lane >> 5); scr[kk * 33 + (lane & 31)] = W[(size_t)(k0 + kk) * ldw + n0 + (lane & 31)]; }
    LDS_WAIT(); asm volatile("" ::: "memory");
    const int c = lane & 7;
    f32x4 ga = {1.f, 1.f, 1.f, 1.f}, gb = ga; if (gk) { ga = *(const f32x4*)(gk + k0 + 8 * c); gb = *(const f32x4*)(gk + k0 + 8 * c + 4); }
#pragma unroll
    for (int j = 0; j < 4; ++j) { const int n = (lane >> 3) + 8 * j; const LAS float* s = scr + (8 * c) * 33 + n;
        v4u o; o.x = pk2(s[0 * 33] * ga.x, s[1 * 33] * ga.y); o.y = pk2(s[2 * 33] * ga.z, s[3 * 33] * ga.w); o.z = pk2(s[4 * 33] * gb.x, s[5 * 33] * gb.y); o.w = pk2(s[6 * 33] * gb.z, s[7 * 33] * gb.w);
        *(GAS v4u*)(WT + (size_t)(dst_row0 + n) * Kdim + k0 + 8 * c) = o; }
    LDS_WAIT(); asm volatile("" ::: "memory");
}
__device__ __forceinline__ void load_row(const float* p, int lane, f32x4 (&v)[4]) {
    const f32x4* r = (const f32x4*)p + lane;
#pragma unroll
    for (int j = 0; j < 4; ++j) v[j] = r[64 * j];
}
__device__ __forceinline__ void load_row_bf16(const bf16* p, int lane, f32x4 (&v)[4]) {
    const v2u* r = (const v2u*)p + lane;
#pragma unroll
    for (int j = 0; j < 4; ++j) { const v2u w = r[64 * j]; v[j].x = __uint_as_float(w.x << 16); v[j].y = __uint_as_float(w.x & 0xffff0000u); v[j].z = __uint_as_float(w.y << 16); v[j].w = __uint_as_float(w.y & 0xffff0000u); }
}
__device__ __forceinline__ void store_row(float* p, int lane, const f32x4 (&v)[4]) {
    f32x4* r = (f32x4*)p + lane;
#pragma unroll
    for (int j = 0; j < 4; ++j) r[64 * j] = v[j];
}
__device__ __forceinline__ float row_rstd(const f32x4 (&v)[4]) {
    float s = 0.f;
#pragma unroll
    for (int j = 0; j < 4; ++j) s += (v[j].x * v[j].x + v[j].y * v[j].y) + (v[j].z * v[j].z + v[j].w * v[j].w);
    return 1.0f / sqrtf(wave_sum(s) * (1.0f / D) + EPS);
}
__device__ __forceinline__ void store_row_bf16(bf16* p, int lane, const f32x4 (&v)[4]) {
    v2u* o = (v2u*)p + lane;
#pragma unroll
    for (int j = 0; j < 4; ++j) { v2u w; w.x = pk2(v[j].x, v[j].y); w.y = pk2(v[j].z, v[j].w); o[64 * j] = w; }
}
constexpr int WFL_OFF = 0;
__device__ __forceinline__ void fill_forget_w(const float* win_l, LAS unsigned char* ldsl, int tid) {
    LAS float* wfl = (LAS float*)(ldsl + WFL_OFF);
    for (int idx = tid; idx < 8 * D; idx += NWAVES * 64) { const int k = idx >> 3, f = idx & 7; wfl[f * D + k] = win_l[(size_t)k * INW + NQKV + f]; }
    __syncthreads();
}
__device__ __forceinline__ void pre_norm_row(const f32x4 (&xv)[4], const f32x4 (&g)[4], bf16* xb_row, const LAS float* wfl, const float* fbias, float* logf, float* rs, int row, int lane) {
    const float rstd = row_rstd(xv); f32x4 h[4];
#pragma unroll
    for (int j = 0; j < 4; ++j) h[j] = xv[j] * rstd * g[j];
    if (xb_row) store_row_bf16(xb_row, lane, xv);
    if (lane == 0) rs[row] = rstd;
    float mine = 0.f;
#pragma unroll
    for (int f = 0; f < 8; ++f) { f32x4 a = {0.f, 0.f, 0.f, 0.f};
#pragma unroll
        for (int j = 0; j < 4; ++j) a += *(const LAS f32x4*)(wfl + f * D + 256 * j + 4 * lane) * h[j];
        const float t = wave_sum((a.x + a.y) + (a.z + a.w)); mine = (lane == f) ? t : mine; }
    if (lane < NFOX) { const float y = mine + fbias[lane]; const float e = __expf(-fabsf(y)), u = 1.0f + e, um = u - 1.0f; const float l1p = (um == 0.f) ? e : __logf(u) * (e / um); const float lf = fminf(y, 0.f) - l1p;
        const int b = row / SEQ, s = row % SEQ; logf[(size_t)(b * NFOX + lane) * SEQ + s] = lf; }
}

#define XB_TMO      128
#define XB_XCNT(j)  (256  + 64 * (j))
#define XB_XSUB(j)  (1280 + 64 * (j))
#define XB_XGEN(j)  (2304 + 64 * (j))
#define XB_TOP      3328
#define XB_TOPGEN   3392
#define XCD_BAR_WORDS 3456
#define XB_SPIN_CAP (1u << 22)

__device__ __forceinline__ unsigned xb_ld(unsigned* p)              { return __hip_atomic_load(p, __ATOMIC_RELAXED, __HIP_MEMORY_SCOPE_AGENT); }
__device__ __forceinline__ unsigned xb_add(unsigned* p, unsigned v) { return __hip_atomic_fetch_add(p, v, __ATOMIC_RELAXED, __HIP_MEMORY_SCOPE_AGENT); }
__device__ __forceinline__ unsigned xb_xcc_id() { return (unsigned)__builtin_amdgcn_s_getreg((3 << 11) | 20) & 0xFu; }
#define XB_SPIN(cond, bar) do { unsigned _sp = 0; while (cond) { __builtin_amdgcn_s_sleep(1); \
    if ((++_sp & 255u) == 0u) { if (xb_ld(&(bar)[XB_TMO])) break; if (_sp > XB_SPIN_CAP) { atomicAdd(&(bar)[XB_TMO], 1u); break; } } } } while (0)

struct XcdBarrier {
    unsigned* bar; unsigned x;
    volatile LAS unsigned* st;
};

__device__ __forceinline__ XcdBarrier xcd_barrier_post(unsigned* bar, volatile LAS unsigned* st, const int tid_in) {
    XcdBarrier b; b.bar = bar; b.x = xb_xcc_id(); b.st = st;
    if (tid_in == 0) (void)xb_add(&bar[XB_XCNT(b.x)], 1u);
    return b;
}
__device__ __forceinline__ void xcd_barrier_complete(unsigned* bar, unsigned x, unsigned& nloc, unsigned& nx) {
    const unsigned G = gridDim.x * gridDim.y * gridDim.z;
    unsigned sum, cnt, mine, sp = 0u;
    for (;;) {
        sum = 0u; cnt = 0u; mine = 0u;
#pragma unroll
        for (unsigned j = 0; j < 16; ++j) { const unsigned c = xb_ld(&bar[XB_XCNT(j)]); sum += c; cnt += (c > 0u) ? 1u : 0u; mine = (j == x) ? c : mine; }
        if (sum == G) break;
        __builtin_amdgcn_s_sleep(1);
        if ((++sp & 255u) == 0u) { if (xb_ld(&bar[XB_TMO])) break; if (sp > XB_SPIN_CAP) { atomicAdd(&bar[XB_TMO], 1u); break; } }
    }
    nloc = mine > 0u ? mine : 1u; nx = cnt > 0u ? cnt : 1u;
}

__device__ __forceinline__ void xcd_barrier(const XcdBarrier& b, const int tid_in) {
    asm volatile("s_waitcnt vmcnt(0)" ::: "memory");
    __syncthreads();
    if (tid_in == 0) {
        unsigned* bar = b.bar;
        __builtin_amdgcn_s_waitcnt(0);
        unsigned nloc = b.st[0], nx = b.st[1];
        if (nloc == 0u) { xcd_barrier_complete(bar, b.x, nloc, nx); b.st[0] = nloc; b.st[1] = nx; }
        const unsigned old = xb_add(&bar[XB_XSUB(b.x)], 1u);
        const unsigned gen = old / nloc;
        if (old + 1u == (gen + 1u) * nloc) {
            __builtin_amdgcn_fence(__ATOMIC_RELEASE, "agent");
            asm volatile("s_waitcnt vmcnt(0)" ::: "memory");
            const unsigned og = xb_add(&bar[XB_TOP], 1u);
            const unsigned tg = og / nx;
            if (og + 1u == (tg + 1u) * nx) xb_add(&bar[XB_TOPGEN], 1u);
            else XB_SPIN(xb_ld(&bar[XB_TOPGEN]) == tg, bar);
            __builtin_amdgcn_fence(__ATOMIC_ACQUIRE, "agent");
            xb_add(&bar[XB_XGEN(b.x)], 1u);
            asm volatile("s_waitcnt vmcnt(0)" ::: "memory");
        } else {
            XB_SPIN(xb_ld(&bar[XB_XGEN(b.x)]) == gen, bar);
            __builtin_amdgcn_fence(__ATOMIC_ACQUIRE, "agent");
            asm volatile("s_waitcnt vmcnt(0)" ::: "memory");
        }
    }
    __syncthreads();
}

constexpr size_t WS_CTL = 0, CTL_ZERO_BYTES = 65536; constexpr int CW_BAR = 4096;
constexpr int MISC_OFF = 131072 + 320;
struct Args { const void* in[17]; float* out; unsigned char* ws; };
typedef const __attribute__((address_space(4))) Args* KArgs;
#define KA() ([]() __attribute__((always_inline)) { KArgs p_ = (KArgs)__builtin_amdgcn_kernarg_segment_ptr(); asm volatile("" : "+s"(p_)); return p_; }())
#define IN_F(A, k) ((const float*)(A)->in[k])

__global__ void __launch_bounds__(NWAVES * 64, 2) hymba_fwd(Args args_unused) {
    extern __shared__ __attribute__((aligned(16))) unsigned char lds[];
    cg::grid_group grid = cg::this_grid();
#define TID_NOW() ({ unsigned ones_ = ~0u; asm volatile("" : "+s"(ones_)); (wave0 << 6) | (int)__builtin_amdgcn_mbcnt_hi(ones_, __builtin_amdgcn_mbcnt_lo(ones_, 0u)); })
    const int wave0 = __builtin_amdgcn_readfirstlane((int)threadIdx.x >> 6);
#define PH_IDS() int tid = TID_NOW(); asm volatile("" : "+v"(tid)); const int lane = tid & 63, wave = __builtin_amdgcn_readfirstlane(tid >> 6); int bx = blockIdx.x; asm volatile("" : "+s"(bx)); \
    const int G = gridDim.x, vcu = (G % 8 == 0) ? (bx % 8) * (G / 8) + bx / 8 : bx, gw = vcu * NWAVES + wave, NGW = G * NWAVES; (void)lane; (void)gw; (void)NGW; (void)vcu; \
      \
    const bool xl_ = (G % 8 == 0) && (M % 8 == 0); const int wpg_ = NGW / 8; \
    const int rbase = xl_ ? (gw / wpg_) * (M / 8) + (gw % wpg_) : gw, rstep = xl_ ? wpg_ : NGW, rend = xl_ ? (gw / wpg_ + 1) * (M / 8) : M; (void)rbase; (void)rstep; (void)rend
#define BARRIER() do { KArgs Ab_ = KA(); XcdBarrier b_; b_.bar = (unsigned*)(Ab_->ws + WS_CTL) + CW_BAR; b_.x = xb_xcc_id(); b_.st = (volatile LAS unsigned*)(ldsl + MISC_OFF) + 8; int t_ = TID_NOW(); asm volatile("" : "+v"(t_)); xcd_barrier(b_, t_); } while (0)
    LAS unsigned char* ldsl = (LAS unsigned char*)lds;
    { const int t_ = TID_NOW(); for (int u = t_; u < (LDS_BYTES - 131072) / 4; u += NWAVES * 64) ((LAS unsigned*)(ldsl + 131072))[u] = 0u;
      __syncthreads();
      (void)xcd_barrier_post((unsigned*)(KA()->ws + WS_CTL) + CW_BAR, (volatile LAS unsigned*)(ldsl + MISC_OFF) + 8, t_); }

    {
        KArgs A = KA(); PH_IDS(); unsigned char* ws = A->ws;
        const float* attn_pre_g = IN_F(A, 2); const float* ffn_pre_g = IN_F(A, 12); const float* w_in = IN_F(A, 3); const float* w_out = IN_F(A, 10); const float* w_gate = IN_F(A, 13); const float* w_up = IN_F(A, 14); const float* w_down = IN_F(A, 15);
        bf16* WIN_T = (bf16*)(ws + WS_WIN); bf16* WO_T = (bf16*)(ws + WS_WO); bf16* WGU_T = (bf16*)(ws + WS_WGU); bf16* WD_T = (bf16*)(ws + WS_WD);
        LAS float* scr = (LAS float*)(ldsl + wave * 16384);
        constexpr int I_IN = 16 * (NQKV / 32), I_O = 16 * (D / 32), I_G = 16 * (DFF / 32), I_D = (DFF / 64) * (D / 32), I_L = I_IN + I_O + 2 * I_G + I_D;
        for (int it = gw; it < DEPTH * I_L; it += NGW) {
            const int l = it / I_L; int r = it % I_L;
            if (r < I_IN) { const int nb = NQKV / 32; transpose_item(w_in + (size_t)l * D * INW, INW, D, WIN_T + (size_t)l * NQKV * D, 32 * (r % nb), 64 * (r / nb), 32 * (r % nb), scr, lane, attn_pre_g + l * D); continue; } r -= I_IN;
            if (r < I_O) { const int nb = D / 32; transpose_item(w_out + (size_t)l * D * D, D, D, WO_T + (size_t)l * D * D, 32 * (r % nb), 64 * (r / nb), 32 * (r % nb), scr, lane, nullptr); continue; } r -= I_O;
            if (r < 2 * I_G) { const int up = r >= I_G; if (up) r -= I_G; const int nb = DFF / 32, n0 = 32 * (r % nb);
                transpose_item((up ? w_up : w_gate) + (size_t)l * D * DFF, DFF, D, WGU_T + (size_t)l * NGU * D, (n0 / 128) * 256 + up * 128 + (n0 % 128), 64 * (r / nb), n0, scr, lane, ffn_pre_g + l * D); continue; } r -= 2 * I_G;
            { const int nb = D / 32; transpose_item(w_down + (size_t)l * DFF * D, D, DFF, WD_T + (size_t)l * D * DFF, 32 * (r % nb), 64 * (r / nb), 32 * (r % nb), scr, lane, nullptr); }
        }
    }
    {
        KArgs A = KA(); PH_IDS(); const int* positions = (const int*)A->in[1]; float* ROT = (float*)(A->ws + WS_ROT);
        for (int e = bx * (NWAVES * 64) + tid; e < M * 8; e += G * NWAVES * 64) {
            const int row = e >> 3, i = e & 7;
            float fr = 1.000000000e+00f;
            fr = (i == 1) ? 1.939227581e-01f : fr; fr = (i == 2) ? 3.760603070e-02f : fr; fr = (i == 3) ? 7.292665076e-03f : fr; fr = (i == 4) ? 1.414213446e-03f : fr;
            fr = (i == 5) ? 2.742481884e-04f : fr; fr = (i == 6) ? 5.318296462e-05f : fr; fr = (i == 7) ? 1.031338525e-05f : fr;
            const float ang = (float)positions[row] * fr;
            const double xd = (double)ang, kq = rint(xd * 0.63661977236758134308), rr = fma(-kq, 6.123233995736766e-17, fma(-kq, 1.5707963267948966, xd)), r2 = rr * rr;
            const double sn = rr * (1.0 + r2 * (-1.0 / 6 + r2 * (1.0 / 120 + r2 * (-1.0 / 5040 + r2 * (1.0 / 362880 + r2 * (-1.0 / 39916800))))));
            const double cs = 1.0 + r2 * (-0.5 + r2 * (1.0 / 24 + r2 * (-1.0 / 720 + r2 * (1.0 / 40320 + r2 * (-1.0 / 3628800 + r2 * (1.0 / 479001600))))));
            const int q4 = (int)kq & 3;
            const double c = (q4 == 0) ? cs : (q4 == 1) ? -sn : (q4 == 2) ? -cs : sn, s = (q4 == 0) ? sn : (q4 == 1) ? cs : (q4 == 2) ? -sn : -cs;
            ROT[(size_t)row * 16 + i] = (float)c; ROT[(size_t)row * 16 + 8 + i] = (float)s;
        }
    }
    {
        KArgs A = KA(); PH_IDS(); const float* x_in = IN_F(A, 0); bf16* XN = (bf16*)(A->ws + WS_XN); float* LOGF = (float*)(A->ws + WS_LOGF); const float* fbias = IN_F(A, 4);
        __syncthreads();
        fill_forget_w(IN_F(A, 3), ldsl, tid);
        f32x4 g[4]; load_row(IN_F(A, 2), lane, g);
        {
            f32x4 xv[4]; load_row(x_in + (size_t)rbase * D, lane, xv);
            for (int m = rbase; m < rend; m += rstep) { f32x4 xn[4]; const int mn = (m + rstep < rend) ? m + rstep : m; load_row(x_in + (size_t)mn * D, lane, xn);
                pre_norm_row(xv, g, XN + (size_t)m * D, (const LAS float*)(ldsl + WFL_OFF), fbias, LOGF, (float*)(A->ws + WS_RS1), m, lane);
#pragma unroll
                for (int j = 0; j < 4; ++j) xv[j] = xn[j]; } }
    }
    grid.sync();

#pragma unroll 1
    for (int l = 0; l < DEPTH; ++l) {
        {
            KArgs A = KA(); PH_IDS(); const float* LOGF = (const float*)(A->ws + WS_LOGF); float* CUM = (float*)(A->ws + WS_CUM);
            for (int ch = bx; ch < BATCH * NFOX; ch += G) {
                LAS float* wt = (LAS float*)ldsl;
                const f32x4* src = (const f32x4*)(LOGF + (size_t)ch * SEQ + tid * 16); f32x4 v[4]; float run = 0.f;
#pragma unroll
                for (int j = 0; j < 4; ++j) { v[j] = src[j]; v[j].x += run; v[j].y += v[j].x; v[j].z += v[j].y; v[j].w += v[j].z; run = v[j].w; }
                float inc = run;
#pragma unroll
                for (int o = 1; o < 64; o <<= 1) { const float t = __uint_as_float((unsigned)__builtin_amdgcn_ds_bpermute(((lane - o) & 63) << 2, (int)__float_as_uint(inc))); if (lane >= o) inc += t; }
                if (lane == 63) wt[wave] = inc;
                __syncthreads();
                float off = inc - run;
                for (int w = 0; w < wave; ++w) off += wt[w];
                f32x4* dst = (f32x4*)(CUM + (size_t)ch * SEQ + tid * 16);
#pragma unroll
                for (int j = 0; j < 4; ++j) dst[j] = (v[j] + off) * -1.4426950408889634f;
                __syncthreads();
            }
        }
        {
            KArgs A = KA(); PH_IDS(); unsigned char* ws = A->ws;
            pg8::Gemm g{(const bf16*)(ws + WS_XN), (const bf16*)(ws + WS_WIN) + (size_t)l * NQKV * D, M, NQKV, D}; pg8::StaticOrder S; S.init(M, NQKV, G, bx);
            pg8::EpiQKV E{(bf16*)(ws + WS_QKV), (const float*)(ws + WS_ROT), (const float*)(ws + WS_RS1)};
            pg8::gemm_phase<pg8::EpiQKV, pg8::StaticOrder, PG8_ALIGN, PG8_SP2>(ldsl, g, S, E, tid);
        }
        BARRIER();
        {
            KArgs A = KA(); PH_IDS(); unsigned char* ws = A->ws;
            const float lam_init = 0.8f - 0.6f * __expf(-0.3f * (float)l);
            const float e1 = __expf(wave_sum(IN_F(A, 5)[l * 64 + lane] * IN_F(A, 6)[l * 64 + lane])), e2 = __expf(wave_sum(IN_F(A, 7)[l * 64 + lane] * IN_F(A, 8)[l * 64 + lane]));
            const float lam = __uint_as_float((unsigned)__builtin_amdgcn_readfirstlane((int)__float_as_uint(e1 - e2 + lam_init))), osc = __uint_as_float((unsigned)__builtin_amdgcn_readfirstlane((int)__float_as_uint(1.0f - lam_init)));
            const float* gsub = IN_F(A, 9) + l * 128;
            unsigned* qcnt = (unsigned*)(ws + WS_CTL) + 64 * (1 + 8 * l);
            volatile LAS unsigned* qs = (volatile LAS unsigned*)(ldsl + MISC_OFF) + 16;
            const attn_body::bf16* Qb = (const attn_body::bf16*)(ws + WS_QKV);
            int k = 0;
            while (k < 8) {
                const int x = (bx + k) & 7;
                if (tid == 0) *qs = __hip_atomic_fetch_add(qcnt + 64 * x, 1u, __ATOMIC_RELAXED, __HIP_MEMORY_SCOPE_AGENT);
                __syncthreads();
                const unsigned e = (unsigned)__builtin_amdgcn_readfirstlane(*qs);
                __syncthreads();
                if (e >= 192u) { ++k; continue; }
                const int qb = (e < 64u) ? 31 - (int)(e >> 1) : 31 - (int)((e - 64u) >> 2), j = (e < 64u) ? (int)(e & 1u) : 2 + (int)((e - 64u) & 3u);
                if (j < 2) { const int idx = 2 * x + j, b = idx >> 2, h = idx & 3;
#pragma unroll 1
                    for (int mp = 0; mp < 2; ++mp) { const int hm = 2 * h + mp;
                        attn128::attn_unit<8, false>(b, qb, (const attn128::bf16*)Qb + hm * 64, (const attn128::bf16*)Qb + 512 + hm * 64, (const attn128::bf16*)Qb + 1024 + h * 128,
                            (mp ? (attn128::bf16*)(ws + WS_MIX) : (attn128::bf16*)(ws + WS_OD)) + h * 128, nullptr, (char*)lds, tid, mp != 0, (const attn128::bf16*)(ws + WS_OD) + h * 128, lam, osc, gsub); }
                } else { const int b = j - 2, f = (x - 2 * b) & 7;
                    attn_body::attn_unit<8, true>(b, qb, Qb + 1536 + f * 64, Qb + 2048 + f * 64, Qb + 2560 + f * 64, (attn_body::bf16*)(ws + WS_MIX) + 512 + f * 64, (const float*)(ws + WS_CUM) + (size_t)(b * NFOX + f) * SEQ, (char*)lds, tid); }
            }
        }
        BARRIER();
        {
            KArgs A = KA(); PH_IDS(); unsigned char* ws = A->ws;
            pg8::Gemm g{(const bf16*)(ws + WS_MIX), (const bf16*)(ws + WS_WO) + (size_t)l * D * D, M, D, D}; pg8::StaticOrder S; S.init(M, D, G, bx);
            pg8::EpiY E{(bf16*)(ws + WS_Y1), D};
            pg8::gemm_phase<pg8::EpiY, pg8::StaticOrder, PG8_ALIGN, PG8_SP2>(ldsl, g, S, E, tid);
        }
        BARRIER();
        {
            KArgs A = KA(); PH_IDS(); const bf16* Y1 = (const bf16*)(A->ws + WS_Y1); bf16* XB = (bf16*)(A->ws + WS_XN); float* RS2 = (float*)(A->ws + WS_RS2); const float* x_in = IN_F(A, 0);
            f32x4 gp[4]; load_row(IN_F(A, 11) + l * D, lane, gp);
            f32x4 y[4], xv[4];
            load_row_bf16(Y1 + (size_t)rbase * D, lane, y); if (l == 0) load_row(x_in + (size_t)rbase * D, lane, xv); else load_row_bf16(XB + (size_t)rbase * D, lane, xv);
            for (int m = rbase; m < rend; m += rstep) { f32x4 yn[4], xn[4];
                const int mn = (m + rstep < rend) ? m + rstep : m;
                load_row_bf16(Y1 + (size_t)mn * D, lane, yn); if (l == 0) load_row(x_in + (size_t)mn * D, lane, xn); else load_row_bf16(XB + (size_t)mn * D, lane, xn);
                const float ry = row_rstd(y);
#pragma unroll
                for (int j = 0; j < 4; ++j) xv[j] += y[j] * ry * gp[j];
                store_row_bf16(XB + (size_t)m * D, lane, xv);
                const float rx = row_rstd(xv);
                if (lane == 0) RS2[m] = rx;
#pragma unroll
                for (int j = 0; j < 4; ++j) { y[j] = yn[j]; xv[j] = xn[j]; }
            }
        }
        BARRIER();
        {
            KArgs A = KA(); PH_IDS(); unsigned char* ws = A->ws;
            pg8::Gemm g{(const bf16*)(ws + WS_XN), (const bf16*)(ws + WS_WGU) + (size_t)l * NGU * D, M, NGU, D}; pg8::StaticOrder S; S.init(M, NGU, G, bx);
            pg8::EpiSwiGLU E{(bf16*)(ws + WS_ACT), DFF, (const float*)(ws + WS_RS2)};
            pg8::gemm_phase<pg8::EpiSwiGLU, pg8::StaticOrder, PG8_ALIGN, PG8_SP2>(ldsl, g, S, E, tid);
        }
        BARRIER();
        {
            KArgs A = KA(); PH_IDS(); unsigned char* ws = A->ws;
            pg8::Gemm g{(const bf16*)(ws + WS_ACT), (const bf16*)(ws + WS_WD) + (size_t)l * D * DFF, M, D, DFF}; pg8::StaticOrder S; S.init(M, D, G, bx);
            pg8::EpiY E{(bf16*)(ws + WS_Y2), D};
            pg8::gemm_phase<pg8::EpiY, pg8::StaticOrder, PG8_ALIGN, PG8_SP2>(ldsl, g, S, E, tid);
        }
        BARRIER();
        {
            KArgs A = KA(); PH_IDS(); const bf16* Y2 = (const bf16*)(A->ws + WS_Y2); bf16* XB = (bf16*)(A->ws + WS_XN);
            f32x4 gp[4]; load_row(IN_F(A, 16) + l * D, lane, gp);
            if (l + 1 < DEPTH) {
                float* LOGF = (float*)(A->ws + WS_LOGF); float* RS1 = (float*)(A->ws + WS_RS1); const float* fbias = IN_F(A, 4) + (l + 1) * NFOX;
                fill_forget_w(IN_F(A, 3) + (size_t)(l + 1) * D * INW, ldsl, tid);
                f32x4 g[4]; load_row(IN_F(A, 2) + (l + 1) * D, lane, g);
                f32x4 y[4], xv[4];
                load_row_bf16(Y2 + (size_t)rbase * D, lane, y); load_row_bf16(XB + (size_t)rbase * D, lane, xv);
                for (int m = rbase; m < rend; m += rstep) { f32x4 yn[4], xn[4];
                    const int mn = (m + rstep < rend) ? m + rstep : m;
                    load_row_bf16(Y2 + (size_t)mn * D, lane, yn); load_row_bf16(XB + (size_t)mn * D, lane, xn);
                    const float ry = row_rstd(y);
#pragma unroll
                    for (int j = 0; j < 4; ++j) xv[j] += y[j] * ry * gp[j];
                    pre_norm_row(xv, g, XB + (size_t)m * D, (const LAS float*)(ldsl + WFL_OFF), fbias, LOGF, RS1, m, lane);
#pragma unroll
                    for (int j = 0; j < 4; ++j) { y[j] = yn[j]; xv[j] = xn[j]; }
                }
                BARRIER();
            } else {
                float* xout = A->out;
                f32x4 y[4], xv[4];
                load_row_bf16(Y2 + (size_t)rbase * D, lane, y); load_row_bf16(XB + (size_t)rbase * D, lane, xv);
                for (int m = rbase; m < rend; m += rstep) { f32x4 yn[4], xn[4];
                    const int mn = (m + rstep < rend) ? m + rstep : m;
                    load_row_bf16(Y2 + (size_t)mn * D, lane, yn); load_row_bf16(XB + (size_t)mn * D, lane, xn);
                    const float ry = row_rstd(y);
#pragma unroll
                    for (int j = 0; j < 4; ++j) xv[j] += y[j] * ry * gp[j];
                    store_row(xout + (size_t)m * D, lane, xv);
#pragma unroll
                    for (int j = 0; j < 4; ++j) { y[j] = yn[j]; xv[j] = xn[j]; }
                }
            }
        }
    }
}

extern "C" void kernel_launch(void* const* d_in, const int* in_sizes, int n_in, void* d_out, int out_size, void* d_ws, size_t ws_size, hipStream_t stream) {
    static int grid = 0;
    if (grid == 0) {
        if (n_in != 17 || in_sizes[0] != M * D || out_size != M * D || ws_size < WS_END) { fprintf(stderr, "kernel_launch: shape/workspace mismatch (n_in %d in0 %d out %d ws %zu)\n", n_in, n_in > 0 ? in_sizes[0] : -1, out_size, ws_size); grid = -1; return; }
        int dev = 0, cus = 0, per_cu = 0;
        if (hipGetDevice(&dev) != hipSuccess || hipDeviceGetAttribute(&cus, hipDeviceAttributeMultiprocessorCount, dev) != hipSuccess) { grid = -1; return; }
        if (hipFuncSetAttribute((const void*)hymba_fwd, hipFuncAttributeMaxDynamicSharedMemorySize, LDS_BYTES) != hipSuccess) { fprintf(stderr, "kernel_launch: hipFuncSetAttribute failed\n"); grid = -1; return; }
        if (hipOccupancyMaxActiveBlocksPerMultiprocessor(&per_cu, (const void*)hymba_fwd, NWAVES * 64, LDS_BYTES) != hipSuccess || per_cu < 1) { fprintf(stderr, "kernel_launch: occupancy query says %d\n", per_cu); per_cu = 1; }
        (void)hipGetLastError();
        grid = cus;
    }
    if (grid < 0) return;
    if (hipMemsetAsync((char*)d_ws + WS_CTL, 0, CTL_ZERO_BYTES, stream) != hipSuccess) { fprintf(stderr, "kernel_launch: hipMemsetAsync failed\n"); return; }
    Args a{};
    for (int i = 0; i < 17; ++i) a.in[i] = d_in[i];
    a.out = (float*)d_out; a.ws = (unsigned char*)d_ws;
    void* kargs[] = {&a};
    const hipError_t le = hipLaunchCooperativeKernel((const void*)hymba_fwd, dim3(grid), dim3(NWAVES * 64), kargs, LDS_BYTES, stream);
    if (le != hipSuccess) fprintf(stderr, "kernel_launch: cooperative launch failed: %s (grid %d)\n", hipGetErrorName(le), grid);
}
```

```cpp
#include <hip/hip_runtime.h>
#include <cstdio>
#include <cstdint>
namespace pg8 {
#define PG8_LAS __attribute__((address_space(3)))
typedef unsigned short bf16_t;
typedef short bf16x8 __attribute__((ext_vector_type(8)));
typedef float f32x4 __attribute__((ext_vector_type(4)));
typedef unsigned u32x4 __attribute__((ext_vector_type(4)));
constexpr int BM = 256, BK = 64, HALF = 128, HTB = HALF * BK * 2  , STAGE_BYTES = 8 * HTB, NXCD = 8, WGM = 4;

__host__ __device__ __forceinline__ int lds_byte(int r, int c) { const int st = (r >> 4) * 2 + (c >> 5), rr = r & 15, cc = c & 31, ob = rr * 64 + cc * 2; return st * 1024 + (ob ^ (((ob >> 9) & 1) << 5)); }
__host__ __device__ __forceinline__ void stage_rc(int b, int& R, int& C) { const int st = b / 1024, sb = b % 1024, swz = sb ^ (((sb >> 9) & 1) << 5); R = (st >> 1) * 16 + swz / 64; C = (st & 1) * 32 + (swz % 64) / 2; }
__host__ __device__ __forceinline__ int perm32(int rho) { const int n = rho >> 4, i = rho & 15; return 8 * (i >> 2) + 4 * n + (i & 3); }

struct Unit { int pm, pn; };
struct Gemm { const bf16_t* A; const bf16_t* Bt; int M, N, K; };

struct StaticOrder {
    int nM, nN, nwg, G, c;
    __host__ __device__ void init(int M, int N, int G_, int c_) { nM = M / BM; nN = N / BM; nwg = nM * nN; G = G_; c = c_; }
    __host__ __device__ bool next(int i, Unit& u) const {
        const long L = (long)i * G + c; if (L >= nwg) return false;
        int wgid = (int)L; { const int q = nwg / NXCD, r = nwg % NXCD, xcd = wgid % NXCD, off = wgid / NXCD; wgid = (xcd < r ? xcd * (q + 1) : r * (q + 1) + (xcd - r) * q) + off; }
        const int nig = WGM * nN, gid = wgid / nig, fm = gid * WGM, gsz = (nM - fm) < WGM ? (nM - fm) : WGM;
        u.pm = fm + ((wgid % nig) % gsz); u.pn = (wgid % nig) / gsz; return true;
    }
    __device__ __forceinline__ void a_ready(const Unit&) const {}
    __device__ __forceinline__ void done(const Unit&) const {}
};

__device__ __forceinline__ unsigned cvt_pk_bf16(float lo, float hi) { unsigned r; asm volatile("v_cvt_pk_bf16_f32 %0, %1, %2" : "=v"(r) : "v"(lo), "v"(hi)); return r; }
typedef float f32x2 __attribute__((ext_vector_type(2)));
constexpr float QSCALE = 0.125f * 1.4426950408889634f;
typedef unsigned u32x4 __attribute__((ext_vector_type(4)));
struct EpiQKV {
    static constexpr bool PERM = true, AFTER_DRAIN = false;
    bf16_t* O; const float* rot; const float* rs;
    __device__ __forceinline__ void pre(const Unit& u, int wr, int fr, float (&rsv)[8]) const {
#pragma unroll
        for (int i = 0; i < 8; ++i) rsv[i] = rs[u.pm * BM + wr * 64 + fr + (i >> 2) * HALF + (i & 3) * 16]; }
    __device__ __forceinline__ void operator()(const f32x4 (&acc)[2][2][4][2], const Unit& u, int wr, int wc, int fr, int fq, const float (&rsv)[8]) const {
        const int row0 = u.pm * BM + wr * 64 + fr, col0 = u.pn * BM + wc * 32 + 8 * fq;
        const bool isq = (u.pn < 2) || (u.pn == 6) || (u.pn == 7);
        const float sc = isq ? QSCALE : 1.f;
        const bool rotw = (u.pn < 4) && ((wc & 1) == 0);
        const float sgn = (fq == 0) ? -1.f : 1.f; const bool rotl = fq < 2; const int pidx = (((fq ^ 1) << 4) | fr) << 2;
#pragma unroll
        for (int ai = 0; ai < 2; ++ai)
#pragma unroll
            for (int m = 0; m < 4; ++m) { const int row = row0 + ai * HALF + m * 16; bf16_t* rowp = O + (size_t)row * 3072 + col0; const float scr_ = sc * rsv[ai * 4 + m];
                f32x4 c0 = {1.f, 1.f, 1.f, 1.f}, c1 = c0, s0 = {0.f, 0.f, 0.f, 0.f}, s1 = s0;
                if (rotw) { const f32x4* rp = (const f32x4*)(rot + (size_t)row * 16); c0 = rp[0]; c1 = rp[1]; s0 = rp[2]; s1 = rp[3]; }
#pragma unroll
                for (int bj = 0; bj < 2; ++bj) { f32x4 v0 = acc[ai][bj][m][0], v1 = acc[ai][bj][m][1];
                    if (rotw) { f32x4 p0, p1;
#pragma unroll
                        for (int j = 0; j < 4; ++j) { const float a0 = v0[j], a1 = v1[j]; p0[j] = __int_as_float(__builtin_amdgcn_ds_bpermute(pidx, __float_as_int(a0))); p1[j] = __int_as_float(__builtin_amdgcn_ds_bpermute(pidx, __float_as_int(a1))); }
                        if (rotl) { v0 = v0 * c0 + (p0 * s0) * sgn; v1 = v1 * c1 + (p1 * s1) * sgn; } }
                    v0 = v0 * scr_; v1 = v1 * scr_; u32x4 w; w.x = cvt_pk_bf16(v0[0], v0[1]); w.y = cvt_pk_bf16(v0[2], v0[3]); w.z = cvt_pk_bf16(v1[0], v1[1]); w.w = cvt_pk_bf16(v1[2], v1[3]);
                    *(u32x4*)(rowp + bj * HALF) = w; } }
    }
};
struct EpiY {
    static constexpr bool PERM = true, AFTER_DRAIN = false;
    bf16_t* O; int ldc;
    __device__ __forceinline__ void pre(const Unit&, int, int, float (&rsv)[8]) const {
#pragma unroll
        for (int i = 0; i < 8; ++i) rsv[i] = 1.f; }
    __device__ __forceinline__ void operator()(const f32x4 (&acc)[2][2][4][2], const Unit& u, int wr, int wc, int fr, int fq, const float (&rsv)[8]) const {
        const int row0 = u.pm * BM + wr * 64 + fr, col0 = u.pn * BM + wc * 32 + 8 * fq;
#pragma unroll
        for (int ai = 0; ai < 2; ++ai)
#pragma unroll
            for (int m = 0; m < 4; ++m) { bf16_t* rowp = O + (size_t)(row0 + ai * HALF + m * 16) * ldc + col0;
#pragma unroll
                for (int bj = 0; bj < 2; ++bj) { const f32x4 v0 = acc[ai][bj][m][0], v1 = acc[ai][bj][m][1];
                    u32x4 w; w.x = cvt_pk_bf16(v0[0], v0[1]); w.y = cvt_pk_bf16(v0[2], v0[3]); w.z = cvt_pk_bf16(v1[0], v1[1]); w.w = cvt_pk_bf16(v1[2], v1[3]);
                    *(u32x4*)(rowp + bj * HALF) = w; } }
    }
};
struct EpiSwiGLU {
    static constexpr bool PERM = true, AFTER_DRAIN = false;
    bf16_t* O; int ldc; const float* rs;
    __device__ __forceinline__ void pre(const Unit& u, int wr, int fr, float (&rsv)[8]) const {
#pragma unroll
        for (int i = 0; i < 8; ++i) rsv[i] = rs[u.pm * BM + wr * 64 + fr + (i >> 2) * HALF + (i & 3) * 16]; }
    __device__ __forceinline__ void operator()(const f32x4 (&acc)[2][2][4][2], const Unit& u, int wr, int wc, int fr, int fq, const float (&rsv)[8]) const {
        const int row0 = u.pm * BM + wr * 64 + fr, col0 = u.pn * HALF + wc * 32 + 8 * fq;
#pragma unroll
        for (int ai = 0; ai < 2; ++ai)
#pragma unroll
            for (int m = 0; m < 4; ++m) { bf16_t* rowp = O + (size_t)(row0 + ai * HALF + m * 16) * ldc + col0; float r[8]; const float rr = rsv[ai * 4 + m];
#pragma unroll
                for (int n = 0; n < 2; ++n)
#pragma unroll
                    for (int j = 0; j < 4; ++j) { const float g = acc[ai][0][m][n][j] * rr, up = acc[ai][1][m][n][j] * rr;
                        const float e = __builtin_amdgcn_exp2f(g * -1.4426950408889634f); r[n * 4 + j] = g * __builtin_amdgcn_rcpf(1.0f + e) * up; }
                u32x4 w; w.x = cvt_pk_bf16(r[0], r[1]); w.y = cvt_pk_bf16(r[2], r[3]); w.z = cvt_pk_bf16(r[4], r[5]); w.w = cvt_pk_bf16(r[6], r[7]);
                *(u32x4*)rowp = w; }
    }
};
template <class Epi, class Sched, bool ALIGN_EPI = false, bool SP2 = false>
__device__ __forceinline__ void gemm_phase(PG8_LAS unsigned char* lds, const Gemm g, const Sched& S, const Epi& E, const int tid_in) {
    int tid = tid_in; asm volatile("" : "+v"(tid)); const int wid = __builtin_amdgcn_readfirstlane(tid >> 6), lane = tid & 63, wr = wid >> 2, wc = wid & 3, fr = lane & 15, fq = lane >> 4;
    const int K = g.K, nt = K / BK;
    unsigned voffA[2], voffB[2];
#pragma unroll
    for (int i = 0; i < 2; ++i) { int R, C; stage_rc(tid * 16 + i * 8192, R, C); const int Rb = Epi::PERM ? ((R & ~31) + perm32(R & 31)) : R;
        voffA[i] = (unsigned)(R * K + C) * 2u; voffB[i] = (unsigned)(Rb * K + C) * 2u; }
    const size_t kstep = (size_t)(BK * 2);
    const size_t hstep = (size_t)HALF * K * 2;
    const size_t tstep = 2 * hstep;
    const unsigned ldsw = (unsigned)wid * 1024u;
    const int aoff = lds_byte(wr * 64 + fr, fq * 8), boff = lds_byte(wc * 32 + fr, fq * 8);
#define PG8_SA(b, h) (((b) * 2 + (h)) * HTB)
#define PG8_SB(b, h) ((4 + (b) * 2 + (h)) * HTB)
#define PG8_STAGE(bufoff, gbase, voff) do { _Pragma("unroll") for (int _i = 0; _i < 2; ++_i) \
        __builtin_amdgcn_global_load_lds((const unsigned*)((const char*)(gbase) + (voff)[_i]), (PG8_LAS unsigned*)(lds + (bufoff) + ldsw + _i * 8192), 16, 0, 0); } while (0)
#define PG8_LDA(dst, b, h) do { _Pragma("unroll") for (int m = 0; m < 4; ++m) _Pragma("unroll") for (int k = 0; k < 2; ++k) dst[m][k] = *(const PG8_LAS bf16x8*)(lds + PG8_SA(b, h) + aoff + m * 2048 + k * 1024); } while (0)
#define PG8_LDB(dst, b, h) do { _Pragma("unroll") for (int n = 0; n < 2; ++n) _Pragma("unroll") for (int k = 0; k < 2; ++k) dst[n][k] = *(const PG8_LAS bf16x8*)(lds + PG8_SB(b, h) + boff + n * 2048 + k * 1024); } while (0)
#define PG8_MMA(ai, bj, At, Bt) do { __builtin_amdgcn_s_setprio(1); _Pragma("unroll") for (int m = 0; m < 4; ++m) _Pragma("unroll") for (int n = 0; n < 2; ++n) _Pragma("unroll") for (int k = 0; k < 2; ++k) \
        acc[ai][bj][m][n] = __builtin_amdgcn_mfma_f32_16x16x32_bf16(Bt[n][k], At[m][k], acc[ai][bj][m][n], 0, 0, 0); __builtin_amdgcn_s_setprio(0); } while (0)
#define PG8_WAIT_V(n) asm volatile("s_waitcnt vmcnt(" #n ")" ::: "memory")
#define PG8_WAIT_L(n) asm volatile("s_waitcnt lgkmcnt(" #n ")" ::: "memory")
#define PG8_BAR __builtin_amdgcn_s_barrier()
#define PG8_SCHED __builtin_amdgcn_sched_barrier(0)
    Unit cur, nxt; int ui = 0;
    if (!S.next(0, cur)) return;
    f32x4 acc[2][2][4][2];
#pragma unroll
    for (int a = 0; a < 2; ++a)
#pragma unroll
        for (int b = 0; b < 2; ++b)
#pragma unroll
            for (int m = 0; m < 4; ++m)
#pragma unroll
                for (int n = 0; n < 2; ++n) acc[a][b][m][n] = (f32x4){0.f, 0.f, 0.f, 0.f};
    bf16x8 At[4][2], B0[2][2], B1[2][2];
    const char* cA = (const char*)g.A + (size_t)cur.pm * tstep; const char* cB = (const char*)g.Bt + (size_t)cur.pn * tstep;
    S.a_ready(cur);
    if constexpr (SP2) {
        PG8_STAGE(PG8_SB(0, 0), cB, voffB); PG8_STAGE(PG8_SB(0, 1), cB + hstep, voffB); PG8_STAGE(PG8_SA(0, 0), cA, voffA); PG8_STAGE(PG8_SA(0, 1), cA + hstep, voffA);
        if (wr == 1) PG8_BAR;
        PG8_WAIT_V(2); PG8_BAR;
        PG8_STAGE(PG8_SB(1, 0), cB + kstep, voffB); PG8_STAGE(PG8_SA(1, 0), cA + kstep, voffA); PG8_STAGE(PG8_SB(1, 1), cB + hstep + kstep, voffB);
        PG8_WAIT_V(6); PG8_BAR;
    } else {
        PG8_STAGE(PG8_SB(0, 0), cB, voffB); PG8_STAGE(PG8_SA(0, 0), cA, voffA); PG8_STAGE(PG8_SB(0, 1), cB + hstep, voffB); PG8_STAGE(PG8_SA(0, 1), cA + hstep, voffA);
        if (wr == 1) PG8_BAR;
        PG8_WAIT_V(4); PG8_BAR;
        PG8_STAGE(PG8_SB(1, 0), cB + kstep, voffB); PG8_STAGE(PG8_SA(1, 0), cA + kstep, voffA); PG8_STAGE(PG8_SB(1, 1), cB + hstep + kstep, voffB);
        PG8_WAIT_V(6); PG8_BAR;
    }
    for (;;) {
        float rsv[8]; E.pre(cur, wr, fr, rsv);
        const bool has_next = S.next(ui + 1, nxt);
        const char* nA = has_next ? (const char*)g.A + (size_t)nxt.pm * tstep : cA; const char* nB = has_next ? (const char*)g.Bt + (size_t)nxt.pn * tstep : cB;
        for (int t = 0; t < nt; t += 2) {
            const bool last = (t == nt - 2);
            const char* a1 = cA + (size_t)(t + 1) * kstep;
            const char* a2 = last ? nA : cA + (size_t)(t + 2) * kstep; const char* b2 = last ? nB : cB + (size_t)(t + 2) * kstep;
            const char* a3 = a2 + kstep; const char* b3 = b2 + kstep;
            if (last && has_next) S.a_ready(nxt);
            if constexpr (SP2) {
            PG8_LDB(B0, 0, 0); PG8_LDB(B1, 0, 1); PG8_SCHED; PG8_LDA(At, 0, 0); PG8_STAGE(PG8_SA(1, 1), a1 + hstep, voffA);
            PG8_WAIT_V(8); PG8_WAIT_L(0); PG8_BAR; PG8_MMA(0, 0, At, B0); PG8_MMA(0, 1, At, B1); PG8_BAR; PG8_SCHED;
            PG8_LDA(At, 0, 1); PG8_STAGE(PG8_SB(0, 0), b2, voffB); PG8_STAGE(PG8_SB(0, 1), b2 + hstep, voffB); PG8_STAGE(PG8_SA(0, 0), a2, voffA);
            PG8_WAIT_V(8); PG8_WAIT_L(0); PG8_BAR; PG8_MMA(1, 0, At, B0); PG8_MMA(1, 1, At, B1); PG8_BAR; PG8_SCHED;
            PG8_LDB(B0, 1, 0); PG8_LDB(B1, 1, 1); PG8_SCHED; PG8_LDA(At, 1, 0); PG8_STAGE(PG8_SA(0, 1), a2 + hstep, voffA);
            PG8_WAIT_V(8); PG8_WAIT_L(0); PG8_BAR; PG8_MMA(0, 0, At, B0); PG8_MMA(0, 1, At, B1); PG8_BAR; PG8_SCHED;
            PG8_LDA(At, 1, 1); PG8_STAGE(PG8_SB(1, 0), b3, voffB); PG8_STAGE(PG8_SB(1, 1), b3 + hstep, voffB); PG8_STAGE(PG8_SA(1, 0), a3, voffA);
            PG8_WAIT_V(8); PG8_WAIT_L(0); PG8_BAR; PG8_MMA(1, 0, At, B0); PG8_MMA(1, 1, At, B1); PG8_BAR; PG8_SCHED;
            } else {
            PG8_LDB(B0, 0, 0); PG8_SCHED; PG8_LDA(At, 0, 0); PG8_STAGE(PG8_SA(1, 1), a1 + hstep, voffA);
            PG8_WAIT_L(8); PG8_BAR; PG8_WAIT_L(0); PG8_MMA(0, 0, At, B0); PG8_BAR; PG8_SCHED;
            PG8_LDB(B1, 0, 1); PG8_STAGE(PG8_SB(0, 0), b2, voffB);
            PG8_BAR; PG8_WAIT_L(0); PG8_MMA(0, 1, At, B1); PG8_BAR;
            PG8_LDA(At, 0, 1); PG8_STAGE(PG8_SA(0, 0), a2, voffA);
            PG8_BAR; PG8_WAIT_L(0); PG8_MMA(1, 0, At, B0); PG8_BAR; PG8_SCHED;
            PG8_STAGE(PG8_SB(0, 1), b2 + hstep, voffB);
            PG8_WAIT_V(6); PG8_BAR; PG8_MMA(1, 1, At, B1); PG8_BAR;
            PG8_LDB(B0, 1, 0); PG8_SCHED; PG8_LDA(At, 1, 0); PG8_STAGE(PG8_SA(0, 1), a2 + hstep, voffA);
            PG8_WAIT_L(8); PG8_BAR; PG8_WAIT_L(0); PG8_MMA(0, 0, At, B0); PG8_BAR; PG8_SCHED;
            PG8_LDB(B1, 1, 1); PG8_STAGE(PG8_SB(1, 0), b3, voffB);
            PG8_BAR; PG8_WAIT_L(0); PG8_MMA(0, 1, At, B1); PG8_BAR;
            PG8_LDA(At, 1, 1); PG8_STAGE(PG8_SA(1, 0), a3, voffA);
            PG8_BAR; PG8_WAIT_L(0); PG8_MMA(1, 0, At, B0); PG8_BAR; PG8_SCHED;
            PG8_STAGE(PG8_SB(1, 1), b3 + hstep, voffB);
            PG8_WAIT_V(6); PG8_BAR; PG8_MMA(1, 1, At, B1); PG8_BAR;
            }
        }
        if constexpr (ALIGN_EPI) { if (wr == 0) PG8_BAR; }
        if constexpr (!Epi::AFTER_DRAIN) { E(acc, cur, wr, wc, fr, fq, rsv); S.done(cur); }
        if (!has_next) break;
#pragma unroll
        for (int a = 0; a < 2; ++a)
#pragma unroll
            for (int b = 0; b < 2; ++b)
#pragma unroll
                for (int m = 0; m < 4; ++m)
#pragma unroll
                    for (int n = 0; n < 2; ++n) acc[a][b][m][n] = (f32x4){0.f, 0.f, 0.f, 0.f};
        cur = nxt; cA = nA; cB = nB; ++ui;
        if constexpr (ALIGN_EPI) { if (wr == 1) PG8_BAR; }
    }
    PG8_WAIT_V(0);
    if constexpr (!ALIGN_EPI) { if (wr == 0) PG8_BAR; }
    PG8_BAR;
    if constexpr (Epi::AFTER_DRAIN) { E.fused(acc, cur, wr, wc, fr, fq, lds, wid, lane); S.done(cur); }
#undef PG8_SA
#undef PG8_SB
#undef PG8_STAGE
#undef PG8_LDA
#undef PG8_LDB
#undef PG8_MMA
#undef PG8_WAIT_V
#undef PG8_WAIT_L
#undef PG8_BAR
#undef PG8_SCHED
}
}

#ifndef PG8_SP2
#define PG8_SP2 true
#endif
#ifndef PG8_ALIGN
#define PG8_ALIGN true
#endif
#include <hip/hip_bf16.h>
#include <cmath>
namespace attn_body {
using bf16=__hip_bfloat16;
using bf16x8=__attribute__((ext_vector_type(8)))short;
using s16x4=__attribute__((ext_vector_type(4)))short;
using f32x16=__attribute__((ext_vector_type(16)))float;
using u32x4=__attribute__((ext_vector_type(4)))unsigned;
constexpr int BATCH=4,SEQ=8192,D=64,DMI=3072,DMO=1024;
constexpr int NW=8,QBLK=32,QB=QBLK*NW,KVBLK=64,NQB=SEQ/QB;
constexpr int ATTN_UNIT_ROWS=QB;
__device__ __forceinline__ int crow(int r,int hi){return (r&3)+8*(r>>2)+4*hi;}
#define SBAR() __builtin_amdgcn_sched_barrier(0)
__device__ __forceinline__ void cmask(f32x16&p0,f32x16&p1,int jb,int qrel,int hi){
  const float NEG=-INFINITY; int kb=64*jb+4*hi;
  #pragma unroll
  for(int r=0;r<16;++r){int kv=kb+(r&3)+8*(r>>2); if(kv>qrel)p0[r]=NEG; if(kv+32>qrel)p1[r]=NEG;}
}

constexpr int NSLOT=3, SLOTB=8192;
constexpr int LDS_K=0, LDS_V=NSLOT*SLOTB, LDS_WS=2*NSLOT*SLOTB, LDS_OST=LDS_WS+NW*64*4, LDS_BIAS=LDS_OST+NW*4096, LDS_BYTES=LDS_BIAS+SEQ*4;
constexpr float C2=0.125f*1.4426950408889634f;
__device__ __forceinline__ void glds16(const void*gsrc,unsigned lds_dst){unsigned keep;
  asm volatile("s_mov_b32 %0, m0\n\ts_mov_b32 m0, %2\n\ts_nop 0\n\tglobal_load_lds_dwordx4 %1, off\n\ts_mov_b32 m0, %0":"=&s"(keep):"v"(gsrc),"s"(lds_dst):"memory");}
__device__ __forceinline__ float max3f(float a,float b,float c){float r;asm("v_max3_f32 %0, %1, %2, %3":"=v"(r):"v"(a),"v"(b),"v"(c));return r;}
__device__ __forceinline__ float max2f(float a,float b){float r;asm("v_max_f32_e32 %0, %1, %2":"=v"(r):"v"(a),"v"(b));return r;}
__device__ __forceinline__ float fadd_s(float a,float b){float r;asm("v_add_f32_e32 %0, %1, %2":"=v"(r):"v"(a),"v"(b));return r;}
__device__ __forceinline__ float fsub_s(float a,float b){float r;asm("v_sub_f32_e32 %0, %1, %2":"=v"(r):"v"(a),"v"(b));return r;}
typedef float f32x2_t __attribute__((ext_vector_type(2))); typedef __bf16 bf16x2_t __attribute__((ext_vector_type(2)));
__device__ __forceinline__ unsigned cvtpk_s(float lo,float hi){f32x2_t v={lo,hi};bf16x2_t b=__builtin_convertvector(v,bf16x2_t);return __builtin_bit_cast(unsigned,b);}
#define WAIT_BAR(N) asm volatile("s_waitcnt vmcnt(" #N ") lgkmcnt(0)\n\ts_barrier":::"memory")

__device__ __forceinline__ void qkt(f32x16&p0,f32x16&p1,const char*Kslot,const bf16x8*qr,const f32x16&negm,int r32,int hi){
  const char*kb=Kslot+hi*1024+r32*16;
  #pragma unroll
  for(int d0=0;d0<4;++d0){
    const bf16x8 b0=*reinterpret_cast<const bf16x8*>(kb+d0*2048);
    const bf16x8 b1=*reinterpret_cast<const bf16x8*>(kb+d0*2048+512);
    if(d0==0){p0=__builtin_amdgcn_mfma_f32_32x32x16_bf16(b0,qr[0],negm,0,0,0);p1=__builtin_amdgcn_mfma_f32_32x32x16_bf16(b1,qr[0],negm,0,0,0);}
    else{p0=__builtin_amdgcn_mfma_f32_32x32x16_bf16(b0,qr[d0],p0,0,0,0);p1=__builtin_amdgcn_mfma_f32_32x32x16_bf16(b1,qr[d0],p1,0,0,0);}}
}
typedef __attribute__((address_space(3))) const char* lds_cptr;
typedef short v4i16_t __attribute__((ext_vector_type(4)));
__device__ __forceinline__ void kload8(bf16x8*kf,lds_cptr kp){
  kf[0]=*(const __attribute__((address_space(3))) bf16x8*)(kp);      kf[1]=*(const __attribute__((address_space(3))) bf16x8*)(kp+512);
  kf[2]=*(const __attribute__((address_space(3))) bf16x8*)(kp+2048); kf[3]=*(const __attribute__((address_space(3))) bf16x8*)(kp+2560);
  kf[4]=*(const __attribute__((address_space(3))) bf16x8*)(kp+4096); kf[5]=*(const __attribute__((address_space(3))) bf16x8*)(kp+4608);
  kf[6]=*(const __attribute__((address_space(3))) bf16x8*)(kp+6144); kf[7]=*(const __attribute__((address_space(3))) bf16x8*)(kp+6656);
}
__device__ __forceinline__ void kload2(bf16x8*kf,lds_cptr kp,int j){ kf[2*j]=*(const __attribute__((address_space(3))) bf16x8*)(kp+j*2048); kf[2*j+1]=*(const __attribute__((address_space(3))) bf16x8*)(kp+j*2048+512); }
__device__ __forceinline__ s16x4 vtr(lds_cptr p){ return __builtin_bit_cast(s16x4,__builtin_amdgcn_ds_read_tr16_b64_v4i16((__attribute__((address_space(3))) v4i16_t*)p)); }
__device__ __forceinline__ float rowmax(const f32x16&p0,const f32x16&p1){
  float a=max3f(p0[0],p0[1],p1[0]),b=max3f(p0[2],p0[3],p1[1]);a=max3f(a,p1[2],p1[3]);
  #pragma unroll
  for(int r=4;r<16;r+=4){a=max3f(a,p0[r],p0[r+1]);b=max3f(b,p0[r+2],p0[r+3]);a=max3f(a,p1[r],p1[r+1]);b=max3f(b,p1[r+2],p1[r+3]);}
  const float m=max2f(a,b);
  auto rr=__builtin_amdgcn_permlane32_swap(__float_as_uint(m),__float_as_uint(m),false,false);
  return max2f(__uint_as_float(rr[0]),__uint_as_float(rr[1]));
}
__device__ __forceinline__ void pv(f32x16*o,int vb,bf16x8 pa0,bf16x8 pa1,bf16x8 pa2,bf16x8 pa3){
  #pragma unroll
  for(int d0=0;d0<2;++d0){s16x4 lo[4],hi[4];
    #pragma unroll
    for(int ks=0;ks<4;++ks){
      asm volatile("ds_read_b64_tr_b16 %0,%1 offset:%c2":"=&v"(lo[ks]):"v"(vb),"i"(d0*4096+ks*1024):"memory");
      asm volatile("ds_read_b64_tr_b16 %0,%1 offset:%c2":"=&v"(hi[ks]):"v"(vb),"i"(d0*4096+ks*1024+512):"memory");}
    asm volatile("s_waitcnt lgkmcnt(0)":::"memory");SBAR();
    #define PK(k) (bf16x8){lo[k][0],lo[k][1],lo[k][2],lo[k][3],hi[k][0],hi[k][1],hi[k][2],hi[k][3]}
    o[d0]=__builtin_amdgcn_mfma_f32_32x32x16_bf16(pa0,PK(0),o[d0],0,0,0);
    o[d0]=__builtin_amdgcn_mfma_f32_32x32x16_bf16(pa1,PK(1),o[d0],0,0,0);
    o[d0]=__builtin_amdgcn_mfma_f32_32x32x16_bf16(pa2,PK(2),o[d0],0,0,0);
    o[d0]=__builtin_amdgcn_mfma_f32_32x32x16_bf16(pa3,PK(3),o[d0],0,0,0);
    #undef PK
  }
}

#ifndef ATTN_STORE16
#define ATTN_STORE16(p,v) (*(u32x4*)(p)=(v))
#endif
template<int THRL,bool BIAS> __device__ __forceinline__ void attn_unit(int b,int qb,const bf16*Q,const bf16*__restrict__ K,const bf16*__restrict__ V,bf16*O,const float*__restrict__ biasg,char*shm,const int tid_in){
  int tid=tid_in; asm volatile("":"+v"(tid)); const int lane=tid&63,r32=lane&31,hi=lane>>5; const int wid=__builtin_amdgcn_readfirstlane(tid>>6);
  const long rowbase=(long)b*SEQ; const int q0=qb*QB;
  const bf16*Qw=Q+(rowbase+q0+wid*QBLK)*DMI;
  int t0=0;
  if(BIAS){ const int NT0=(q0+QB)/KVBLK; const float bq=biasg[q0]; int cnt=0;
    _Pragma("unroll") for(int h2=0;h2<2;++h2){ const int T=lane+64*h2; const bool sk=(T<NT0-4)&&(biasg[64*(T<NT0?T:0)+63]-bq<-64.f); cnt+=__popcll(__ballot(sk)); }
    t0=__builtin_amdgcn_readfirstlane(cnt)&~1; }
  const float*bg=BIAS?biasg+t0*KVBLK:biasg;
  const bf16*Kh=K+(rowbase+t0*KVBLK)*DMI,*Vh=V+(rowbase+t0*KVBLK)*DMI;
  const unsigned lds0=(unsigned)(uintptr_t)shm;
  float*wsf=(float*)(shm+LDS_WS)+wid*64;
  const bf16*ksrc=Kh+(long)lane*DMI+wid*8;
  const bf16*vsrc=Vh+(long)(16*(wid&3)+(lane>>2))*DMI+(wid>>2)*32+(lane&3)*8;
  const unsigned kdst=lds0+LDS_K+wid*1024, vdst=lds0+LDS_V+wid*1024;
  #define DMA_K(t,slot) glds16(ksrc+(long)(t)*KVBLK*DMI,(unsigned)__builtin_amdgcn_readfirstlane(kdst+(slot)))
  #define DMA_V(t,slot) glds16(vsrc+(long)(t)*KVBLK*DMI,(unsigned)__builtin_amdgcn_readfirstlane(vdst+(slot)))
  const int vb0=(int)(lds0+LDS_V)+((lane>>4)&1)*32+(lane&3)*8+(4*hi+((lane&15)>>2))*64;
  const char*Kbase=shm+LDS_K; bf16x8 kf[8];
  const lds_cptr shm3=(lds_cptr)shm; const lds_cptr kp0=shm3+LDS_K+hi*1024+r32*16; const lds_cptr vp0=shm3+LDS_V+((lane>>4)&1)*32+(lane&3)*8+(4*hi+((lane&15)>>2))*64;
  const int NT=(q0+QB)/KVBLK-t0;
  typedef __attribute__((address_space(3))) const float* lds_fptr; typedef float f32x4_t __attribute__((ext_vector_type(4)));
  const lds_fptr biasl=(lds_fptr)(shm3+LDS_BIAS)+4*hi;
  if(BIAS){ __attribute__((address_space(3))) float* bw=(__attribute__((address_space(3))) float*)(shm3+LDS_BIAS); const int nb=NT*KVBLK;
    for(int i=tid*4;i<nb;i+=NW*64*4)*(__attribute__((address_space(3))) f32x4_t*)(bw+i)=*(const f32x4_t*)(bg+i); }
  #define BIASADD(P0,P1,t) do{ if(BIAS){ const lds_fptr bp_=biasl+KVBLK*(t); _Pragma("unroll") for(int i_=0;i_<4;++i_){ \
      const f32x4_t b0_=*(const __attribute__((address_space(3))) f32x4_t*)(bp_+8*i_), b1_=*(const __attribute__((address_space(3))) f32x4_t*)(bp_+32+8*i_); \
      _Pragma("unroll") for(int j_=0;j_<4;++j_){ P0[4*i_+j_]+=b0_[j_]; P1[4*i_+j_]+=b1_[j_]; } } } }while(0)
  DMA_K(0,0);DMA_V(0,0);DMA_K(1,SLOTB);
  bf16x8 qr[4];
  #pragma unroll
  for(int d0=0;d0<4;++d0)qr[d0]=*reinterpret_cast<const bf16x8*>(&Qw[(long)r32*DMI+d0*16+hi*8]);
  float mhat=0.f,l_reg=0.f;f32x16 o[2];o[0]=f32x16{};o[1]=f32x16{};f32x16 negm=f32x16{};asm volatile("":"+v"(negm));
  const int qrel=wid*QBLK+r32;
  #define CMASK(P0,P1,t) do{int jb_=(t)-(NT-4); if(jb_>=0)cmask(P0,P1,jb_,qrel,hi);}while(0)
  bool resc=false;
  #define START(P0,P1) do{ const float rm=rowmax(P0,P1); resc=false; \
    { const float dl=rm; mhat=fadd_s(mhat,dl); \
      _Pragma("unroll") for(int r=0;r<16;++r){P0[r]=fsub_s(P0[r],dl);P1[r]=fsub_s(P1[r],dl);} \
      _Pragma("unroll") for(int r=0;r<16;++r)negm[r]=-mhat; asm volatile("":"+v"(negm)); } \
    _Pragma("unroll") for(int r=0;r<16;++r)P0[r]=__builtin_amdgcn_exp2f(P0[r]); }while(0)
  #define RESC() do{ if(resc){ asm volatile("s_waitcnt lgkmcnt(0)":::"memory"); \
      _Pragma("unroll") for(int d_=0;d_<2;++d_) _Pragma("unroll") for(int r=0;r<16;++r)o[d_][r]*=wsf[crow(r,hi)]; } }while(0)
  f32x16 pA0,pA1,pB0,pB1;
  int sl_prev=0,sl_cur=0,sl_next=SLOTB;
  #define ROT() do{sl_prev=sl_cur;sl_cur=sl_next;sl_next=(sl_next==(NSLOT-1)*SLOTB)?0:sl_next+SLOTB;}while(0)
  DMA_K(2,2*SLOTB);
  WAIT_BAR(3);
  qkt(pA0,pA1,Kbase,qr,negm,r32,hi);asm volatile("s_nop 15\n\ts_nop 7":"+v"(pA0),"+v"(pA1));BIASADD(pA0,pA1,0);CMASK(pA0,pA1,0);
  START(pA0,pA1);
  _Pragma("unroll") for(int r=0;r<16;++r)pA1[r]=__builtin_amdgcn_exp2f(pA1[r]);
  WAIT_BAR(0);
  DMA_K(3,0);DMA_V(1,SLOTB);
  ROT();
  kload8(kf,kp0+sl_cur);
  WAIT_BAR(2);
  s16x4 vlo[8],vhi[8]; u32x4 pw0,pw1,pw2,pw3;
  #define PKW(P,B) cvtpk_s(P[B],P[B+1])
  #define PAF(k) __builtin_bit_cast(bf16x8,pw##k)
  #define VFR(i) (bf16x8){vlo[i][0],vlo[i][1],vlo[i][2],vlo[i][3],vhi[i][0],vhi[i][1],vhi[i][2],vhi[i][3]}
  #define PIN(x) asm volatile("":"+v"(x))
  #define MX3(a,b,c) __builtin_fmaxf(__builtin_fmaxf((a),(b)),(c))
  #define GAPA(MF,A0,A1,A2,A3,W0,W1,PW) do{ MF; sacc+=A0; sacc+=A1; sacc+=A2; sacc+=A3; PIN(sacc); W0; W1; PIN(PW); SBAR(); }while(0)
  #define EX(v) __builtin_amdgcn_exp2f(v)
  #define GAPB(MF,X,B) do{ MF; X[B]=EX(X[B]); X[B+1]=EX(X[B+1]); X[B+2]=EX(X[B+2]); X[B+3]=EX(X[B+3]); PIN(X); SBAR(); }while(0)
  #define VRD(i) do{ vlo[i]=vtr(vp_+(((i)>>2)*4096+((i)&3)*1024)); vhi[i]=vtr(vp_+(((i)>>2)*4096+((i)&3)*1024+512)); }while(0)
  #define KRD(G,j) do{ if(G){ kload2(kf,kp0+sl_next,j); SBAR(); } }while(0)
  #define STEP(C0,C1,P0,P1,t,GK,GV,GL) do{ SBAR(); \
    const lds_cptr vp_=vp0+sl_prev; \
    VRD(0); SBAR(); float sacc=(P0[0]+P0[1]); \
    GAPA(C0=__builtin_amdgcn_mfma_f32_32x32x16_bf16(kf[0],qr[0],negm,0,0,0), P0[2],P0[3],P0[4],P0[5],     pw0[0]=PKW(P0,0), pw0[1]=PKW(P0,2), pw0); \
    VRD(4); SBAR(); GAPA(C1=__builtin_amdgcn_mfma_f32_32x32x16_bf16(kf[1],qr[0],negm,0,0,0), P0[6],P0[7],P0[8],P0[9],     pw0[2]=PKW(P0,4), pw0[3]=PKW(P0,6), pw0); \
    VRD(1); SBAR(); GAPA(C0=__builtin_amdgcn_mfma_f32_32x32x16_bf16(kf[2],qr[1],C0,0,0,0),   P0[10],P0[11],P0[12],P0[13], pw1[0]=PKW(P0,8), pw1[1]=PKW(P0,10), pw1); \
    VRD(5); SBAR(); GAPA(C1=__builtin_amdgcn_mfma_f32_32x32x16_bf16(kf[3],qr[1],C1,0,0,0),   P0[14],P0[15],P1[0],P1[1],   pw1[2]=PKW(P0,12),pw1[3]=PKW(P0,14), pw1); \
    VRD(2); SBAR(); GAPA(C0=__builtin_amdgcn_mfma_f32_32x32x16_bf16(kf[4],qr[2],C0,0,0,0),   P1[2],P1[3],P1[4],P1[5],     pw2[0]=PKW(P1,0), pw2[1]=PKW(P1,2), pw2); \
    VRD(6); SBAR(); GAPA(C1=__builtin_amdgcn_mfma_f32_32x32x16_bf16(kf[5],qr[2],C1,0,0,0),   P1[6],P1[7],P1[8],P1[9],     pw2[2]=PKW(P1,4), pw2[3]=PKW(P1,6), pw2); \
    VRD(3); SBAR(); GAPA(C0=__builtin_amdgcn_mfma_f32_32x32x16_bf16(kf[6],qr[3],C0,0,0,0),   P1[10],P1[11],P1[12],P1[13], pw3[0]=PKW(P1,8), pw3[1]=PKW(P1,10), pw3); \
    VRD(7); SBAR(); GAPA(C1=__builtin_amdgcn_mfma_f32_32x32x16_bf16(kf[7],qr[3],C1,0,0,0),   P1[14],P1[15],0.f,0.f,       pw3[2]=PKW(P1,12),pw3[3]=PKW(P1,14), pw3); \
    l_reg+=sacc; \
    if(GK){DMA_K((t)+3,sl_cur);} if(GV){DMA_V((t)+1,sl_next);} \
    BIASADD(C0,C1,t); CMASK(C0,C1,t); \
    { float a=MX3(C0[0],C0[1],C1[0]),b=MX3(C0[2],C0[3],C1[1]); a=MX3(a,C1[2],C1[3]); \
      _Pragma("unroll") for(int r=4;r<16;r+=4){a=MX3(a,C0[r],C0[r+1]);b=MX3(b,C0[r+2],C0[r+3]);a=MX3(a,C1[r],C1[r+1]);b=MX3(b,C1[r+2],C1[r+3]);} \
      float rm=__builtin_fmaxf(a,b); { auto rr=__builtin_amdgcn_permlane32_swap(__float_as_uint(rm),__float_as_uint(rm),false,false); rm=__builtin_fmaxf(__uint_as_float(rr[0]),__uint_as_float(rr[1])); } \
      resc=false; \
      if(__builtin_expect(__any(rm>(float)THRL),0)){ const float dl=__builtin_fmaxf(rm,0.f); mhat+=dl; \
        _Pragma("unroll") for(int r=0;r<16;++r){C0[r]-=dl;C1[r]-=dl;} \
        _Pragma("unroll") for(int r=0;r<16;++r)negm[r]=-mhat; asm volatile("":"+v"(negm)); \
        const float f=__builtin_amdgcn_exp2f(-dl); l_reg*=f; if(hi==0)wsf[r32]=f; resc=true; } } \
    SBAR(); \
    GAPB(o[0]=__builtin_amdgcn_mfma_f32_32x32x16_bf16(PAF(0),VFR(0),o[0],0,0,0), C0,0); \
    GAPB(o[1]=__builtin_amdgcn_mfma_f32_32x32x16_bf16(PAF(0),VFR(4),o[1],0,0,0), C0,4); \
    KRD(GL,0); GAPB(o[0]=__builtin_amdgcn_mfma_f32_32x32x16_bf16(PAF(1),VFR(1),o[0],0,0,0), C0,8); \
    KRD(GL,1); GAPB(o[1]=__builtin_amdgcn_mfma_f32_32x32x16_bf16(PAF(1),VFR(5),o[1],0,0,0), C0,12); \
    KRD(GL,2); GAPB(o[0]=__builtin_amdgcn_mfma_f32_32x32x16_bf16(PAF(2),VFR(2),o[0],0,0,0), C1,0); \
    KRD(GL,3); GAPB(o[1]=__builtin_amdgcn_mfma_f32_32x32x16_bf16(PAF(2),VFR(6),o[1],0,0,0), C1,4); \
    GAPB(o[0]=__builtin_amdgcn_mfma_f32_32x32x16_bf16(PAF(3),VFR(3),o[0],0,0,0), C1,8); \
    GAPB(o[1]=__builtin_amdgcn_mfma_f32_32x32x16_bf16(PAF(3),VFR(7),o[1],0,0,0), C1,12); \
    }while(0)
  int t=1;
  #undef CMASK
  #define CMASK(P0,P1,t) do{}while(0)
  for(;t+5<NT;t+=2){
    STEP(pB0,pB1,pA0,pA1,t,true,true,true);     WAIT_BAR(2); RESC(); ROT();
    STEP(pA0,pA1,pB0,pB1,t+1,true,true,true);   WAIT_BAR(2); RESC(); ROT();
  }
  #undef CMASK
  #define CMASK(P0,P1,t) do{int jb_=(t)-(NT-4); if(jb_>=0)cmask(P0,P1,jb_,qrel,hi);}while(0)
  #define ENDW(tt) do{ if((tt)+3<NT){WAIT_BAR(2);} else if((tt)+2<NT){WAIT_BAR(1);} else {WAIT_BAR(0);} }while(0)
  for(;t+1<NT;t+=2){
    STEP(pB0,pB1,pA0,pA1,t,(t+3<NT),(t+1<NT),(t+1<NT));       ENDW(t);   RESC(); ROT();
    STEP(pA0,pA1,pB0,pB1,t+1,(t+4<NT),(t+2<NT),(t+2<NT));     ENDW(t+1); RESC(); ROT();
  }
  STEP(pB0,pB1,pA0,pA1,NT-1,false,false,false); RESC();
  { float sacc=pB0[0]+pB0[1]; _Pragma("unroll") for(int r=2;r<16;++r)sacc+=pB0[r]; _Pragma("unroll") for(int r=0;r<16;++r)sacc+=pB1[r]; l_reg+=sacc;
    pw0=(u32x4){PKW(pB0,0),PKW(pB0,2),PKW(pB0,4),PKW(pB0,6)};pw1=(u32x4){PKW(pB0,8),PKW(pB0,10),PKW(pB0,12),PKW(pB0,14)};pw2=(u32x4){PKW(pB1,0),PKW(pB1,2),PKW(pB1,4),PKW(pB1,6)};pw3=(u32x4){PKW(pB1,8),PKW(pB1,10),PKW(pB1,12),PKW(pB1,14)};
    SBAR(); pv(o,vb0+sl_cur,PAF(0),PAF(1),PAF(2),PAF(3)); }
  #undef PKW
  #undef PAF
  #undef VFR
  #undef PIN
  #undef MX3
  #undef GAPA
  #undef GAPB
  #undef EX
  #undef VRD
  #undef KRD
  #undef STEP
  #undef ENDW
  {auto rr=__builtin_amdgcn_permlane32_swap(__float_as_uint(l_reg),__float_as_uint(l_reg),false,false);l_reg=__uint_as_float(rr[0])+__uint_as_float(rr[1]);}
  if(hi==0)wsf[32+r32]=l_reg;asm volatile("s_waitcnt lgkmcnt(0)":::"memory");
  float rli[16];
  #pragma unroll
  for(int r=0;r<16;++r)rli[r]=__builtin_amdgcn_rcpf(wsf[32+crow(r,hi)]);
  bf16*Ow=O+(rowbase+q0+wid*QBLK)*DMO;
  { bf16*stg=(bf16*)(shm+LDS_OST)+wid*2048;
    #pragma unroll
    for(int r=0;r<16;++r){const int orow=crow(r,hi);
      #pragma unroll
      for(int d0=0;d0<2;++d0)stg[orow*64+d0*32+r32]=__float2bfloat16(o[d0][r]*rli[r]);}
    asm volatile("s_waitcnt lgkmcnt(0)":::"memory");
    #pragma unroll
    for(int i=0;i<4;++i){const int row=i*8+(lane>>3),ch=lane&7; const u32x4 v=*(const u32x4*)(stg+row*64+ch*8); ATTN_STORE16(Ow+(long)row*DMO+ch*8,v);} }
  asm volatile("s_waitcnt lgkmcnt(0)\n\ts_barrier":::"memory");
  #undef BIASADD
  #undef DMA_K
  #undef DMA_V
  #undef CMASK
  #undef START
  #undef RESC
  #undef ROT
}
constexpr int ATTN_LDS_BYTES=LDS_BYTES;
#undef SBAR
#undef WAIT_BAR
}
#include <hip/hip_bf16.h>
#include <cmath>
namespace attn128 {
using bf16=__hip_bfloat16;
using bf16x8=__attribute__((ext_vector_type(8)))short;
using s16x4=__attribute__((ext_vector_type(4)))short;
using f32x16=__attribute__((ext_vector_type(16)))float;
using u32x4=__attribute__((ext_vector_type(4)))unsigned;
constexpr int BATCH=4,SEQ=8192,D=64,DMI=3072,DMO=1024;
constexpr int NW=8,QBLK=32,QB=QBLK*NW,KVBLK=64,NQB=SEQ/QB;
constexpr int ATTN_UNIT_ROWS=QB;
__device__ __forceinline__ int crow(int r,int hi){return (r&3)+8*(r>>2)+4*hi;}
#define SBAR() __builtin_amdgcn_sched_barrier(0)
__device__ __forceinline__ void cmask(f32x16&p0,f32x16&p1,int jb,int qrel,int hi){
  const float NEG=-INFINITY; int kb=64*jb+4*hi;
  #pragma unroll
  for(int r=0;r<16;++r){int kv=kb+(r&3)+8*(r>>2); if(kv>qrel)p0[r]=NEG; if(kv+32>qrel)p1[r]=NEG;}
}

constexpr int NSLOT=3, SLOTB=8192;
constexpr int VSLOTB=2*SLOTB; constexpr int LDS_K=0, LDS_V=NSLOT*SLOTB, LDS_WS=LDS_V+NSLOT*VSLOTB, LDS_OST=LDS_WS+NW*64*4, LDS_BIAS=LDS_OST+NW*4096, LDS_BYTES=LDS_BIAS;
constexpr float C2=0.125f*1.4426950408889634f;
__device__ __forceinline__ void glds16(const void*gsrc,unsigned lds_dst){unsigned keep;
  asm volatile("s_mov_b32 %0, m0\n\ts_mov_b32 m0, %2\n\ts_nop 0\n\tglobal_load_lds_dwordx4 %1, off\n\ts_mov_b32 m0, %0":"=&s"(keep):"v"(gsrc),"s"(lds_dst):"memory");}
__device__ __forceinline__ float max3f(float a,float b,float c){float r;asm("v_max3_f32 %0, %1, %2, %3":"=v"(r):"v"(a),"v"(b),"v"(c));return r;}
__device__ __forceinline__ float max2f(float a,float b){float r;asm("v_max_f32_e32 %0, %1, %2":"=v"(r):"v"(a),"v"(b));return r;}
__device__ __forceinline__ float fadd_s(float a,float b){float r;asm("v_add_f32_e32 %0, %1, %2":"=v"(r):"v"(a),"v"(b));return r;}
__device__ __forceinline__ float fsub_s(float a,float b){float r;asm("v_sub_f32_e32 %0, %1, %2":"=v"(r):"v"(a),"v"(b));return r;}
typedef float f32x2_t __attribute__((ext_vector_type(2))); typedef __bf16 bf16x2_t __attribute__((ext_vector_type(2)));
__device__ __forceinline__ unsigned cvtpk_s(float lo,float hi){f32x2_t v={lo,hi};bf16x2_t b=__builtin_convertvector(v,bf16x2_t);return __builtin_bit_cast(unsigned,b);}
#define WAIT_BAR(N) asm volatile("s_waitcnt vmcnt(" #N ") lgkmcnt(0)\n\ts_barrier":::"memory")

__device__ __forceinline__ void qkt(f32x16&p0,f32x16&p1,const char*Kslot,const bf16x8*qr,const f32x16&negm,int r32,int hi){
  const char*kb=Kslot+hi*1024+r32*16;
  #pragma unroll
  for(int d0=0;d0<4;++d0){
    const bf16x8 b0=*reinterpret_cast<const bf16x8*>(kb+d0*2048);
    const bf16x8 b1=*reinterpret_cast<const bf16x8*>(kb+d0*2048+512);
    if(d0==0){p0=__builtin_amdgcn_mfma_f32_32x32x16_bf16(b0,qr[0],negm,0,0,0);p1=__builtin_amdgcn_mfma_f32_32x32x16_bf16(b1,qr[0],negm,0,0,0);}
    else{p0=__builtin_amdgcn_mfma_f32_32x32x16_bf16(b0,qr[d0],p0,0,0,0);p1=__builtin_amdgcn_mfma_f32_32x32x16_bf16(b1,qr[d0],p1,0,0,0);}}
}
typedef __attribute__((address_space(3))) const char* lds_cptr;
typedef short v4i16_t __attribute__((ext_vector_type(4)));
__device__ __forceinline__ void kload8(bf16x8*kf,lds_cptr kp){
  kf[0]=*(const __attribute__((address_space(3))) bf16x8*)(kp);      kf[1]=*(const __attribute__((address_space(3))) bf16x8*)(kp+512);
  kf[2]=*(const __attribute__((address_space(3))) bf16x8*)(kp+2048); kf[3]=*(const __attribute__((address_space(3))) bf16x8*)(kp+2560);
  kf[4]=*(const __attribute__((address_space(3))) bf16x8*)(kp+4096); kf[5]=*(const __attribute__((address_space(3))) bf16x8*)(kp+4608);
  kf[6]=*(const __attribute__((address_space(3))) bf16x8*)(kp+6144); kf[7]=*(const __attribute__((address_space(3))) bf16x8*)(kp+6656);
}
__device__ __forceinline__ void kload2(bf16x8*kf,lds_cptr kp,int j){ kf[2*j]=*(const __attribute__((address_space(3))) bf16x8*)(kp+j*2048); kf[2*j+1]=*(const __attribute__((address_space(3))) bf16x8*)(kp+j*2048+512); }
__device__ __forceinline__ s16x4 vtr(lds_cptr p){ return __builtin_bit_cast(s16x4,__builtin_amdgcn_ds_read_tr16_b64_v4i16((__attribute__((address_space(3))) v4i16_t*)p)); }
__device__ __forceinline__ float rowmax(const f32x16&p0,const f32x16&p1){
  float a=max3f(p0[0],p0[1],p1[0]),b=max3f(p0[2],p0[3],p1[1]);a=max3f(a,p1[2],p1[3]);
  #pragma unroll
  for(int r=4;r<16;r+=4){a=max3f(a,p0[r],p0[r+1]);b=max3f(b,p0[r+2],p0[r+3]);a=max3f(a,p1[r],p1[r+1]);b=max3f(b,p1[r+2],p1[r+3]);}
  const float m=max2f(a,b);
  auto rr=__builtin_amdgcn_permlane32_swap(__float_as_uint(m),__float_as_uint(m),false,false);
  return max2f(__uint_as_float(rr[0]),__uint_as_float(rr[1]));
}
__device__ __forceinline__ void pv(f32x16*o,int vb,bf16x8 pa0,bf16x8 pa1,bf16x8 pa2,bf16x8 pa3){
  #pragma unroll
  for(int d0=0;d0<2;++d0){s16x4 lo[4],hi[4];
    #pragma unroll
    for(int ks=0;ks<4;++ks){
      asm volatile("ds_read_b64_tr_b16 %0,%1 offset:%c2":"=&v"(lo[ks]):"v"(vb),"i"(d0*4096+ks*1024):"memory");
      asm volatile("ds_read_b64_tr_b16 %0,%1 offset:%c2":"=&v"(hi[ks]):"v"(vb),"i"(d0*4096+ks*1024+512):"memory");}
    asm volatile("s_waitcnt lgkmcnt(0)":::"memory");SBAR();
    #define PK(k) (bf16x8){lo[k][0],lo[k][1],lo[k][2],lo[k][3],hi[k][0],hi[k][1],hi[k][2],hi[k][3]}
    o[d0]=__builtin_amdgcn_mfma_f32_32x32x16_bf16(pa0,PK(0),o[d0],0,0,0);
    o[d0]=__builtin_amdgcn_mfma_f32_32x32x16_bf16(pa1,PK(1),o[d0],0,0,0);
    o[d0]=__builtin_amdgcn_mfma_f32_32x32x16_bf16(pa2,PK(2),o[d0],0,0,0);
    o[d0]=__builtin_amdgcn_mfma_f32_32x32x16_bf16(pa3,PK(3),o[d0],0,0,0);
    #undef PK
  }
}

#ifndef ATTN_STORE16
#define ATTN_STORE16(p,v) (*(u32x4*)(p)=(v))
#endif
template<int THRL,bool BIAS> __device__ __forceinline__ void attn_unit(int b,int qb,const bf16*Q,const bf16*__restrict__ K,const bf16*__restrict__ V,bf16*O,const float*__restrict__ biasg,char*shm,const int tid_in,const bool comb,const bf16*O0,const float lam,const float osc,const float*__restrict__ gsub){
  int tid=tid_in; asm volatile("":"+v"(tid)); const int lane=tid&63,r32=lane&31,hi=lane>>5; const int wid=__builtin_amdgcn_readfirstlane(tid>>6);
  const long rowbase=(long)b*SEQ; const int q0=qb*QB;
  const bf16*Qw=Q+(rowbase+q0+wid*QBLK)*DMI;
  int t0=0;
  if(BIAS){ const int NT0=(q0+QB)/KVBLK; const float bq=biasg[q0]; int cnt=0;
    _Pragma("unroll") for(int h2=0;h2<2;++h2){ const int T=lane+64*h2; const bool sk=(T<NT0-4)&&(biasg[64*(T<NT0?T:0)+63]-bq<-200.f); cnt+=__popcll(__ballot(sk)); }
    t0=__builtin_amdgcn_readfirstlane(cnt)&~1; }
  const float*bg=BIAS?biasg+t0*KVBLK:biasg;
  const bf16*Kh=K+(rowbase+t0*KVBLK)*DMI,*Vh=V+(rowbase+t0*KVBLK)*DMI;
  const unsigned lds0=(unsigned)(uintptr_t)shm;
  float*wsf=(float*)(shm+LDS_WS)+wid*64;
  const bf16*ksrc=Kh+(long)lane*DMI+wid*8;
  const bf16*vsrc=Vh+(long)(16*(wid&3)+(lane>>2))*DMI+(wid>>2)*32+(lane&3)*8;
  const unsigned kdst=lds0+LDS_K+wid*1024, vdst=lds0+LDS_V+wid*1024;
  #define DMA_K(t,slot) glds16(ksrc+(long)(t)*KVBLK*DMI,(unsigned)__builtin_amdgcn_readfirstlane(kdst+(slot)))
  #define DMA_V(t,slot) do{ glds16(vsrc+(long)(t)*KVBLK*DMI,(unsigned)__builtin_amdgcn_readfirstlane(vdst+2*(slot))); glds16(vsrc+64+(long)(t)*KVBLK*DMI,(unsigned)__builtin_amdgcn_readfirstlane(vdst+2*(slot)+8192)); }while(0)
  const int vb0=(int)(lds0+LDS_V)+((lane>>4)&1)*32+(lane&3)*8+(4*hi+((lane&15)>>2))*64;
  const char*Kbase=shm+LDS_K; bf16x8 kf[8];
  const lds_cptr shm3=(lds_cptr)shm; const lds_cptr kp0=shm3+LDS_K+hi*1024+r32*16; const lds_cptr vp0=shm3+LDS_V+((lane>>4)&1)*32+(lane&3)*8+(4*hi+((lane&15)>>2))*64;
  const int NT=(q0+QB)/KVBLK-t0;
  typedef __attribute__((address_space(3))) const float* lds_fptr; typedef float f32x4_t __attribute__((ext_vector_type(4)));
  const lds_fptr biasl=(lds_fptr)(shm3+LDS_BIAS)+4*hi;
  if(BIAS){ __attribute__((address_space(3))) float* bw=(__attribute__((address_space(3))) float*)(shm3+LDS_BIAS); const int nb=NT*KVBLK;
    for(int i=tid*4;i<nb;i+=NW*64*4)*(__attribute__((address_space(3))) f32x4_t*)(bw+i)=*(const f32x4_t*)(bg+i); }
  #define BIASADD(P0,P1,t) do{ if(BIAS){ const lds_fptr bp_=biasl+KVBLK*(t); _Pragma("unroll") for(int i_=0;i_<4;++i_){ \
      const f32x4_t b0_=*(const __attribute__((address_space(3))) f32x4_t*)(bp_+8*i_), b1_=*(const __attribute__((address_space(3))) f32x4_t*)(bp_+32+8*i_); \
      _Pragma("unroll") for(int j_=0;j_<4;++j_){ P0[4*i_+j_]+=b0_[j_]; P1[4*i_+j_]+=b1_[j_]; } } } }while(0)
  DMA_K(0,0);DMA_V(0,0);DMA_K(1,SLOTB);
  bf16x8 qr[4];
  #pragma unroll
  for(int d0=0;d0<4;++d0)qr[d0]=*reinterpret_cast<const bf16x8*>(&Qw[(long)r32*DMI+d0*16+hi*8]);
  float mhat=0.f,l_reg=0.f;f32x16 o[4];o[0]=f32x16{};o[1]=f32x16{};o[2]=f32x16{};o[3]=f32x16{};f32x16 negm=f32x16{};asm volatile("":"+v"(negm));
  const int qrel=wid*QBLK+r32;
  #define CMASK(P0,P1,t) do{int jb_=(t)-(NT-4); if(jb_>=0)cmask(P0,P1,jb_,qrel,hi);}while(0)
  bool resc=false;
  #define START(P0,P1) do{ const float rm=rowmax(P0,P1); resc=false; \
    { const float dl=rm; mhat=fadd_s(mhat,dl); \
      _Pragma("unroll") for(int r=0;r<16;++r){P0[r]=fsub_s(P0[r],dl);P1[r]=fsub_s(P1[r],dl);} \
      _Pragma("unroll") for(int r=0;r<16;++r)negm[r]=-mhat; asm volatile("":"+v"(negm)); } \
    _Pragma("unroll") for(int r=0;r<16;++r)P0[r]=__builtin_amdgcn_exp2f(P0[r]); }while(0)
  #define RESC() do{ if(resc){ asm volatile("s_waitcnt lgkmcnt(0)":::"memory"); \
      _Pragma("unroll") for(int d_=0;d_<4;++d_) _Pragma("unroll") for(int r=0;r<16;++r)o[d_][r]*=wsf[crow(r,hi)]; } }while(0)
  f32x16 pA0,pA1,pB0,pB1;
  int sl_prev=0,sl_cur=0,sl_next=SLOTB;
  #define ROT() do{sl_prev=sl_cur;sl_cur=sl_next;sl_next=(sl_next==(NSLOT-1)*SLOTB)?0:sl_next+SLOTB;}while(0)
  DMA_K(2,2*SLOTB);
  WAIT_BAR(3);
  qkt(pA0,pA1,Kbase,qr,negm,r32,hi);asm volatile("s_nop 15\n\ts_nop 7":"+v"(pA0),"+v"(pA1));BIASADD(pA0,pA1,0);CMASK(pA0,pA1,0);
  START(pA0,pA1);
  _Pragma("unroll") for(int r=0;r<16;++r)pA1[r]=__builtin_amdgcn_exp2f(pA1[r]);
  WAIT_BAR(0);
  DMA_K(3,0);DMA_V(1,SLOTB);
  ROT();
  kload8(kf,kp0+sl_cur);
  WAIT_BAR(3);
  s16x4 vlo[3],vhi[3]; u32x4 pw0,pw1,pw2,pw3;
  #define PKW(P,B) cvtpk_s(P[B],P[B+1])
  #define PAF(k) __builtin_bit_cast(bf16x8,pw##k)
  #define PIN(x) asm volatile("":"+v"(x))
  #define MX3(a,b,c) __builtin_fmaxf(__builtin_fmaxf((a),(b)),(c))
  #define GAPA(MF,A0,A1,A2,A3,W0,W1,PW) do{ MF; sacc+=A0; sacc+=A1; sacc+=A2; sacc+=A3; PIN(sacc); W0; W1; PIN(PW); SBAR(); }while(0)
  #define EX(v) __builtin_amdgcn_exp2f(v)
  #define GAPB(MF,X,B) do{ MF; X[B]=EX(X[B]); X[B+1]=EX(X[B+1]); PIN(X); SBAR(); }while(0)
  #define VRDW(w,i) do{ vlo[w]=vtr(vp_+(((i)>>2)*4096+((i)&3)*1024)); vhi[w]=vtr(vp_+(((i)>>2)*4096+((i)&3)*1024+512)); }while(0)
  #define VFW(w) (bf16x8){vlo[w][0],vlo[w][1],vlo[w][2],vlo[w][3],vhi[w][0],vhi[w][1],vhi[w][2],vhi[w][3]}
  #define KRD(G,j) do{ if(G){ kload2(kf,kp0+sl_next,j); SBAR(); } }while(0)
  #define PVM(a,k,w) o[a]=__builtin_amdgcn_mfma_f32_32x32x16_bf16(PAF(k),VFW(w),o[a],0,0,0)
  #define STEP(C0,C1,P0,P1,t,GK,GV,GL) do{ SBAR(); \
    const lds_cptr vp_=vp0+2*sl_prev; \
    float sacc=(P0[0]+P0[1]); \
    GAPA(C0=__builtin_amdgcn_mfma_f32_32x32x16_bf16(kf[0],qr[0],negm,0,0,0), P0[2],P0[3],P0[4],P0[5],     pw0[0]=PKW(P0,0), pw0[1]=PKW(P0,2), pw0); \
    GAPA(C1=__builtin_amdgcn_mfma_f32_32x32x16_bf16(kf[1],qr[0],negm,0,0,0), P0[6],P0[7],P0[8],P0[9],     pw0[2]=PKW(P0,4), pw0[3]=PKW(P0,6), pw0); \
    GAPA(C0=__builtin_amdgcn_mfma_f32_32x32x16_bf16(kf[2],qr[1],C0,0,0,0),   P0[10],P0[11],P0[12],P0[13], pw1[0]=PKW(P0,8), pw1[1]=PKW(P0,10), pw1); \
    GAPA(C1=__builtin_amdgcn_mfma_f32_32x32x16_bf16(kf[3],qr[1],C1,0,0,0),   P0[14],P0[15],P1[0],P1[1],   pw1[2]=PKW(P0,12),pw1[3]=PKW(P0,14), pw1); \
    GAPA(C0=__builtin_amdgcn_mfma_f32_32x32x16_bf16(kf[4],qr[2],C0,0,0,0),   P1[2],P1[3],P1[4],P1[5],     pw2[0]=PKW(P1,0), pw2[1]=PKW(P1,2), pw2); \
    GAPA(C1=__builtin_amdgcn_mfma_f32_32x32x16_bf16(kf[5],qr[2],C1,0,0,0),   P1[6],P1[7],P1[8],P1[9],     pw2[2]=PKW(P1,4), pw2[3]=PKW(P1,6), pw2); \
    VRDW(0,0); SBAR(); \
    GAPA(C0=__builtin_amdgcn_mfma_f32_32x32x16_bf16(kf[6],qr[3],C0,0,0,0),   P1[10],P1[11],P1[12],P1[13], pw3[0]=PKW(P1,8), pw3[1]=PKW(P1,10), pw3); \
    VRDW(1,4); SBAR(); \
    GAPA(C1=__builtin_amdgcn_mfma_f32_32x32x16_bf16(kf[7],qr[3],C1,0,0,0),   P1[14],P1[15],0.f,0.f,       pw3[2]=PKW(P1,12),pw3[3]=PKW(P1,14), pw3); \
    l_reg+=sacc; \
    if(GK){DMA_K((t)+3,sl_cur);} if(GV){DMA_V((t)+1,sl_next);} \
    BIASADD(C0,C1,t); CMASK(C0,C1,t); \
    { float a=MX3(C0[0],C0[1],C1[0]),b=MX3(C0[2],C0[3],C1[1]); a=MX3(a,C1[2],C1[3]); \
      _Pragma("unroll") for(int r=4;r<16;r+=4){a=MX3(a,C0[r],C0[r+1]);b=MX3(b,C0[r+2],C0[r+3]);a=MX3(a,C1[r],C1[r+1]);b=MX3(b,C1[r+2],C1[r+3]);} \
      float rm=__builtin_fmaxf(a,b); { auto rr=__builtin_amdgcn_permlane32_swap(__float_as_uint(rm),__float_as_uint(rm),false,false); rm=__builtin_fmaxf(__uint_as_float(rr[0]),__uint_as_float(rr[1])); } \
      resc=false; \
      if(__builtin_expect(__any(rm>(float)THRL),0)){ const float dl=__builtin_fmaxf(rm,0.f); mhat+=dl; \
        _Pragma("unroll") for(int r=0;r<16;++r){C0[r]-=dl;C1[r]-=dl;} \
        _Pragma("unroll") for(int r=0;r<16;++r)negm[r]=-mhat; asm volatile("":"+v"(negm)); \
        const float f=__builtin_amdgcn_exp2f(-dl); l_reg*=f; if(hi==0)wsf[r32]=f; resc=true; } } \
    SBAR(); \
    GAPB(PVM(0,0,0), C0,0);  VRDW(2,8);  SBAR(); \
    GAPB(PVM(1,0,1), C0,2);  VRDW(0,12); SBAR(); \
    KRD(GL,0); GAPB(PVM(2,0,2), C0,4);  VRDW(1,1);  SBAR(); \
    GAPB(PVM(3,0,0), C0,6);  VRDW(2,5);  SBAR(); \
    KRD(GL,1); GAPB(PVM(0,1,1), C0,8);  VRDW(0,9);  SBAR(); \
    GAPB(PVM(1,1,2), C0,10); VRDW(1,13); SBAR(); \
    KRD(GL,2); GAPB(PVM(2,1,0), C0,12); VRDW(2,2);  SBAR(); \
    GAPB(PVM(3,1,1), C0,14); VRDW(0,6);  SBAR(); \
    KRD(GL,3); GAPB(PVM(0,2,2), C1,0);  VRDW(1,10); SBAR(); \
    GAPB(PVM(1,2,0), C1,2);  VRDW(2,14); SBAR(); \
    GAPB(PVM(2,2,1), C1,4);  VRDW(0,3);  SBAR(); \
    GAPB(PVM(3,2,2), C1,6);  VRDW(1,7);  SBAR(); \
    GAPB(PVM(0,3,0), C1,8);  VRDW(2,11); SBAR(); \
    GAPB(PVM(1,3,1), C1,10); VRDW(0,15); SBAR(); \
    GAPB(PVM(2,3,2), C1,12); \
    GAPB(PVM(3,3,0), C1,14); \
    }while(0)
  int t=1;
  #undef CMASK
  #define CMASK(P0,P1,t) do{}while(0)
  for(;t+5<NT;t+=2){
    STEP(pB0,pB1,pA0,pA1,t,true,true,true);     WAIT_BAR(3); RESC(); ROT();
    STEP(pA0,pA1,pB0,pB1,t+1,true,true,true);   WAIT_BAR(3); RESC(); ROT();
  }
  #undef CMASK
  #define CMASK(P0,P1,t) do{int jb_=(t)-(NT-4); if(jb_>=0)cmask(P0,P1,jb_,qrel,hi);}while(0)
  #define ENDW(tt) do{ if((tt)+3<NT){WAIT_BAR(3);} else if((tt)+2<NT){WAIT_BAR(2);} else {WAIT_BAR(0);} }while(0)
  for(;t+1<NT;t+=2){
    STEP(pB0,pB1,pA0,pA1,t,(t+3<NT),(t+1<NT),(t+1<NT));       ENDW(t);   RESC(); ROT();
    STEP(pA0,pA1,pB0,pB1,t+1,(t+4<NT),(t+2<NT),(t+2<NT));     ENDW(t+1); RESC(); ROT();
  }
  STEP(pB0,pB1,pA0,pA1,NT-1,false,false,false); RESC();
  { float sacc=pB0[0]+pB0[1]; _Pragma("unroll") for(int r=2;r<16;++r)sacc+=pB0[r]; _Pragma("unroll") for(int r=0;r<16;++r)sacc+=pB1[r]; l_reg+=sacc;
    pw0=(u32x4){PKW(pB0,0),PKW(pB0,2),PKW(pB0,4),PKW(pB0,6)};pw1=(u32x4){PKW(pB0,8),PKW(pB0,10),PKW(pB0,12),PKW(pB0,14)};pw2=(u32x4){PKW(pB1,0),PKW(pB1,2),PKW(pB1,4),PKW(pB1,6)};pw3=(u32x4){PKW(pB1,8),PKW(pB1,10),PKW(pB1,12),PKW(pB1,14)};
    SBAR(); pv(o,vb0+2*sl_cur,PAF(0),PAF(1),PAF(2),PAF(3)); pv(o+2,vb0+2*sl_cur+8192,PAF(0),PAF(1),PAF(2),PAF(3)); }
  #undef PKW
  #undef PAF
  #undef PIN
  #undef MX3
  #undef GAPA
  #undef GAPB
  #undef VRDW
  #undef VFW
  #undef PVM
  #undef EX
  #undef KRD
  #undef STEP
  #undef ENDW
  {auto rr=__builtin_amdgcn_permlane32_swap(__float_as_uint(l_reg),__float_as_uint(l_reg),false,false);l_reg=__uint_as_float(rr[0])+__uint_as_float(rr[1]);}
  if(hi==0)wsf[32+r32]=l_reg;asm volatile("s_waitcnt lgkmcnt(0)":::"memory");
  float rli[16];
  #pragma unroll
  for(int r=0;r<16;++r)rli[r]=__builtin_amdgcn_rcpf(wsf[32+crow(r,hi)]);
  bf16*Ow=O+(rowbase+q0+wid*QBLK)*DMO;
  { bf16*stg=(bf16*)(shm+LDS_OST)+wid*2048;
    if(!comb){
    #pragma unroll
    for(int ps=0;ps<2;++ps){
      #pragma unroll
      for(int r=0;r<16;++r){const int orow=crow(r,hi);
        #pragma unroll
        for(int d0=0;d0<2;++d0)stg[orow*64+d0*32+r32]=__float2bfloat16(o[2*ps+d0][r]*rli[r]);}
      asm volatile("s_waitcnt lgkmcnt(0)":::"memory");
      #pragma unroll
      for(int i=0;i<4;++i){const int row=i*8+(lane>>3),ch=lane&7; const u32x4 v=*(const u32x4*)(stg+row*64+ch*8); ATTN_STORE16(Ow+(long)row*DMO+ps*64+ch*8,v);}
      asm volatile("s_waitcnt lgkmcnt(0)":::"memory"); }
    } else {
      __builtin_amdgcn_fence(__ATOMIC_ACQUIRE,"agent");
      const bf16*O0w=O0+(rowbase+q0+wid*QBLK)*DMO; const int ch=lane&7,rw=lane>>3;
      float dv[2][4][8]; float ssq[4]={0.f,0.f,0.f,0.f};
      #pragma unroll
      for(int ps=0;ps<2;++ps){
        #pragma unroll
        for(int r=0;r<16;++r){const int orow=crow(r,hi);
          #pragma unroll
          for(int d0=0;d0<2;++d0)stg[orow*64+d0*32+r32]=__float2bfloat16(o[2*ps+d0][r]*rli[r]);}
        asm volatile("s_waitcnt lgkmcnt(0)":::"memory");
        #pragma unroll
        for(int i=0;i<4;++i){const int row=i*8+rw; const u32x4 v1=*(const u32x4*)(stg+row*64+ch*8); const u32x4 v0=*(const u32x4*)(O0w+(long)row*DMO+ps*64+ch*8);
          #pragma unroll
          for(int c=0;c<4;++c){ const float a0=__uint_as_float(v0[c]<<16),a1=__uint_as_float(v0[c]&0xffff0000u),b0=__uint_as_float(v1[c]<<16),b1=__uint_as_float(v1[c]&0xffff0000u);
            const float e0=a0-lam*b0,e1=a1-lam*b1; dv[ps][i][2*c]=e0; dv[ps][i][2*c+1]=e1; ssq[i]+=e0*e0+e1*e1; } }
        asm volatile("s_waitcnt lgkmcnt(0)":::"memory"); }
      #pragma unroll
      for(int i=0;i<4;++i){ float s=ssq[i];
        s+=__int_as_float(__builtin_amdgcn_ds_swizzle(__float_as_int(s),(1<<10)|0x1f)); s+=__int_as_float(__builtin_amdgcn_ds_swizzle(__float_as_int(s),(2<<10)|0x1f)); s+=__int_as_float(__builtin_amdgcn_ds_swizzle(__float_as_int(s),(4<<10)|0x1f));
        ssq[i]=osc/sqrtf(s*(1.0f/128.0f)+1e-6f); }
      #pragma unroll
      for(int ps=0;ps<2;++ps){ typedef float f32x4_u __attribute__((ext_vector_type(4)));
        const f32x4_u g0=*(const f32x4_u*)(gsub+ps*64+ch*8),g1=*(const f32x4_u*)(gsub+ps*64+ch*8+4);
        #pragma unroll
        for(int i=0;i<4;++i){const int row=i*8+rw; const float rs=ssq[i]; u32x4 w;
          w.x=cvtpk_s(dv[ps][i][0]*rs*g0.x,dv[ps][i][1]*rs*g0.y); w.y=cvtpk_s(dv[ps][i][2]*rs*g0.z,dv[ps][i][3]*rs*g0.w);
          w.z=cvtpk_s(dv[ps][i][4]*rs*g1.x,dv[ps][i][5]*rs*g1.y); w.w=cvtpk_s(dv[ps][i][6]*rs*g1.z,dv[ps][i][7]*rs*g1.w);
          ATTN_STORE16(Ow+(long)row*DMO+ps*64+ch*8,w);} }
    } }
  asm volatile("s_waitcnt lgkmcnt(0)\n\ts_barrier":::"memory");
  #undef BIASADD
  #undef DMA_K
  #undef DMA_V
  #undef CMASK
  #undef START
  #undef RESC
  #undef ROT
}
constexpr int ATTN_LDS_BYTES=LDS_BYTES;
#undef SBAR
#undef WAIT_BAR
}
#include <hip/hip_cooperative_groups.h>
namespace cg = cooperative_groups;
#define GAS __attribute__((address_space(1)))
#define LAS __attribute__((address_space(3)))
typedef unsigned short bf16;
typedef unsigned v4u __attribute__((ext_vector_type(4)));
typedef unsigned v2u __attribute__((ext_vector_type(2)));
typedef float f32x4 __attribute__((ext_vector_type(4)));
constexpr int NWAVES = 8;
constexpr int BATCH = 4, SEQ = 8192, D = 1024, DEPTH = 2, M = BATCH * SEQ;
constexpr int INW = 3080, NQKV = 3072, DFF = 2816, NGU = 2 * DFF, NFOX = 8;
constexpr float EPS = 1e-6f;
constexpr size_t MiB = 1u << 20;
constexpr size_t WS_RS1 = 5 * MiB, WS_RS2 = 5 * MiB + 262144;
constexpr size_t WS_ROT = 1 * MiB, WS_LOGF = 3 * MiB, WS_CUM = 4 * MiB, WS_WIN = 6 * MiB, WS_WO = 18 * MiB, WS_WGU = 22 * MiB, WS_WD = 44 * MiB, WS_XN = 56 * MiB,
                 WS_QKV = 120 * MiB, WS_ACT = 120 * MiB, WS_Y1 = 120 * MiB, WS_OD = 312 * MiB, WS_MIX = 376 * MiB, WS_Y2 = 312 * MiB, WS_END = 440 * MiB;
constexpr int LDS_BYTES = 147456;
static_assert(attn_body::ATTN_LDS_BYTES <= 131072 && attn128::ATTN_LDS_BYTES <= 131072, "attention scratch fits");
#define LDS_WAIT() asm volatile("s_waitcnt lgkmcnt(0)" ::: "memory")
__device__ __forceinline__ unsigned f2bf(float f) { unsigned u = __builtin_bit_cast(unsigned, f); return (u + 0x7fffu + ((u >> 16) & 1u)) >> 16; }
__device__ __forceinline__ unsigned pk2(float lo, float hi) { return f2bf(lo) | (f2bf(hi) << 16); }
#define SWZ_XOR(v, m) __uint_as_float((unsigned)__builtin_amdgcn_ds_swizzle((int)__float_as_uint(v), ((m) << 10) | 0x1f))
__device__ __forceinline__ float wave_sum(float v) {
    v += SWZ_XOR(v, 1); v += SWZ_XOR(v, 2); v += SWZ_XOR(v, 4); v += SWZ_XOR(v, 8); v += SWZ_XOR(v, 16);
    const auto rr = __builtin_amdgcn_permlane32_swap(__float_as_uint(v), __float_as_uint(v), false, false);
    return __uint_as_float(rr[0]) + __uint_as_float(rr[1]);
}
__device__ __forceinline__ void transpose_item(const float* W, int ldw, int Kdim, bf16* WT, int dst_row0, int k0, int n0, LAS float* scr, int lane, const float* gk) {
#pragma unroll 8
    for (int i = 0; i < 32; ++i) { const int kk = 2 * i + (lane >> 5); scr[kk * 33 + (lane & 31)] = W[(size_t)(k0 + kk) * ldw + n0 + (lane & 31)]; }
    LDS_WAIT(); asm volatile("" ::: "memory");
    const int c = lane & 7;
    f32x4 ga = {1.f, 1.f, 1.f, 1.f}, gb = ga; if (gk) { ga = *(const f32x4*)(gk + k0 + 8 * c); gb = *(const f32x4*)(gk + k0 + 8 * c + 4); }
#pragma unroll
    for (int j = 0; j < 4; ++j) { const int n = (lane >> 3) + 8 * j; const LAS float* s = scr + (8 * c) * 33 + n;
        v4u o; o.x = pk2(s[0 * 33] * ga.x, s[1 * 33] * ga.y); o.y = pk2(s[2 * 33] * ga.z, s[3 * 33] * ga.w); o.z = pk2(s[4 * 33] * gb.x, s[5 * 33] * gb.y); o.w = pk2(s[6 * 33] * gb.z, s[7 * 33] * gb.w);
        *(GAS v4u*)(WT + (size_t)(dst_row0 + n) * Kdim + k0 + 8 * c) = o; }
    LDS_WAIT(); asm volatile("" ::: "memory");
}
__device__ __forceinline__ void load_row(const float* p, int lane, f32x4 (&v)[4]) {
    const f32x4* r = (const f32x4*)p + lane;
#pragma unroll
    for (int j = 0; j < 4; ++j) v[j] = r[64 * j];
}
__device__ __forceinline__ void load_row_bf16(const bf16* p, int lane, f32x4 (&v)[4]) {
    const v2u* r = (const v2u*)p + lane;
#pragma unroll
    for (int j = 0; j < 4; ++j) { const v2u w = r[64 * j]; v[j].x = __uint_as_float(w.x << 16); v[j].y = __uint_as_float(w.x & 0xffff0000u); v[j].z = __uint_as_float(w.y << 16); v[j].w = __uint_as_float(w.y & 0xffff0000u); }
}
__device__ __forceinline__ void store_row(float* p, int lane, const f32x4 (&v)[4]) {
    f32x4* r = (f32x4*)p + lane;
#pragma unroll
    for (int j = 0; j < 4; ++j) r[64 * j] = v[j];
}
__device__ __forceinline__ float row_rstd(const f32x4 (&v)[4]) {
    float s = 0.f;
#pragma unroll
    for (int j = 0; j < 4; ++j) s += (v[j].x * v[j].x + v[j].y * v[j].y) + (v[j].z * v[j].z + v[j].w * v[j].w);
    return 1.0f / sqrtf(wave_sum(s) * (1.0f / D) + EPS);
}
__device__ __forceinline__ void store_row_bf16(bf16* p, int lane, const f32x4 (&v)[4]) {
    v2u* o = (v2u*)p + lane;
#pragma unroll
    for (int j = 0; j < 4; ++j) { v2u w; w.x = pk2(v[j].x, v[j].y); w.y = pk2(v[j].z, v[j].w); o[64 * j] = w; }
}
constexpr int WFL_OFF = 0;
__device__ __forceinline__ void fill_forget_w(const float* win_l, LAS unsigned char* ldsl, int tid) {
    LAS float* wfl = (LAS float*)(ldsl + WFL_OFF);
    for (int idx = tid; idx < 8 * D; idx += NWAVES * 64) { const int k = idx >> 3, f = idx & 7; wfl[f * D + k] = win_l[(size_t)k * INW + NQKV + f]; }
    __syncthreads();
}
__device__ __forceinline__ void pre_norm_row(const f32x4 (&xv)[4], const f32x4 (&g)[4], bf16* xb_row, const LAS float* wfl, const float* fbias, float* logf, float* rs, int row, int lane) {
    const float rstd = row_rstd(xv); f32x4 h[4];
#pragma unroll
    for (int j = 0; j < 4; ++j) h[j] = xv[j] * rstd * g[j];
    if (xb_row) store_row_bf16(xb_row, lane, xv);
    if (lane == 0) rs[row] = rstd;
    float mine = 0.f;
#pragma unroll
    for (int f = 0; f < 8; ++f) { f32x4 a = {0.f, 0.f, 0.f, 0.f};
#pragma unroll
        for (int j = 0; j < 4; ++j) a += *(const LAS f32x4*)(wfl + f * D + 256 * j + 4 * lane) * h[j];
        const float t = wave_sum((a.x + a.y) + (a.z + a.w)); mine = (lane == f) ? t : mine; }
    if (lane < NFOX) { const float y = mine + fbias[lane]; const float e = __expf(-fabsf(y)), u = 1.0f + e, um = u - 1.0f; const float l1p = (um == 0.f) ? e : __logf(u) * (e / um); const float lf = fminf(y, 0.f) - l1p;
        const int b = row / SEQ, s = row % SEQ; logf[(size_t)(b * NFOX + lane) * SEQ + s] = lf; }
}

#define XB_TMO      128
#define XB_XCNT(j)  (256  + 64 * (j))
#define XB_XSUB(j)  (1280 + 64 * (j))
#define XB_XGEN(j)  (2304 + 64 * (j))
#define XB_TOP      3328
#define XB_TOPGEN   3392
#define XCD_BAR_WORDS 3456
#define XB_SPIN_CAP (1u << 22)

__device__ __forceinline__ unsigned xb_ld(unsigned* p)              { return __hip_atomic_load(p, __ATOMIC_RELAXED, __HIP_MEMORY_SCOPE_AGENT); }
__device__ __forceinline__ unsigned xb_add(unsigned* p, unsigned v) { return __hip_atomic_fetch_add(p, v, __ATOMIC_RELAXED, __HIP_MEMORY_SCOPE_AGENT); }
__device__ __forceinline__ unsigned xb_xcc_id() { return (unsigned)__builtin_amdgcn_s_getreg((3 << 11) | 20) & 0xFu; }
#define XB_SPIN(cond, bar) do { unsigned _sp = 0; while (cond) { __builtin_amdgcn_s_sleep(1); \
    if ((++_sp & 255u) == 0u) { if (xb_ld(&(bar)[XB_TMO])) break; if (_sp > XB_SPIN_CAP) { atomicAdd(&(bar)[XB_TMO], 1u); break; } } } } while (0)

struct XcdBarrier {
    unsigned* bar; unsigned x;
    volatile LAS unsigned* st;
};

__device__ __forceinline__ XcdBarrier xcd_barrier_post(unsigned* bar, volatile LAS unsigned* st, const int tid_in) {
    XcdBarrier b; b.bar = bar; b.x = xb_xcc_id(); b.st = st;
    if (tid_in == 0) (void)xb_add(&bar[XB_XCNT(b.x)], 1u);
    return b;
}
__device__ __forceinline__ void xcd_barrier_complete(unsigned* bar, unsigned x, unsigned& nloc, unsigned& nx) {
    const unsigned G = gridDim.x * gridDim.y * gridDim.z;
    unsigned sum, cnt, mine, sp = 0u;
    for (;;) {
        sum = 0u; cnt = 0u; mine = 0u;
#pragma unroll
        for (unsigned j = 0; j < 16; ++j) { const unsigned c = xb_ld(&bar[XB_XCNT(j)]); sum += c; cnt += (c > 0u) ? 1u : 0u; mine = (j == x) ? c : mine; }
        if (sum == G) break;
        __builtin_amdgcn_s_sleep(1);
        if ((++sp & 255u) == 0u) { if (xb_ld(&bar[XB_TMO])) break; if (sp > XB_SPIN_CAP) { atomicAdd(&bar[XB_TMO], 1u); break; } }
    }
    nloc = mine > 0u ? mine : 1u; nx = cnt > 0u ? cnt : 1u;
}

__device__ __forceinline__ void xcd_barrier(const XcdBarrier& b, const int tid_in) {
    asm volatile("s_waitcnt vmcnt(0)" ::: "memory");
    __syncthreads();
    if (tid_in == 0) {
        unsigned* bar = b.bar;
        __builtin_amdgcn_s_waitcnt(0);
        unsigned nloc = b.st[0], nx = b.st[1];
        if (nloc == 0u) { xcd_barrier_complete(bar, b.x, nloc, nx); b.st[0] = nloc; b.st[1] = nx; }
        const unsigned old = xb_add(&bar[XB_XSUB(b.x)], 1u);
        const unsigned gen = old / nloc;
        if (old + 1u == (gen + 1u) * nloc) {
            __builtin_amdgcn_fence(__ATOMIC_RELEASE, "agent");
            asm volatile("s_waitcnt vmcnt(0)" ::: "memory");
            const unsigned og = xb_add(&bar[XB_TOP], 1u);
            const unsigned tg = og / nx;
            if (og + 1u == (tg + 1u) * nx) xb_add(&bar[XB_TOPGEN], 1u);
            else XB_SPIN(xb_ld(&bar[XB_TOPGEN]) == tg, bar);
            __builtin_amdgcn_fence(__ATOMIC_ACQUIRE, "agent");
            xb_add(&bar[XB_XGEN(b.x)], 1u);
            asm volatile("s_waitcnt vmcnt(0)" ::: "memory");
        } else {
            XB_SPIN(xb_ld(&bar[XB_XGEN(b.x)]) == gen, bar);
            __builtin_amdgcn_fence(__ATOMIC_ACQUIRE, "agent");
            asm volatile("s_waitcnt vmcnt(0)" ::: "memory");
        }
    }
    __syncthreads();
}

constexpr size_t WS_CTL = 0, CTL_ZERO_BYTES = 65536; constexpr int CW_BAR = 4096;
constexpr int MISC_OFF = 131072 + 320;
struct Args { const void* in[17]; float* out; unsigned char* ws; };
typedef const __attribute__((address_space(4))) Args* KArgs;
#define KA() ([]() __attribute__((always_inline)) { KArgs p_ = (KArgs)__builtin_amdgcn_kernarg_segment_ptr(); asm volatile("" : "+s"(p_)); return p_; }())
#define IN_F(A, k) ((const float*)(A)->in[k])

__global__ void __launch_bounds__(NWAVES * 64, 2) hymba_fwd(Args args_unused) {
    extern __shared__ __attribute__((aligned(16))) unsigned char lds[];
    cg::grid_group grid = cg::this_grid();
#define TID_NOW() ({ unsigned ones_ = ~0u; asm volatile("" : "+s"(ones_)); (wave0 << 6) | (int)__builtin_amdgcn_mbcnt_hi(ones_, __builtin_amdgcn_mbcnt_lo(ones_, 0u)); })
    const int wave0 = __builtin_amdgcn_readfirstlane((int)threadIdx.x >> 6);
#define PH_IDS() int tid = TID_NOW(); asm volatile("" : "+v"(tid)); const int lane = tid & 63, wave = __builtin_amdgcn_readfirstlane(tid >> 6); int bx = blockIdx.x; asm volatile("" : "+s"(bx)); \
    const int G = gridDim.x, vcu = (G % 8 == 0) ? (bx % 8) * (G / 8) + bx / 8 : bx, gw = vcu * NWAVES + wave, NGW = G * NWAVES; (void)lane; (void)gw; (void)NGW; (void)vcu
#define BARRIER() do { KArgs Ab_ = KA(); XcdBarrier b_; b_.bar = (unsigned*)(Ab_->ws + WS_CTL) + CW_BAR; b_.x = xb_xcc_id(); b_.st = (volatile LAS unsigned*)(ldsl + MISC_OFF) + 8; int t_ = TID_NOW(); asm volatile("" : "+v"(t_)); xcd_barrier(b_, t_); } while (0)
    LAS unsigned char* ldsl = (LAS unsigned char*)lds;
    { const int t_ = TID_NOW(); for (int u = t_; u < (LDS_BYTES - 131072) / 4; u += NWAVES * 64) ((LAS unsigned*)(ldsl + 131072))[u] = 0u;
      __syncthreads();
      (void)xcd_barrier_post((unsigned*)(KA()->ws + WS_CTL) + CW_BAR, (volatile LAS unsigned*)(ldsl + MISC_OFF) + 8, t_); }

    {
        KArgs A = KA(); PH_IDS(); unsigned char* ws = A->ws;
        const float* attn_pre_g = IN_F(A, 2); const float* ffn_pre_g = IN_F(A, 12); const float* w_in = IN_F(A, 3); const float* w_out = IN_F(A, 10); const float* w_gate = IN_F(A, 13); const float* w_up = IN_F(A, 14); const float* w_down = IN_F(A, 15);
        bf16* WIN_T = (bf16*)(ws + WS_WIN); bf16* WO_T = (bf16*)(ws + WS_WO); bf16* WGU_T = (bf16*)(ws + WS_WGU); bf16* WD_T = (bf16*)(ws + WS_WD);
        LAS float* scr = (LAS float*)(ldsl + wave * 16384);
        constexpr int I_IN = 16 * (NQKV / 32), I_O = 16 * (D / 32), I_G = 16 * (DFF / 32), I_D = (DFF / 64) * (D / 32), I_L = I_IN + I_O + 2 * I_G + I_D;
        for (int it = gw; it < DEPTH * I_L; it += NGW) {
            const int l = it / I_L; int r = it % I_L;
            if (r < I_IN) { const int nb = NQKV / 32; transpose_item(w_in + (size_t)l * D * INW, INW, D, WIN_T + (size_t)l * NQKV * D, 32 * (r % nb), 64 * (r / nb), 32 * (r % nb), scr, lane, attn_pre_g + l * D); continue; } r -= I_IN;
            if (r < I_O) { const int nb = D / 32; transpose_item(w_out + (size_t)l * D * D, D, D, WO_T + (size_t)l * D * D, 32 * (r % nb), 64 * (r / nb), 32 * (r % nb), scr, lane, nullptr); continue; } r -= I_O;
            if (r < 2 * I_G) { const int up = r >= I_G; if (up) r -= I_G; const int nb = DFF / 32, n0 = 32 * (r % nb);
                transpose_item((up ? w_up : w_gate) + (size_t)l * D * DFF, DFF, D, WGU_T + (size_t)l * NGU * D, (n0 / 128) * 256 + up * 128 + (n0 % 128), 64 * (r / nb), n0, scr, lane, ffn_pre_g + l * D); continue; } r -= 2 * I_G;
            { const int nb = D / 32; transpose_item(w_down + (size_t)l * DFF * D, D, DFF, WD_T + (size_t)l * D * DFF, 32 * (r % nb), 64 * (r / nb), 32 * (r % nb), scr, lane, nullptr); }
        }
    }
    {
        KArgs A = KA(); PH_IDS(); const int* positions = (const int*)A->in[1]; float* ROT = (float*)(A->ws + WS_ROT);
        for (int e = bx * (NWAVES * 64) + tid; e < M * 8; e += G * NWAVES * 64) {
            const int row = e >> 3, i = e & 7;
            float fr = 1.000000000e+00f;
            fr = (i == 1) ? 1.939227581e-01f : fr; fr = (i == 2) ? 3.760603070e-02f : fr; fr = (i == 3) ? 7.292665076e-03f : fr; fr = (i == 4) ? 1.414213446e-03f : fr;
            fr = (i == 5) ? 2.742481884e-04f : fr; fr = (i == 6) ? 5.318296462e-05f : fr; fr = (i == 7) ? 1.031338525e-05f : fr;
            const float ang = (float)positions[row] * fr;
            const double xd = (double)ang, kq = rint(xd * 0.63661977236758134308), rr = fma(-kq, 6.123233995736766e-17, fma(-kq, 1.5707963267948966, xd)), r2 = rr * rr;
            const double sn = rr * (1.0 + r2 * (-1.0 / 6 + r2 * (1.0 / 120 + r2 * (-1.0 / 5040 + r2 * (1.0 / 362880 + r2 * (-1.0 / 39916800))))));
            const double cs = 1.0 + r2 * (-0.5 + r2 * (1.0 / 24 + r2 * (-1.0 / 720 + r2 * (1.0 / 40320 + r2 * (-1.0 / 3628800 + r2 * (1.0 / 479001600))))));
            const int q4 = (int)kq & 3;
            const double c = (q4 == 0) ? cs : (q4 == 1) ? -sn : (q4 == 2) ? -cs : sn, s = (q4 == 0) ? sn : (q4 == 1) ? cs : (q4 == 2) ? -sn : -cs;
            ROT[(size_t)row * 16 + i] = (float)c; ROT[(size_t)row * 16 + 8 + i] = (float)s;
        }
    }
    {
        KArgs A = KA(); PH_IDS(); const float* x_in = IN_F(A, 0); bf16* XN = (bf16*)(A->ws + WS_XN); float* LOGF = (float*)(A->ws + WS_LOGF); const float* fbias = IN_F(A, 4);
        __syncthreads();
        fill_forget_w(IN_F(A, 3), ldsl, tid);
        f32x4 g[4]; load_row(IN_F(A, 2), lane, g);
        {
            f32x4 xv[4]; load_row(x_in + (size_t)gw * D, lane, xv);
            for (int m = gw; m < M; m += NGW) { f32x4 xn[4]; const int mn = (m + NGW < M) ? m + NGW : m; load_row(x_in + (size_t)mn * D, lane, xn);
                pre_norm_row(xv, g, XN + (size_t)m * D, (const LAS float*)(ldsl + WFL_OFF), fbias, LOGF, (float*)(A->ws + WS_RS1), m, lane);
#pragma unroll
                for (int j = 0; j < 4; ++j) xv[j] = xn[j]; } }
    }
    if (KA()->ws == nullptr) grid.sync();
    BARRIER();

#pragma unroll 1
    for (int l = 0; l < DEPTH; ++l) {
        {
            KArgs A = KA(); PH_IDS(); const float* LOGF = (const float*)(A->ws + WS_LOGF); float* CUM = (float*)(A->ws + WS_CUM);
            for (int ch = bx; ch < BATCH * NFOX; ch += G) {
                LAS float* wt = (LAS float*)ldsl;
                const f32x4* src = (const f32x4*)(LOGF + (size_t)ch * SEQ + tid * 16); f32x4 v[4]; float run = 0.f;
#pragma unroll
                for (int j = 0; j < 4; ++j) { v[j] = src[j]; v[j].x += run; v[j].y += v[j].x; v[j].z += v[j].y; v[j].w += v[j].z; run = v[j].w; }
                float inc = run;
#pragma unroll
                for (int o = 1; o < 64; o <<= 1) { const float t = __uint_as_float((unsigned)__builtin_amdgcn_ds_bpermute(((lane - o) & 63) << 2, (int)__float_as_uint(inc))); if (lane >= o) inc += t; }
                if (lane == 63) wt[wave] = inc;
                __syncthreads();
                float off = inc - run;
                for (int w = 0; w < wave; ++w) off += wt[w];
                f32x4* dst = (f32x4*)(CUM + (size_t)ch * SEQ + tid * 16);
#pragma unroll
                for (int j = 0; j < 4; ++j) dst[j] = (v[j] + off) * -1.4426950408889634f;
                __syncthreads();
            }
        }
        {
            KArgs A = KA(); PH_IDS(); unsigned char* ws = A->ws;
            pg8::Gemm g{(const bf16*)(ws + WS_XN), (const bf16*)(ws + WS_WIN) + (size_t)l * NQKV * D, M, NQKV, D}; pg8::StaticOrder S; S.init(M, NQKV, G, bx);
            pg8::EpiQKV E{(bf16*)(ws + WS_QKV), (const float*)(ws + WS_ROT), (const float*)(ws + WS_RS1)};
            pg8::gemm_phase<pg8::EpiQKV, pg8::StaticOrder, PG8_ALIGN, PG8_SP2>(ldsl, g, S, E, tid);
        }
        BARRIER();
        {
            KArgs A = KA(); PH_IDS(); unsigned char* ws = A->ws;
            const float lam_init = 0.8f - 0.6f * __expf(-0.3f * (float)l);
            const float e1 = __expf(wave_sum(IN_F(A, 5)[l * 64 + lane] * IN_F(A, 6)[l * 64 + lane])), e2 = __expf(wave_sum(IN_F(A, 7)[l * 64 + lane] * IN_F(A, 8)[l * 64 + lane]));
            const float lam = __uint_as_float((unsigned)__builtin_amdgcn_readfirstlane((int)__float_as_uint(e1 - e2 + lam_init))), osc = __uint_as_float((unsigned)__builtin_amdgcn_readfirstlane((int)__float_as_uint(1.0f - lam_init)));
            const float* gsub = IN_F(A, 9) + l * 128;
            unsigned* qcnt = (unsigned*)(ws + WS_CTL) + 64 * (1 + 8 * l);
            volatile LAS unsigned* qs = (volatile LAS unsigned*)(ldsl + MISC_OFF) + 16;
            const attn_body::bf16* Qb = (const attn_body::bf16*)(ws + WS_QKV);
            for (;;) {
                if (tid == 0) *qs = __hip_atomic_fetch_add(qcnt, 1u, __ATOMIC_RELAXED, __HIP_MEMORY_SCOPE_AGENT);
                __syncthreads();
                const unsigned gq = (unsigned)__builtin_amdgcn_readfirstlane(*qs);
                __syncthreads();
                if (gq >= 1536u) break;
                const int x = (int)(gq & 7u); const unsigned e = gq >> 3;
                const int qb = (e < 64u) ? 31 - (int)(e >> 1) : 31 - (int)((e - 64u) >> 2), j = (e < 64u) ? (int)(e & 1u) : 2 + (int)((e - 64u) & 3u);
                if (j < 2) { const int idx = 2 * x + j, b = idx >> 2, h = idx & 3;
#pragma unroll 1
                    for (int mp = 0; mp < 2; ++mp) { const int hm = 2 * h + mp;
                        attn128::attn_unit<8, false>(b, qb, (const attn128::bf16*)Qb + hm * 64, (const attn128::bf16*)Qb + 512 + hm * 64, (const attn128::bf16*)Qb + 1024 + h * 128,
                            (mp ? (attn128::bf16*)(ws + WS_MIX) : (attn128::bf16*)(ws + WS_OD)) + h * 128, nullptr, (char*)lds, tid, mp != 0, (const attn128::bf16*)(ws + WS_OD) + h * 128, lam, osc, gsub); }
                } else { const int b = j - 2, f = (x - 2 * b) & 7;
                    attn_body::attn_unit<8, true>(b, qb, Qb + 1536 + f * 64, Qb + 2048 + f * 64, Qb + 2560 + f * 64, (attn_body::bf16*)(ws + WS_MIX) + 512 + f * 64, (const float*)(ws + WS_CUM) + (size_t)(b * NFOX + f) * SEQ, (char*)lds, tid); }
            }
        }
        BARRIER();
        {
            KArgs A = KA(); PH_IDS(); unsigned char* ws = A->ws;
            pg8::Gemm g{(const bf16*)(ws + WS_MIX), (const bf16*)(ws + WS_WO) + (size_t)l * D * D, M, D, D}; pg8::StaticOrder S; S.init(M, D, G, bx);
            pg8::EpiY E{(bf16*)(ws + WS_Y1), D};
            pg8::gemm_phase<pg8::EpiY, pg8::StaticOrder, PG8_ALIGN, PG8_SP2>(ldsl, g, S, E, tid);
        }
        BARRIER();
        {
            KArgs A = KA(); PH_IDS(); const bf16* Y1 = (const bf16*)(A->ws + WS_Y1); bf16* XB = (bf16*)(A->ws + WS_XN); float* RS2 = (float*)(A->ws + WS_RS2); const float* x_in = IN_F(A, 0);
            f32x4 gp[4]; load_row(IN_F(A, 11) + l * D, lane, gp);
            f32x4 y[4], xv[4];
            load_row_bf16(Y1 + (size_t)gw * D, lane, y); if (l == 0) load_row(x_in + (size_t)gw * D, lane, xv); else load_row_bf16(XB + (size_t)gw * D, lane, xv);
            for (int m = gw; m < M; m += NGW) { f32x4 yn[4], xn[4];
                const int mn = (m + NGW < M) ? m + NGW : m;
                load_row_bf16(Y1 + (size_t)mn * D, lane, yn); if (l == 0) load_row(x_in + (size_t)mn * D, lane, xn); else load_row_bf16(XB + (size_t)mn * D, lane, xn);
                const float ry = row_rstd(y);
#pragma unroll
                for (int j = 0; j < 4; ++j) xv[j] += y[j] * ry * gp[j];
                store_row_bf16(XB + (size_t)m * D, lane, xv);
                const float rx = row_rstd(xv);
                if (lane == 0) RS2[m] = rx;
#pragma unroll
                for (int j = 0; j < 4; ++j) { y[j] = yn[j]; xv[j] = xn[j]; }
            }
        }
        BARRIER();
        {
            KArgs A = KA(); PH_IDS(); unsigned char* ws = A->ws;
            pg8::Gemm g{(const bf16*)(ws + WS_XN), (const bf16*)(ws + WS_WGU) + (size_t)l * NGU * D, M, NGU, D}; pg8::StaticOrder S; S.init(M, NGU, G, bx);
            pg8::EpiSwiGLU E{(bf16*)(ws + WS_ACT), DFF, (const float*)(ws + WS_RS2)};
            pg8::gemm_phase<pg8::EpiSwiGLU, pg8::StaticOrder, PG8_ALIGN, PG8_SP2>(ldsl, g, S, E, tid);
        }
        BARRIER();
        {
            KArgs A = KA(); PH_IDS(); unsigned char* ws = A->ws;
            pg8::Gemm g{(const bf16*)(ws + WS_ACT), (const bf16*)(ws + WS_WD) + (size_t)l * D * DFF, M, D, DFF}; pg8::StaticOrder S; S.init(M, D, G, bx);
            pg8::EpiY E{(bf16*)(ws + WS_Y2), D};
            pg8::gemm_phase<pg8::EpiY, pg8::StaticOrder, PG8_ALIGN, PG8_SP2>(ldsl, g, S, E, tid);
        }
        BARRIER();
        {
            KArgs A = KA(); PH_IDS(); const bf16* Y2 = (const bf16*)(A->ws + WS_Y2); bf16* XB = (bf16*)(A->ws + WS_XN);
            f32x4 gp[4]; load_row(IN_F(A, 16) + l * D, lane, gp);
            if (l + 1 < DEPTH) {
                float* LOGF = (float*)(A->ws + WS_LOGF); float* RS1 = (float*)(A->ws + WS_RS1); const float* fbias = IN_F(A, 4) + (l + 1) * NFOX;
                fill_forget_w(IN_F(A, 3) + (size_t)(l + 1) * D * INW, ldsl, tid);
                f32x4 g[4]; load_row(IN_F(A, 2) + (l + 1) * D, lane, g);
                f32x4 y[4], xv[4];
                load_row_bf16(Y2 + (size_t)gw * D, lane, y); load_row_bf16(XB + (size_t)gw * D, lane, xv);
                for (int m = gw; m < M; m += NGW) { f32x4 yn[4], xn[4];
                    const int mn = (m + NGW < M) ? m + NGW : m;
                    load_row_bf16(Y2 + (size_t)mn * D, lane, yn); load_row_bf16(XB + (size_t)mn * D, lane, xn);
                    const float ry = row_rstd(y);
#pragma unroll
                    for (int j = 0; j < 4; ++j) xv[j] += y[j] * ry * gp[j];
                    pre_norm_row(xv, g, XB + (size_t)m * D, (const LAS float*)(ldsl + WFL_OFF), fbias, LOGF, RS1, m, lane);
#pragma unroll
                    for (int j = 0; j < 4; ++j) { y[j] = yn[j]; xv[j] = xn[j]; }
                }
                BARRIER();
            } else {
                float* xout = A->out;
                f32x4 y[4], xv[4];
                load_row_bf16(Y2 + (size_t)gw * D, lane, y); load_row_bf16(XB + (size_t)gw * D, lane, xv);
                for (int m = gw; m < M; m += NGW) { f32x4 yn[4], xn[4];
                    const int mn = (m + NGW < M) ? m + NGW : m;
                    load_row_bf16(Y2 + (size_t)mn * D, lane, yn); load_row_bf16(XB + (size_t)mn * D, lane, xn);
                    const float ry = row_rstd(y);
#pragma unroll
                    for (int j = 0; j < 4; ++j) xv[j] += y[j] * ry * gp[j];
                    store_row(xout + (size_t)m * D, lane, xv);
#pragma unroll
                    for (int j = 0; j < 4; ++j) { y[j] = yn[j]; xv[j] = xn[j]; }
                }
            }
        }
    }
}

extern "C" void kernel_launch(void* const* d_in, const int* in_sizes, int n_in, void* d_out, int out_size, void* d_ws, size_t ws_size, hipStream_t stream) {
    static int grid = 0;
    if (grid == 0) {
        if (n_in != 17 || in_sizes[0] != M * D || out_size != M * D || ws_size < WS_END) { fprintf(stderr, "kernel_launch: shape/workspace mismatch (n_in %d in0 %d out %d ws %zu)\n", n_in, n_in > 0 ? in_sizes[0] : -1, out_size, ws_size); grid = -1; return; }
        int dev = 0, cus = 0, per_cu = 0;
        if (hipGetDevice(&dev) != hipSuccess || hipDeviceGetAttribute(&cus, hipDeviceAttributeMultiprocessorCount, dev) != hipSuccess) { grid = -1; return; }
        if (hipFuncSetAttribute((const void*)hymba_fwd, hipFuncAttributeMaxDynamicSharedMemorySize, LDS_BYTES) != hipSuccess) { fprintf(stderr, "kernel_launch: hipFuncSetAttribute failed\n"); grid = -1; return; }
        if (hipOccupancyMaxActiveBlocksPerMultiprocessor(&per_cu, (const void*)hymba_fwd, NWAVES * 64, LDS_BYTES) != hipSuccess || per_cu < 1) { fprintf(stderr, "kernel_launch: occupancy query says %d\n", per_cu); per_cu = 1; }
        (void)hipGetLastError();
        grid = cus;
    }
    if (grid < 0) return;
    if (hipMemsetAsync((char*)d_ws + WS_CTL, 0, CTL_ZERO_BYTES, stream) != hipSuccess) { fprintf(stderr, "kernel_launch: hipMemsetAsync failed\n"); return; }
    Args a{};
    for (int i = 0; i < 17; ++i) a.in[i] = d_in[i];
    a.out = (float*)d_out; a.ws = (unsigned char*)d_ws;
    void* kargs[] = {&a};
    const hipError_t le = hipLaunchCooperativeKernel((const void*)hymba_fwd, dim3(grid), dim3(NWAVES * 64), kargs, LDS_BYTES, stream);
    if (le != hipSuccess) fprintf(stderr, "kernel_launch: cooperative launch failed: %s (grid %d)\n", hipGetErrorName(le), grid);
}
```

```cpp
#include <hip/hip_runtime.h>
#include <cstdio>
#include <cstdint>
namespace pg8 {
#define PG8_LAS __attribute__((address_space(3)))
typedef unsigned short bf16_t;
typedef short bf16x8 __attribute__((ext_vector_type(8)));
typedef float f32x4 __attribute__((ext_vector_type(4)));
typedef unsigned u32x4 __attribute__((ext_vector_type(4)));
constexpr int BM = 256, BK = 64, HALF = 128, HTB = HALF * BK * 2  , STAGE_BYTES = 8 * HTB, NXCD = 8, WGM = 4;

__host__ __device__ __forceinline__ int lds_byte(int r, int c) { const int st = (r >> 4) * 2 + (c >> 5), rr = r & 15, cc = c & 31, ob = rr * 64 + cc * 2; return st * 1024 + (ob ^ (((ob >> 9) & 1) << 5)); }
__host__ __device__ __forceinline__ void stage_rc(int b, int& R, int& C) { const int st = b / 1024, sb = b % 1024, swz = sb ^ (((sb >> 9) & 1) << 5); R = (st >> 1) * 16 + swz / 64; C = (st & 1) * 32 + (swz % 64) / 2; }
__host__ __device__ __forceinline__ int perm32(int rho) { const int n = rho >> 4, i = rho & 15; return 8 * (i >> 2) + 4 * n + (i & 3); }

struct Unit { int pm, pn; };
struct Gemm { const bf16_t* A; const bf16_t* Bt; int M, N, K; };

struct StaticOrder {
    int nM, nN, nwg, G, c;
    __host__ __device__ void init(int M, int N, int G_, int c_) { nM = M / BM; nN = N / BM; nwg = nM * nN; G = G_; c = c_; }
    __host__ __device__ bool next(int i, Unit& u) const {
        const long L = (long)i * G + c; if (L >= nwg) return false;
        int wgid = (int)L; { const int q = nwg / NXCD, r = nwg % NXCD, xcd = wgid % NXCD, off = wgid / NXCD; wgid = (xcd < r ? xcd * (q + 1) : r * (q + 1) + (xcd - r) * q) + off; }
        const int nig = WGM * nN, gid = wgid / nig, fm = gid * WGM, gsz = (nM - fm) < WGM ? (nM - fm) : WGM;
        u.pm = fm + ((wgid % nig) % gsz); u.pn = (wgid % nig) / gsz; return true;
    }
    __device__ __forceinline__ void a_ready(const Unit&) const {}
    __device__ __forceinline__ void done(const Unit&) const {}
};

__device__ __forceinline__ unsigned cvt_pk_bf16(float lo, float hi) { unsigned r; asm volatile("v_cvt_pk_bf16_f32 %0, %1, %2" : "=v"(r) : "v"(lo), "v"(hi)); return r; }
typedef float f32x2 __attribute__((ext_vector_type(2)));
constexpr float QSCALE = 0.125f * 1.4426950408889634f;
typedef unsigned u32x4 __attribute__((ext_vector_type(4)));
struct EpiQKV {
    static constexpr bool PERM = true, AFTER_DRAIN = false;
    bf16_t* O; const float* rot; const float* rs;
    __device__ __forceinline__ void pre(const Unit& u, int wr, int fr, float (&rsv)[8]) const {
#pragma unroll
        for (int i = 0; i < 8; ++i) rsv[i] = rs[u.pm * BM + wr * 64 + fr + (i >> 2) * HALF + (i & 3) * 16]; }
    __device__ __forceinline__ void operator()(const f32x4 (&acc)[2][2][4][2], const Unit& u, int wr, int wc, int fr, int fq, const float (&rsv)[8]) const {
        const int row0 = u.pm * BM + wr * 64 + fr, col0 = u.pn * BM + wc * 32 + 8 * fq;
        const bool isq = (u.pn < 2) || (u.pn == 6) || (u.pn == 7);
        const float sc = isq ? QSCALE : 1.f;
        const bool rotw = (u.pn < 4) && ((wc & 1) == 0);
        const float sgn = (fq == 0) ? -1.f : 1.f; const bool rotl = fq < 2; const int pidx = (((fq ^ 1) << 4) | fr) << 2;
#pragma unroll
        for (int ai = 0; ai < 2; ++ai)
#pragma unroll
            for (int m = 0; m < 4; ++m) { const int row = row0 + ai * HALF + m * 16; bf16_t* rowp = O + (size_t)row * 3072 + col0; const float scr_ = sc * rsv[ai * 4 + m];
                f32x4 c0 = {1.f, 1.f, 1.f, 1.f}, c1 = c0, s0 = {0.f, 0.f, 0.f, 0.f}, s1 = s0;
                if (rotw) { const f32x4* rp = (const f32x4*)(rot + (size_t)row * 16); c0 = rp[0]; c1 = rp[1]; s0 = rp[2]; s1 = rp[3]; }
#pragma unroll
                for (int bj = 0; bj < 2; ++bj) { f32x4 v0 = acc[ai][bj][m][0], v1 = acc[ai][bj][m][1];
                    if (rotw) { f32x4 p0, p1;
#pragma unroll
                        for (int j = 0; j < 4; ++j) { const float a0 = v0[j], a1 = v1[j]; p0[j] = __int_as_float(__builtin_amdgcn_ds_bpermute(pidx, __float_as_int(a0))); p1[j] = __int_as_float(__builtin_amdgcn_ds_bpermute(pidx, __float_as_int(a1))); }
                        if (rotl) { v0 = v0 * c0 + (p0 * s0) * sgn; v1 = v1 * c1 + (p1 * s1) * sgn; } }
                    v0 = v0 * scr_; v1 = v1 * scr_; u32x4 w; w.x = cvt_pk_bf16(v0[0], v0[1]); w.y = cvt_pk_bf16(v0[2], v0[3]); w.z = cvt_pk_bf16(v1[0], v1[1]); w.w = cvt_pk_bf16(v1[2], v1[3]);
                    *(u32x4*)(rowp + bj * HALF) = w; } }
    }
};
struct EpiY {
    static constexpr bool PERM = true, AFTER_DRAIN = false;
    bf16_t* O; int ldc;
    __device__ __forceinline__ void pre(const Unit&, int, int, float (&rsv)[8]) const {
#pragma unroll
        for (int i = 0; i < 8; ++i) rsv[i] = 1.f; }
    __device__ __forceinline__ void operator()(const f32x4 (&acc)[2][2][4][2], const Unit& u, int wr, int wc, int fr, int fq, const float (&rsv)[8]) const {
        const int row0 = u.pm * BM + wr * 64 + fr, col0 = u.pn * BM + wc * 32 + 8 * fq;
#pragma unroll
        for (int ai = 0; ai < 2; ++ai)
#pragma unroll
            for (int m = 0; m < 4; ++m) { bf16_t* rowp = O + (size_t)(row0 + ai * HALF + m * 16) * ldc + col0;
#pragma unroll
                for (int bj = 0; bj < 2; ++bj) { const f32x4 v0 = acc[ai][bj][m][0], v1 = acc[ai][bj][m][1];
                    u32x4 w; w.x = cvt_pk_bf16(v0[0], v0[1]); w.y = cvt_pk_bf16(v0[2], v0[3]); w.z = cvt_pk_bf16(v1[0], v1[1]); w.w = cvt_pk_bf16(v1[2], v1[3]);
                    *(u32x4*)(rowp + bj * HALF) = w; } }
    }
};
struct EpiSwiGLU {
    static constexpr bool PERM = true, AFTER_DRAIN = false;
    bf16_t* O; int ldc; const float* rs;
    __device__ __forceinline__ void pre(const Unit& u, int wr, int fr, float (&rsv)[8]) const {
#pragma unroll
        for (int i = 0; i < 8; ++i) rsv[i] = rs[u.pm * BM + wr * 64 + fr + (i >> 2) * HALF + (i & 3) * 16]; }
    __device__ __forceinline__ void operator()(const f32x4 (&acc)[2][2][4][2], const Unit& u, int wr, int wc, int fr, int fq, const float (&rsv)[8]) const {
        const int row0 = u.pm * BM + wr * 64 + fr, col0 = u.pn * HALF + wc * 32 + 8 * fq;
#pragma unroll
        for (int ai = 0; ai < 2; ++ai)
#pragma unroll
            for (int m = 0; m < 4; ++m) { bf16_t* rowp = O + (size_t)(row0 + ai * HALF + m * 16) * ldc + col0; float r[8]; const float rr = rsv[ai * 4 + m];
#pragma unroll
                for (int n = 0; n < 2; ++n)
#pragma unroll
                    for (int j = 0; j < 4; ++j) { const float g = acc[ai][0][m][n][j] * rr, up = acc[ai][1][m][n][j] * rr;
                        const float e = __builtin_amdgcn_exp2f(g * -1.4426950408889634f); r[n * 4 + j] = g * __builtin_amdgcn_rcpf(1.0f + e) * up; }
                u32x4 w; w.x = cvt_pk_bf16(r[0], r[1]); w.y = cvt_pk_bf16(r[2], r[3]); w.z = cvt_pk_bf16(r[4], r[5]); w.w = cvt_pk_bf16(r[6], r[7]);
                *(u32x4*)rowp = w; }
    }
};
template <class Epi, class Sched, bool ALIGN_EPI = false, bool SP2 = false>
__device__ __forceinline__ void gemm_phase(PG8_LAS unsigned char* lds, const Gemm g, const Sched& S, const Epi& E, const int tid_in) {
    int tid = tid_in; asm volatile("" : "+v"(tid)); const int wid = __builtin_amdgcn_readfirstlane(tid >> 6), lane = tid & 63, wr = wid >> 2, wc = wid & 3, fr = lane & 15, fq = lane >> 4;
    const int K = g.K, nt = K / BK;
    unsigned voffA[2], voffB[2];
#pragma unroll
    for (int i = 0; i < 2; ++i) { int R, C; stage_rc(tid * 16 + i * 8192, R, C); const int Rb = Epi::PERM ? ((R & ~31) + perm32(R & 31)) : R;
        voffA[i] = (unsigned)(R * K + C) * 2u; voffB[i] = (unsigned)(Rb * K + C) * 2u; }
    const size_t kstep = (size_t)(BK * 2);
    const size_t hstep = (size_t)HALF * K * 2;
    const size_t tstep = 2 * hstep;
    const unsigned ldsw = (unsigned)wid * 1024u;
    const int aoff = lds_byte(wr * 64 + fr, fq * 8), boff = lds_byte(wc * 32 + fr, fq * 8);
#define PG8_SA(b, h) (((b) * 2 + (h)) * HTB)
#define PG8_SB(b, h) ((4 + (b) * 2 + (h)) * HTB)
#define PG8_STAGE(bufoff, gbase, voff) do { _Pragma("unroll") for (int _i = 0; _i < 2; ++_i) \
        __builtin_amdgcn_global_load_lds((const unsigned*)((const char*)(gbase) + (voff)[_i]), (PG8_LAS unsigned*)(lds + (bufoff) + ldsw + _i * 8192), 16, 0, 0); } while (0)
#define PG8_LDA(dst, b, h) do { _Pragma("unroll") for (int m = 0; m < 4; ++m) _Pragma("unroll") for (int k = 0; k < 2; ++k) dst[m][k] = *(const PG8_LAS bf16x8*)(lds + PG8_SA(b, h) + aoff + m * 2048 + k * 1024); } while (0)
#define PG8_LDB(dst, b, h) do { _Pragma("unroll") for (int n = 0; n < 2; ++n) _Pragma("unroll") for (int k = 0; k < 2; ++k) dst[n][k] = *(const PG8_LAS bf16x8*)(lds + PG8_SB(b, h) + boff + n * 2048 + k * 1024); } while (0)
#define PG8_MMA(ai, bj, At, Bt) do { __builtin_amdgcn_s_setprio(1); _Pragma("unroll") for (int m = 0; m < 4; ++m) _Pragma("unroll") for (int n = 0; n < 2; ++n) _Pragma("unroll") for (int k = 0; k < 2; ++k) \
        acc[ai][bj][m][n] = __builtin_amdgcn_mfma_f32_16x16x32_bf16(Bt[n][k], At[m][k], acc[ai][bj][m][n], 0, 0, 0); __builtin_amdgcn_s_setprio(0); } while (0)
#define PG8_WAIT_V(n) asm volatile("s_waitcnt vmcnt(" #n ")" ::: "memory")
#define PG8_WAIT_L(n) asm volatile("s_waitcnt lgkmcnt(" #n ")" ::: "memory")
#define PG8_BAR __builtin_amdgcn_s_barrier()
#define PG8_SCHED __builtin_amdgcn_sched_barrier(0)
    Unit cur, nxt; int ui = 0;
    if (!S.next(0, cur)) return;
    f32x4 acc[2][2][4][2];
#pragma unroll
    for (int a = 0; a < 2; ++a)
#pragma unroll
        for (int b = 0; b < 2; ++b)
#pragma unroll
            for (int m = 0; m < 4; ++m)
#pragma unroll
                for (int n = 0; n < 2; ++n) acc[a][b][m][n] = (f32x4){0.f, 0.f, 0.f, 0.f};
    bf16x8 At[4][2], B0[2][2], B1[2][2];
    const char* cA = (const char*)g.A + (size_t)cur.pm * tstep; const char* cB = (const char*)g.Bt + (size_t)cur.pn * tstep;
    S.a_ready(cur);
    if constexpr (SP2) {
        PG8_STAGE(PG8_SB(0, 0), cB, voffB); PG8_STAGE(PG8_SB(0, 1), cB + hstep, voffB); PG8_STAGE(PG8_SA(0, 0), cA, voffA); PG8_STAGE(PG8_SA(0, 1), cA + hstep, voffA);
        if (wr == 1) PG8_BAR;
        PG8_WAIT_V(2); PG8_BAR;
        PG8_STAGE(PG8_SB(1, 0), cB + kstep, voffB); PG8_STAGE(PG8_SA(1, 0), cA + kstep, voffA); PG8_STAGE(PG8_SB(1, 1), cB + hstep + kstep, voffB);
        PG8_WAIT_V(6); PG8_BAR;
    } else {
        PG8_STAGE(PG8_SB(0, 0), cB, voffB); PG8_STAGE(PG8_SA(0, 0), cA, voffA); PG8_STAGE(PG8_SB(0, 1), cB + hstep, voffB); PG8_STAGE(PG8_SA(0, 1), cA + hstep, voffA);
        if (wr == 1) PG8_BAR;
        PG8_WAIT_V(4); PG8_BAR;
        PG8_STAGE(PG8_SB(1, 0), cB + kstep, voffB); PG8_STAGE(PG8_SA(1, 0), cA + kstep, voffA); PG8_STAGE(PG8_SB(1, 1), cB + hstep + kstep, voffB);
        PG8_WAIT_V(6); PG8_BAR;
    }
    for (;;) {
        float rsv[8]; E.pre(cur, wr, fr, rsv);
        const bool has_next = S.next(ui + 1, nxt);
        const char* nA = has_next ? (const char*)g.A + (size_t)nxt.pm * tstep : cA; const char* nB = has_next ? (const char*)g.Bt + (size_t)nxt.pn * tstep : cB;
        for (int t = 0; t < nt; t += 2) {
            const bool last = (t == nt - 2);
            const char* a1 = cA + (size_t)(t + 1) * kstep;
            const char* a2 = last ? nA : cA + (size_t)(t + 2) * kstep; const char* b2 = last ? nB : cB + (size_t)(t + 2) * kstep;
            const char* a3 = a2 + kstep; const char* b3 = b2 + kstep;
            if (last && has_next) S.a_ready(nxt);
            if constexpr (SP2) {
            PG8_LDB(B0, 0, 0); PG8_LDB(B1, 0, 1); PG8_SCHED; PG8_LDA(At, 0, 0); PG8_STAGE(PG8_SA(1, 1), a1 + hstep, voffA);
            PG8_WAIT_V(8); PG8_WAIT_L(0); PG8_BAR; PG8_MMA(0, 0, At, B0); PG8_MMA(0, 1, At, B1); PG8_BAR; PG8_SCHED;
            PG8_LDA(At, 0, 1); PG8_STAGE(PG8_SB(0, 0), b2, voffB); PG8_STAGE(PG8_SB(0, 1), b2 + hstep, voffB); PG8_STAGE(PG8_SA(0, 0), a2, voffA);
            PG8_WAIT_V(8); PG8_WAIT_L(0); PG8_BAR; PG8_MMA(1, 0, At, B0); PG8_MMA(1, 1, At, B1); PG8_BAR; PG8_SCHED;
            PG8_LDB(B0, 1, 0); PG8_LDB(B1, 1, 1); PG8_SCHED; PG8_LDA(At, 1, 0); PG8_STAGE(PG8_SA(0, 1), a2 + hstep, voffA);
            PG8_WAIT_V(8); PG8_WAIT_L(0); PG8_BAR; PG8_MMA(0, 0, At, B0); PG8_MMA(0, 1, At, B1); PG8_BAR; PG8_SCHED;
            PG8_LDA(At, 1, 1); PG8_STAGE(PG8_SB(1, 0), b3, voffB); PG8_STAGE(PG8_SB(1, 1), b3 + hstep, voffB); PG8_STAGE(PG8_SA(1, 0), a3, voffA);
            PG8_WAIT_V(8); PG8_WAIT_L(0); PG8_BAR; PG8_MMA(1, 0, At, B0); PG8_MMA(1, 1, At, B1); PG8_BAR; PG8_SCHED;
            } else {
            PG8_LDB(B0, 0, 0); PG8_SCHED; PG8_LDA(At, 0, 0); PG8_STAGE(PG8_SA(1, 1), a1 + hstep, voffA);
            PG8_WAIT_L(8); PG8_BAR; PG8_WAIT_L(0); PG8_MMA(0, 0, At, B0); PG8_BAR; PG8_SCHED;
            PG8_LDB(B1, 0, 1); PG8_STAGE(PG8_SB(0, 0), b2, voffB);
            PG8_BAR; PG8_WAIT_L(0); PG8_MMA(0, 1, At, B1); PG8_BAR;
            PG8_LDA(At, 0, 1); PG8_STAGE(PG8_SA(0, 0), a2, voffA);
            PG8_BAR; PG8_WAIT_L(0); PG8_MMA(1, 0, At, B0); PG8_BAR; PG8_SCHED;
            PG8_STAGE(PG8_SB(0, 1), b2 + hstep, voffB);
            PG8_WAIT_V(6); PG8_BAR; PG8_MMA(1, 1, At, B1); PG8_BAR;
            PG8_LDB(B0, 1, 0); PG8_SCHED; PG8_LDA(At, 1, 0); PG8_STAGE(PG8_SA(0, 1), a2 + hstep, voffA);
            PG8_WAIT_L(8); PG8_BAR; PG8_WAIT_L(0); PG8_MMA(0, 0, At, B0); PG8_BAR; PG8_SCHED;
            PG8_LDB(B1, 1, 1); PG8_STAGE(PG8_SB(1, 0), b3, voffB);
            PG8_BAR; PG8_WAIT_L(0); PG8_MMA(0, 1, At, B1); PG8_BAR;
            PG8_LDA(At, 1, 1); PG8_STAGE(PG8_SA(1, 0), a3, voffA);
            PG8_BAR; PG8_WAIT_L(0); PG8_MMA(1, 0, At, B0); PG8_BAR; PG8_SCHED;
            PG8_STAGE(PG8_SB(1, 1), b3 + hstep, voffB);
            PG8_WAIT_V(6); PG8_BAR; PG8_MMA(1, 1, At, B1); PG8_BAR;
            }
        }
        if constexpr (ALIGN_EPI) { if (wr == 0) PG8_BAR; }
        if constexpr (!Epi::AFTER_DRAIN) { E(acc, cur, wr, wc, fr, fq, rsv); S.done(cur); }
        if (!has_next) break;
#pragma unroll
        for (int a = 0; a < 2; ++a)
#pragma unroll
            for (int b = 0; b < 2; ++b)
#pragma unroll
                for (int m = 0; m < 4; ++m)
#pragma unroll
                    for (int n = 0; n < 2; ++n) acc[a][b][m][n] = (f32x4){0.f, 0.f, 0.f, 0.f};
        cur = nxt; cA = nA; cB = nB; ++ui;
        if constexpr (ALIGN_EPI) { if (wr == 1) PG8_BAR; }
    }
    PG8_WAIT_V(0);
    if constexpr (!ALIGN_EPI) { if (wr == 0) PG8_BAR; }
    PG8_BAR;
    if constexpr (Epi::AFTER_DRAIN) { E.fused(acc, cur, wr, wc, fr, fq, lds, wid, lane); S.done(cur); }
#undef PG8_SA
#undef PG8_SB
#undef PG8_STAGE
#undef PG8_LDA
#undef PG8_LDB
#undef PG8_MMA
#undef PG8_WAIT_V
#undef PG8_WAIT_L
#undef PG8_BAR
#undef PG8_SCHED
}
}

#ifndef PG8_SP2
#define PG8_SP2 true
#endif
#ifndef PG8_ALIGN
#define PG8_ALIGN true
#endif
#include <hip/hip_bf16.h>
#include <cmath>
namespace attn_body {
using bf16=__hip_bfloat16;
using bf16x8=__attribute__((ext_vector_type(8)))short;
using s16x4=__attribute__((ext_vector_type(4)))short;
using f32x16=__attribute__((ext_vector_type(16)))float;
using u32x4=__attribute__((ext_vector_type(4)))unsigned;
constexpr int BATCH=4,SEQ=8192,D=64,DMI=3072,DMO=1024;
constexpr int NW=8,QBLK=32,QB=QBLK*NW,KVBLK=64,NQB=SEQ/QB;
constexpr int ATTN_UNIT_ROWS=QB;
__device__ __forceinline__ int crow(int r,int hi){return (r&3)+8*(r>>2)+4*hi;}
#define SBAR() __builtin_amdgcn_sched_barrier(0)
__device__ __forceinline__ void cmask(f32x16&p0,f32x16&p1,int jb,int qrel,int hi){
  const float NEG=-INFINITY; int kb=64*jb+4*hi;
  #pragma unroll
  for(int r=0;r<16;++r){int kv=kb+(r&3)+8*(r>>2); if(kv>qrel)p0[r]=NEG; if(kv+32>qrel)p1[r]=NEG;}
}

constexpr int NSLOT=3, SLOTB=8192;
constexpr int LDS_K=0, LDS_V=NSLOT*SLOTB, LDS_WS=2*NSLOT*SLOTB, LDS_OST=LDS_WS+NW*64*4, LDS_BIAS=LDS_OST+NW*4096, LDS_BYTES=LDS_BIAS+SEQ*4;
constexpr float C2=0.125f*1.4426950408889634f;
__device__ __forceinline__ void glds16(const void*gsrc,unsigned lds_dst){unsigned keep;
  asm volatile("s_mov_b32 %0, m0\n\ts_mov_b32 m0, %2\n\ts_nop 0\n\tglobal_load_lds_dwordx4 %1, off\n\ts_mov_b32 m0, %0":"=&s"(keep):"v"(gsrc),"s"(lds_dst):"memory");}
__device__ __forceinline__ float max3f(float a,float b,float c){float r;asm("v_max3_f32 %0, %1, %2, %3":"=v"(r):"v"(a),"v"(b),"v"(c));return r;}
__device__ __forceinline__ float max2f(float a,float b){float r;asm("v_max_f32_e32 %0, %1, %2":"=v"(r):"v"(a),"v"(b));return r;}
__device__ __forceinline__ float fadd_s(float a,float b){float r;asm("v_add_f32_e32 %0, %1, %2":"=v"(r):"v"(a),"v"(b));return r;}
__device__ __forceinline__ float fsub_s(float a,float b){float r;asm("v_sub_f32_e32 %0, %1, %2":"=v"(r):"v"(a),"v"(b));return r;}
typedef float f32x2_t __attribute__((ext_vector_type(2))); typedef __bf16 bf16x2_t __attribute__((ext_vector_type(2)));
__device__ __forceinline__ unsigned cvtpk_s(float lo,float hi){f32x2_t v={lo,hi};bf16x2_t b=__builtin_convertvector(v,bf16x2_t);return __builtin_bit_cast(unsigned,b);}
#define WAIT_BAR(N) asm volatile("s_waitcnt vmcnt(" #N ") lgkmcnt(0)\n\ts_barrier":::"memory")

__device__ __forceinline__ void qkt(f32x16&p0,f32x16&p1,const char*Kslot,const bf16x8*qr,const f32x16&negm,int r32,int hi){
  const char*kb=Kslot+hi*1024+r32*16;
  #pragma unroll
  for(int d0=0;d0<4;++d0){
    const bf16x8 b0=*reinterpret_cast<const bf16x8*>(kb+d0*2048);
    const bf16x8 b1=*reinterpret_cast<const bf16x8*>(kb+d0*2048+512);
    if(d0==0){p0=__builtin_amdgcn_mfma_f32_32x32x16_bf16(b0,qr[0],negm,0,0,0);p1=__builtin_amdgcn_mfma_f32_32x32x16_bf16(b1,qr[0],negm,0,0,0);}
    else{p0=__builtin_amdgcn_mfma_f32_32x32x16_bf16(b0,qr[d0],p0,0,0,0);p1=__builtin_amdgcn_mfma_f32_32x32x16_bf16(b1,qr[d0],p1,0,0,0);}}
}
typedef __attribute__((address_space(3))) const char* lds_cptr;
typedef short v4i16_t __attribute__((ext_vector_type(4)));
__device__ __forceinline__ void kload8(bf16x8*kf,lds_cptr kp){
  kf[0]=*(const __attribute__((address_space(3))) bf16x8*)(kp);      kf[1]=*(const __attribute__((address_space(3))) bf16x8*)(kp+512);
  kf[2]=*(const __attribute__((address_space(3))) bf16x8*)(kp+2048); kf[3]=*(const __attribute__((address_space(3))) bf16x8*)(kp+2560);
  kf[4]=*(const __attribute__((address_space(3))) bf16x8*)(kp+4096); kf[5]=*(const __attribute__((address_space(3))) bf16x8*)(kp+4608);
  kf[6]=*(const __attribute__((address_space(3))) bf16x8*)(kp+6144); kf[7]=*(const __attribute__((address_space(3))) bf16x8*)(kp+6656);
}
__device__ __forceinline__ void kload2(bf16x8*kf,lds_cptr kp,int j){ kf[2*j]=*(const __attribute__((address_space(3))) bf16x8*)(kp+j*2048); kf[2*j+1]=*(const __attribute__((address_space(3))) bf16x8*)(kp+j*2048+512); }
__device__ __forceinline__ s16x4 vtr(lds_cptr p){ return __builtin_bit_cast(s16x4,__builtin_amdgcn_ds_read_tr16_b64_v4i16((__attribute__((address_space(3))) v4i16_t*)p)); }
__device__ __forceinline__ float rowmax(const f32x16&p0,const f32x16&p1){
  float a=max3f(p0[0],p0[1],p1[0]),b=max3f(p0[2],p0[3],p1[1]);a=max3f(a,p1[2],p1[3]);
  #pragma unroll
  for(int r=4;r<16;r+=4){a=max3f(a,p0[r],p0[r+1]);b=max3f(b,p0[r+2],p0[r+3]);a=max3f(a,p1[r],p1[r+1]);b=max3f(b,p1[r+2],p1[r+3]);}
  const float m=max2f(a,b);
  auto rr=__builtin_amdgcn_permlane32_swap(__float_as_uint(m),__float_as_uint(m),false,false);
  return max2f(__uint_as_float(rr[0]),__uint_as_float(rr[1]));
}
__device__ __forceinline__ void pv(f32x16*o,int vb,bf16x8 pa0,bf16x8 pa1,bf16x8 pa2,bf16x8 pa3){
  #pragma unroll
  for(int d0=0;d0<2;++d0){s16x4 lo[4],hi[4];
    #pragma unroll
    for(int ks=0;ks<4;++ks){
      asm volatile("ds_read_b64_tr_b16 %0,%1 offset:%c2":"=&v"(lo[ks]):"v"(vb),"i"(d0*4096+ks*1024):"memory");
      asm volatile("ds_read_b64_tr_b16 %0,%1 offset:%c2":"=&v"(hi[ks]):"v"(vb),"i"(d0*4096+ks*1024+512):"memory");}
    asm volatile("s_waitcnt lgkmcnt(0)":::"memory");SBAR();
    #define PK(k) (bf16x8){lo[k][0],lo[k][1],lo[k][2],lo[k][3],hi[k][0],hi[k][1],hi[k][2],hi[k][3]}
    o[d0]=__builtin_amdgcn_mfma_f32_32x32x16_bf16(pa0,PK(0),o[d0],0,0,0);
    o[d0]=__builtin_amdgcn_mfma_f32_32x32x16_bf16(pa1,PK(1),o[d0],0,0,0);
    o[d0]=__builtin_amdgcn_mfma_f32_32x32x16_bf16(pa2,PK(2),o[d0],0,0,0);
    o[d0]=__builtin_amdgcn_mfma_f32_32x32x16_bf16(pa3,PK(3),o[d0],0,0,0);
    #undef PK
  }
}

#ifndef ATTN_STORE16
#define ATTN_STORE16(p,v) (*(u32x4*)(p)=(v))
#endif
template<int THRL,bool BIAS> __device__ __forceinline__ void attn_unit(int b,int qb,const bf16*Q,const bf16*__restrict__ K,const bf16*__restrict__ V,bf16*O,const float*__restrict__ biasg,char*shm,const int tid_in){
  int tid=tid_in; asm volatile("":"+v"(tid)); const int lane=tid&63,r32=lane&31,hi=lane>>5; const int wid=__builtin_amdgcn_readfirstlane(tid>>6);
  const long rowbase=(long)b*SEQ; const int q0=qb*QB;
  const bf16*Qw=Q+(rowbase+q0+wid*QBLK)*DMI;
  int t0=0;
  if(BIAS){ const int NT0=(q0+QB)/KVBLK; const float bq=biasg[q0]; int cnt=0;
    _Pragma("unroll") for(int h2=0;h2<2;++h2){ const int T=lane+64*h2; const bool sk=(T<NT0-4)&&(biasg[64*(T<NT0?T:0)+63]-bq<-64.f); cnt+=__popcll(__ballot(sk)); }
    t0=__builtin_amdgcn_readfirstlane(cnt)&~1; }
  const float*bg=BIAS?biasg+t0*KVBLK:biasg;
  const bf16*Kh=K+(rowbase+t0*KVBLK)*DMI,*Vh=V+(rowbase+t0*KVBLK)*DMI;
  const unsigned lds0=(unsigned)(uintptr_t)shm;
  float*wsf=(float*)(shm+LDS_WS)+wid*64;
  const bf16*ksrc=Kh+(long)lane*DMI+wid*8;
  const bf16*vsrc=Vh+(long)(16*(wid&3)+(lane>>2))*DMI+(wid>>2)*32+(lane&3)*8;
  const unsigned kdst=lds0+LDS_K+wid*1024, vdst=lds0+LDS_V+wid*1024;
  #define DMA_K(t,slot) glds16(ksrc+(long)(t)*KVBLK*DMI,(unsigned)__builtin_amdgcn_readfirstlane(kdst+(slot)))
  #define DMA_V(t,slot) glds16(vsrc+(long)(t)*KVBLK*DMI,(unsigned)__builtin_amdgcn_readfirstlane(vdst+(slot)))
  const int vb0=(int)(lds0+LDS_V)+((lane>>4)&1)*32+(lane&3)*8+(4*hi+((lane&15)>>2))*64;
  const char*Kbase=shm+LDS_K; bf16x8 kf[8];
  const lds_cptr shm3=(lds_cptr)shm; const lds_cptr kp0=shm3+LDS_K+hi*1024+r32*16; const lds_cptr vp0=shm3+LDS_V+((lane>>4)&1)*32+(lane&3)*8+(4*hi+((lane&15)>>2))*64;
  const int NT=(q0+QB)/KVBLK-t0;
  typedef __attribute__((address_space(3))) const float* lds_fptr; typedef float f32x4_t __attribute__((ext_vector_type(4)));
  const lds_fptr biasl=(lds_fptr)(shm3+LDS_BIAS)+4*hi;
  if(BIAS){ __attribute__((address_space(3))) float* bw=(__attribute__((address_space(3))) float*)(shm3+LDS_BIAS); const int nb=NT*KVBLK;
    for(int i=tid*4;i<nb;i+=NW*64*4)*(__attribute__((address_space(3))) f32x4_t*)(bw+i)=*(const f32x4_t*)(bg+i); }
  #define BIASADD(P0,P1,t) do{ if(BIAS){ const lds_fptr bp_=biasl+KVBLK*(t); _Pragma("unroll") for(int i_=0;i_<4;++i_){ \
      const f32x4_t b0_=*(const __attribute__((address_space(3))) f32x4_t*)(bp_+8*i_), b1_=*(const __attribute__((address_space(3))) f32x4_t*)(bp_+32+8*i_); \
      _Pragma("unroll") for(int j_=0;j_<4;++j_){ P0[4*i_+j_]+=b0_[j_]; P1[4*i_+j_]+=b1_[j_]; } } } }while(0)
  DMA_K(0,0);DMA_V(0,0);DMA_K(1,SLOTB);
  bf16x8 qr[4];
  #pragma unroll
  for(int d0=0;d0<4;++d0)qr[d0]=*reinterpret_cast<const bf16x8*>(&Qw[(long)r32*DMI+d0*16+hi*8]);
  float mhat=0.f,l_reg=0.f;f32x16 o[2];o[0]=f32x16{};o[1]=f32x16{};f32x16 negm=f32x16{};asm volatile("":"+v"(negm));
  const int qrel=wid*QBLK+r32;
  #define CMASK(P0,P1,t) do{int jb_=(t)-(NT-4); if(jb_>=0)cmask(P0,P1,jb_,qrel,hi);}while(0)
  bool resc=false;
  #define START(P0,P1) do{ const float rm=rowmax(P0,P1); resc=false; \
    { const float dl=rm; mhat=fadd_s(mhat,dl); \
      _Pragma("unroll") for(int r=0;r<16;++r){P0[r]=fsub_s(P0[r],dl);P1[r]=fsub_s(P1[r],dl);} \
      _Pragma("unroll") for(int r=0;r<16;++r)negm[r]=-mhat; asm volatile("":"+v"(negm)); } \
    _Pragma("unroll") for(int r=0;r<16;++r)P0[r]=__builtin_amdgcn_exp2f(P0[r]); }while(0)
  #define RESC() do{ if(resc){ asm volatile("s_waitcnt lgkmcnt(0)":::"memory"); \
      _Pragma("unroll") for(int d_=0;d_<2;++d_) _Pragma("unroll") for(int r=0;r<16;++r)o[d_][r]*=wsf[crow(r,hi)]; } }while(0)
  f32x16 pA0,pA1,pB0,pB1;
  int sl_prev=0,sl_cur=0,sl_next=SLOTB;
  #define ROT() do{sl_prev=sl_cur;sl_cur=sl_next;sl_next=(sl_next==(NSLOT-1)*SLOTB)?0:sl_next+SLOTB;}while(0)
  DMA_K(2,2*SLOTB);
  WAIT_BAR(3);
  qkt(pA0,pA1,Kbase,qr,negm,r32,hi);asm volatile("s_nop 15\n\ts_nop 7":"+v"(pA0),"+v"(pA1));BIASADD(pA0,pA1,0);CMASK(pA0,pA1,0);
  START(pA0,pA1);
  _Pragma("unroll") for(int r=0;r<16;++r)pA1[r]=__builtin_amdgcn_exp2f(pA1[r]);
  WAIT_BAR(0);
  DMA_K(3,0);DMA_V(1,SLOTB);
  ROT();
  kload8(kf,kp0+sl_cur);
  WAIT_BAR(2);
  s16x4 vlo[8],vhi[8]; u32x4 pw0,pw1,pw2,pw3;
  #define PKW(P,B) cvtpk_s(P[B],P[B+1])
  #define PAF(k) __builtin_bit_cast(bf16x8,pw##k)
  #define VFR(i) (bf16x8){vlo[i][0],vlo[i][1],vlo[i][2],vlo[i][3],vhi[i][0],vhi[i][1],vhi[i][2],vhi[i][3]}
  #define PIN(x) asm volatile("":"+v"(x))
  #define MX3(a,b,c) __builtin_fmaxf(__builtin_fmaxf((a),(b)),(c))
  #define GAPA(MF,A0,A1,A2,A3,W0,W1,PW) do{ MF; sacc+=A0; sacc+=A1; sacc+=A2; sacc+=A3; PIN(sacc); W0; W1; PIN(PW); SBAR(); }while(0)
  #define EX(v) __builtin_amdgcn_exp2f(v)
  #define GAPB(MF,X,B) do{ MF; X[B]=EX(X[B]); X[B+1]=EX(X[B+1]); X[B+2]=EX(X[B+2]); X[B+3]=EX(X[B+3]); PIN(X); SBAR(); }while(0)
  #define VRD(i) do{ vlo[i]=vtr(vp_+(((i)>>2)*4096+((i)&3)*1024)); vhi[i]=vtr(vp_+(((i)>>2)*4096+((i)&3)*1024+512)); }while(0)
  #define KRD(G,j) do{ if(G){ kload2(kf,kp0+sl_next,j); SBAR(); } }while(0)
  #define STEP(C0,C1,P0,P1,t,GK,GV,GL) do{ SBAR(); \
    const lds_cptr vp_=vp0+sl_prev; \
    VRD(0); SBAR(); float sacc=(P0[0]+P0[1]); \
    GAPA(C0=__builtin_amdgcn_mfma_f32_32x32x16_bf16(kf[0],qr[0],negm,0,0,0), P0[2],P0[3],P0[4],P0[5],     pw0[0]=PKW(P0,0), pw0[1]=PKW(P0,2), pw0); \
    VRD(4); SBAR(); GAPA(C1=__builtin_amdgcn_mfma_f32_32x32x16_bf16(kf[1],qr[0],negm,0,0,0), P0[6],P0[7],P0[8],P0[9],     pw0[2]=PKW(P0,4), pw0[3]=PKW(P0,6), pw0); \
    VRD(1); SBAR(); GAPA(C0=__builtin_amdgcn_mfma_f32_32x32x16_bf16(kf[2],qr[1],C0,0,0,0),   P0[10],P0[11],P0[12],P0[13], pw1[0]=PKW(P0,8), pw1[1]=PKW(P0,10), pw1); \
    VRD(5); SBAR(); GAPA(C1=__builtin_amdgcn_mfma_f32_32x32x16_bf16(kf[3],qr[1],C1,0,0,0),   P0[14],P0[15],P1[0],P1[1],   pw1[2]=PKW(P0,12),pw1[3]=PKW(P0,14), pw1); \
    VRD(2); SBAR(); GAPA(C0=__builtin_amdgcn_mfma_f32_32x32x16_bf16(kf[4],qr[2],C0,0,0,0),   P1[2],P1[3],P1[4],P1[5],     pw2[0]=PKW(P1,0), pw2[1]=PKW(P1,2), pw2); \
    VRD(6); SBAR(); GAPA(C1=__builtin_amdgcn_mfma_f32_32x32x16_bf16(kf[5],qr[2],C1,0,0,0),   P1[6],P1[7],P1[8],P1[9],     pw2[2]=PKW(P1,4), pw2[3]=PKW(P1,6), pw2); \
    VRD(3); SBAR(); GAPA(C0=__builtin_amdgcn_mfma_f32_32x32x16_bf16(kf[6],qr[3],C0,0,0,0),   P1[10],P1[11],P1[12],P1[13], pw3[0]=PKW(P1,8), pw3[1]=PKW(P1,10), pw3); \
    VRD(7); SBAR(); GAPA(C1=__builtin_amdgcn_mfma_f32_32x32x16_bf16(kf[7],qr[3],C1,0,0,0),   P1[14],P1[15],0.f,0.f,       pw3[2]=PKW(P1,12),pw3[3]=PKW(P1,14), pw3); \
    l_reg+=sacc; \
    if(GK){DMA_K((t)+3,sl_cur);} if(GV){DMA_V((t)+1,sl_next);} \
    BIASADD(C0,C1,t); CMASK(C0,C1,t); \
    { float a=MX3(C0[0],C0[1],C1[0]),b=MX3(C0[2],C0[3],C1[1]); a=MX3(a,C1[2],C1[3]); \
      _Pragma("unroll") for(int r=4;r<16;r+=4){a=MX3(a,C0[r],C0[r+1]);b=MX3(b,C0[r+2],C0[r+3]);a=MX3(a,C1[r],C1[r+1]);b=MX3(b,C1[r+2],C1[r+3]);} \
      float rm=__builtin_fmaxf(a,b); { auto rr=__builtin_amdgcn_permlane32_swap(__float_as_uint(rm),__float_as_uint(rm),false,false); rm=__builtin_fmaxf(__uint_as_float(rr[0]),__uint_as_float(rr[1])); } \
      resc=false; \
      if(__builtin_expect(__any(rm>(float)THRL),0)){ const float dl=__builtin_fmaxf(rm,0.f); mhat+=dl; \
        _Pragma("unroll") for(int r=0;r<16;++r){C0[r]-=dl;C1[r]-=dl;} \
        _Pragma("unroll") for(int r=0;r<16;++r)negm[r]=-mhat; asm volatile("":"+v"(negm)); \
        const float f=__builtin_amdgcn_exp2f(-dl); l_reg*=f; if(hi==0)wsf[r32]=f; resc=true; } } \
    SBAR(); \
    GAPB(o[0]=__builtin_amdgcn_mfma_f32_32x32x16_bf16(PAF(0),VFR(0),o[0],0,0,0), C0,0); \
    GAPB(o[1]=__builtin_amdgcn_mfma_f32_32x32x16_bf16(PAF(0),VFR(4),o[1],0,0,0), C0,4); \
    KRD(GL,0); GAPB(o[0]=__builtin_amdgcn_mfma_f32_32x32x16_bf16(PAF(1),VFR(1),o[0],0,0,0), C0,8); \
    KRD(GL,1); GAPB(o[1]=__builtin_amdgcn_mfma_f32_32x32x16_bf16(PAF(1),VFR(5),o[1],0,0,0), C0,12); \
    KRD(GL,2); GAPB(o[0]=__builtin_amdgcn_mfma_f32_32x32x16_bf16(PAF(2),VFR(2),o[0],0,0,0), C1,0); \
    KRD(GL,3); GAPB(o[1]=__builtin_amdgcn_mfma_f32_32x32x16_bf16(PAF(2),VFR(6),o[1],0,0,0), C1,4); \
    GAPB(o[0]=__builtin_amdgcn_mfma_f32_32x32x16_bf16(PAF(3),VFR(3),o[0],0,0,0), C1,8); \
    GAPB(o[1]=__builtin_amdgcn_mfma_f32_32x32x16_bf16(PAF(3),VFR(7),o[1],0,0,0), C1,12); \
    }while(0)
  int t=1;
  #undef CMASK
  #define CMASK(P0,P1,t) do{}while(0)
  for(;t+5<NT;t+=2){
    STEP(pB0,pB1,pA0,pA1,t,true,true,true);     WAIT_BAR(2); RESC(); ROT();
    STEP(pA0,pA1,pB0,pB1,t+1,true,true,true);   WAIT_BAR(2); RESC(); ROT();
  }
  #undef CMASK
  #define CMASK(P0,P1,t) do{int jb_=(t)-(NT-4); if(jb_>=0)cmask(P0,P1,jb_,qrel,hi);}while(0)
  #define ENDW(tt) do{ if((tt)+3<NT){WAIT_BAR(2);} else if((tt)+2<NT){WAIT_BAR(1);} else {WAIT_BAR(0);} }while(0)
  for(;t+1<NT;t+=2){
    STEP(pB0,pB1,pA0,pA1,t,(t+3<NT),(t+1<NT),(t+1<NT));       ENDW(t);   RESC(); ROT();
    STEP(pA0,pA1,pB0,pB1,t+1,(t+4<NT),(t+2<NT),(t+2<NT));     ENDW(t+1); RESC(); ROT();
  }
  STEP(pB0,pB1,pA0,pA1,NT-1,false,false,false); RESC();
  { float sacc=pB0[0]+pB0[1]; _Pragma("unroll") for(int r=2;r<16;++r)sacc+=pB0[r]; _Pragma("unroll") for(int r=0;r<16;++r)sacc+=pB1[r]; l_reg+=sacc;
    pw0=(u32x4){PKW(pB0,0),PKW(pB0,2),PKW(pB0,4),PKW(pB0,6)};pw1=(u32x4){PKW(pB0,8),PKW(pB0,10),PKW(pB0,12),PKW(pB0,14)};pw2=(u32x4){PKW(pB1,0),PKW(pB1,2),PKW(pB1,4),PKW(pB1,6)};pw3=(u32x4){PKW(pB1,8),PKW(pB1,10),PKW(pB1,12),PKW(pB1,14)};
    SBAR(); pv(o,vb0+sl_cur,PAF(0),PAF(1),PAF(2),PAF(3)); }
  #undef PKW
  #undef PAF
  #undef VFR
  #undef PIN
  #undef MX3
  #undef GAPA
  #undef GAPB
  #undef EX
  #undef VRD
  #undef KRD
  #undef STEP
  #undef ENDW
  {auto rr=__builtin_amdgcn_permlane32_swap(__float_as_uint(l_reg),__float_as_uint(l_reg),false,false);l_reg=__uint_as_float(rr[0])+__uint_as_float(rr[1]);}
  if(hi==0)wsf[32+r32]=l_reg;asm volatile("s_waitcnt lgkmcnt(0)":::"memory");
  float rli[16];
  #pragma unroll
  for(int r=0;r<16;++r)rli[r]=__builtin_amdgcn_rcpf(wsf[32+crow(r,hi)]);
  bf16*Ow=O+(rowbase+q0+wid*QBLK)*DMO;
  { bf16*stg=(bf16*)(shm+LDS_OST)+wid*2048;
    #pragma unroll
    for(int r=0;r<16;++r){const int orow=crow(r,hi);
      #pragma unroll
      for(int d0=0;d0<2;++d0)stg[orow*64+d0*32+r32]=__float2bfloat16(o[d0][r]*rli[r]);}
    asm volatile("s_waitcnt lgkmcnt(0)":::"memory");
    #pragma unroll
    for(int i=0;i<4;++i){const int row=i*8+(lane>>3),ch=lane&7; const u32x4 v=*(const u32x4*)(stg+row*64+ch*8); ATTN_STORE16(Ow+(long)row*DMO+ch*8,v);} }
  asm volatile("s_waitcnt lgkmcnt(0)\n\ts_barrier":::"memory");
  #undef BIASADD
  #undef DMA_K
  #undef DMA_V
  #undef CMASK
  #undef START
  #undef RESC
  #undef ROT
}
constexpr int ATTN_LDS_BYTES=LDS_BYTES;
#undef SBAR
#undef WAIT_BAR
}
#include <hip/hip_bf16.h>
#include <cmath>
namespace attn128 {
using bf16=__hip_bfloat16;
using bf16x8=__attribute__((ext_vector_type(8)))short;
using s16x4=__attribute__((ext_vector_type(4)))short;
using f32x16=__attribute__((ext_vector_type(16)))float;
using u32x4=__attribute__((ext_vector_type(4)))unsigned;
constexpr int BATCH=4,SEQ=8192,D=64,DMI=3072,DMO=1024;
constexpr int NW=8,QBLK=32,QB=QBLK*NW,KVBLK=64,NQB=SEQ/QB;
constexpr int ATTN_UNIT_ROWS=QB;
__device__ __forceinline__ int crow(int r,int hi){return (r&3)+8*(r>>2)+4*hi;}
#define SBAR() __builtin_amdgcn_sched_barrier(0)
__device__ __forceinline__ void cmask(f32x16&p0,f32x16&p1,int jb,int qrel,int hi){
  const float NEG=-INFINITY; int kb=64*jb+4*hi;
  #pragma unroll
  for(int r=0;r<16;++r){int kv=kb+(r&3)+8*(r>>2); if(kv>qrel)p0[r]=NEG; if(kv+32>qrel)p1[r]=NEG;}
}

constexpr int NSLOT=3, SLOTB=8192;
constexpr int VSLOTB=2*SLOTB; constexpr int LDS_K=0, LDS_V=NSLOT*SLOTB, LDS_WS=LDS_V+NSLOT*VSLOTB, LDS_OST=LDS_WS+NW*64*4, LDS_BIAS=LDS_OST+NW*4096, LDS_BYTES=LDS_BIAS;
constexpr float C2=0.125f*1.4426950408889634f;
__device__ __forceinline__ void glds16(const void*gsrc,unsigned lds_dst){unsigned keep;
  asm volatile("s_mov_b32 %0, m0\n\ts_mov_b32 m0, %2\n\ts_nop 0\n\tglobal_load_lds_dwordx4 %1, off\n\ts_mov_b32 m0, %0":"=&s"(keep):"v"(gsrc),"s"(lds_dst):"memory");}
__device__ __forceinline__ float max3f(float a,float b,float c){float r;asm("v_max3_f32 %0, %1, %2, %3":"=v"(r):"v"(a),"v"(b),"v"(c));return r;}
__device__ __forceinline__ float max2f(float a,float b){float r;asm("v_max_f32_e32 %0, %1, %2":"=v"(r):"v"(a),"v"(b));return r;}
__device__ __forceinline__ float fadd_s(float a,float b){float r;asm("v_add_f32_e32 %0, %1, %2":"=v"(r):"v"(a),"v"(b));return r;}
__device__ __forceinline__ float fsub_s(float a,float b){float r;asm("v_sub_f32_e32 %0, %1, %2":"=v"(r):"v"(a),"v"(b));return r;}
typedef float f32x2_t __attribute__((ext_vector_type(2))); typedef __bf16 bf16x2_t __attribute__((ext_vector_type(2)));
__device__ __forceinline__ unsigned cvtpk_s(float lo,float hi){f32x2_t v={lo,hi};bf16x2_t b=__builtin_convertvector(v,bf16x2_t);return __builtin_bit_cast(unsigned,b);}
#define WAIT_BAR(N) asm volatile("s_waitcnt vmcnt(" #N ") lgkmcnt(0)\n\ts_barrier":::"memory")

__device__ __forceinline__ void qkt(f32x16&p0,f32x16&p1,const char*Kslot,const bf16x8*qr,const f32x16&negm,int r32,int hi){
  const char*kb=Kslot+hi*1024+r32*16;
  #pragma unroll
  for(int d0=0;d0<4;++d0){
    const bf16x8 b0=*reinterpret_cast<const bf16x8*>(kb+d0*2048);
    const bf16x8 b1=*reinterpret_cast<const bf16x8*>(kb+d0*2048+512);
    if(d0==0){p0=__builtin_amdgcn_mfma_f32_32x32x16_bf16(b0,qr[0],negm,0,0,0);p1=__builtin_amdgcn_mfma_f32_32x32x16_bf16(b1,qr[0],negm,0,0,0);}
    else{p0=__builtin_amdgcn_mfma_f32_32x32x16_bf16(b0,qr[d0],p0,0,0,0);p1=__builtin_amdgcn_mfma_f32_32x32x16_bf16(b1,qr[d0],p1,0,0,0);}}
}
typedef __attribute__((address_space(3))) const char* lds_cptr;
typedef short v4i16_t __attribute__((ext_vector_type(4)));
__device__ __forceinline__ void kload8(bf16x8*kf,lds_cptr kp){
  kf[0]=*(const __attribute__((address_space(3))) bf16x8*)(kp);      kf[1]=*(const __attribute__((address_space(3))) bf16x8*)(kp+512);
  kf[2]=*(const __attribute__((address_space(3))) bf16x8*)(kp+2048); kf[3]=*(const __attribute__((address_space(3))) bf16x8*)(kp+2560);
  kf[4]=*(const __attribute__((address_space(3))) bf16x8*)(kp+4096); kf[5]=*(const __attribute__((address_space(3))) bf16x8*)(kp+4608);
  kf[6]=*(const __attribute__((address_space(3))) bf16x8*)(kp+6144); kf[7]=*(const __attribute__((address_space(3))) bf16x8*)(kp+6656);
}
__device__ __forceinline__ void kload2(bf16x8*kf,lds_cptr kp,int j){ kf[2*j]=*(const __attribute__((address_space(3))) bf16x8*)(kp+j*2048); kf[2*j+1]=*(const __attribute__((address_space(3))) bf16x8*)(kp+j*2048+512); }
__device__ __forceinline__ s16x4 vtr(lds_cptr p){ return __builtin_bit_cast(s16x4,__builtin_amdgcn_ds_read_tr16_b64_v4i16((__attribute__((address_space(3))) v4i16_t*)p)); }
__device__ __forceinline__ float rowmax(const f32x16&p0,const f32x16&p1){
  float a=max3f(p0[0],p0[1],p1[0]),b=max3f(p0[2],p0[3],p1[1]);a=max3f(a,p1[2],p1[3]);
  #pragma unroll
  for(int r=4;r<16;r+=4){a=max3f(a,p0[r],p0[r+1]);b=max3f(b,p0[r+2],p0[r+3]);a=max3f(a,p1[r],p1[r+1]);b=max3f(b,p1[r+2],p1[r+3]);}
  const float m=max2f(a,b);
  auto rr=__builtin_amdgcn_permlane32_swap(__float_as_uint(m),__float_as_uint(m),false,false);
  return max2f(__uint_as_float(rr[0]),__uint_as_float(rr[1]));
}
__device__ __forceinline__ void pv(f32x16*o,int vb,bf16x8 pa0,bf16x8 pa1,bf16x8 pa2,bf16x8 pa3){
  #pragma unroll
  for(int d0=0;d0<2;++d0){s16x4 lo[4],hi[4];
    #pragma unroll
    for(int ks=0;ks<4;++ks){
      asm volatile("ds_read_b64_tr_b16 %0,%1 offset:%c2":"=&v"(lo[ks]):"v"(vb),"i"(d0*4096+ks*1024):"memory");
      asm volatile("ds_read_b64_tr_b16 %0,%1 offset:%c2":"=&v"(hi[ks]):"v"(vb),"i"(d0*4096+ks*1024+512):"memory");}
    asm volatile("s_waitcnt lgkmcnt(0)":::"memory");SBAR();
    #define PK(k) (bf16x8){lo[k][0],lo[k][1],lo[k][2],lo[k][3],hi[k][0],hi[k][1],hi[k][2],hi[k][3]}
    o[d0]=__builtin_amdgcn_mfma_f32_32x32x16_bf16(pa0,PK(0),o[d0],0,0,0);
    o[d0]=__builtin_amdgcn_mfma_f32_32x32x16_bf16(pa1,PK(1),o[d0],0,0,0);
    o[d0]=__builtin_amdgcn_mfma_f32_32x32x16_bf16(pa2,PK(2),o[d0],0,0,0);
    o[d0]=__builtin_amdgcn_mfma_f32_32x32x16_bf16(pa3,PK(3),o[d0],0,0,0);
    #undef PK
  }
}

#ifndef ATTN_STORE16
#define ATTN_STORE16(p,v) (*(u32x4*)(p)=(v))
#endif
template<int THRL,bool BIAS> __device__ __forceinline__ void attn_unit(int b,int qb,const bf16*Q,const bf16*__restrict__ K,const bf16*__restrict__ V,bf16*O,const float*__restrict__ biasg,char*shm,const int tid_in,const bool comb,const bf16*O0,const float lam,const float osc,const float*__restrict__ gsub){
  int tid=tid_in; asm volatile("":"+v"(tid)); const int lane=tid&63,r32=lane&31,hi=lane>>5; const int wid=__builtin_amdgcn_readfirstlane(tid>>6);
  const long rowbase=(long)b*SEQ; const int q0=qb*QB;
  const bf16*Qw=Q+(rowbase+q0+wid*QBLK)*DMI;
  int t0=0;
  if(BIAS){ const int NT0=(q0+QB)/KVBLK; const float bq=biasg[q0]; int cnt=0;
    _Pragma("unroll") for(int h2=0;h2<2;++h2){ const int T=lane+64*h2; const bool sk=(T<NT0-4)&&(biasg[64*(T<NT0?T:0)+63]-bq<-200.f); cnt+=__popcll(__ballot(sk)); }
    t0=__builtin_amdgcn_readfirstlane(cnt)&~1; }
  const float*bg=BIAS?biasg+t0*KVBLK:biasg;
  const bf16*Kh=K+(rowbase+t0*KVBLK)*DMI,*Vh=V+(rowbase+t0*KVBLK)*DMI;
  const unsigned lds0=(unsigned)(uintptr_t)shm;
  float*wsf=(float*)(shm+LDS_WS)+wid*64;
  const bf16*ksrc=Kh+(long)lane*DMI+wid*8;
  const bf16*vsrc=Vh+(long)(16*(wid&3)+(lane>>2))*DMI+(wid>>2)*32+(lane&3)*8;
  const unsigned kdst=lds0+LDS_K+wid*1024, vdst=lds0+LDS_V+wid*1024;
  #define DMA_K(t,slot) glds16(ksrc+(long)(t)*KVBLK*DMI,(unsigned)__builtin_amdgcn_readfirstlane(kdst+(slot)))
  #define DMA_V(t,slot) do{ glds16(vsrc+(long)(t)*KVBLK*DMI,(unsigned)__builtin_amdgcn_readfirstlane(vdst+2*(slot))); glds16(vsrc+64+(long)(t)*KVBLK*DMI,(unsigned)__builtin_amdgcn_readfirstlane(vdst+2*(slot)+8192)); }while(0)
  const int vb0=(int)(lds0+LDS_V)+((lane>>4)&1)*32+(lane&3)*8+(4*hi+((lane&15)>>2))*64;
  const char*Kbase=shm+LDS_K; bf16x8 kf[8];
  const lds_cptr shm3=(lds_cptr)shm; const lds_cptr kp0=shm3+LDS_K+hi*1024+r32*16; const lds_cptr vp0=shm3+LDS_V+((lane>>4)&1)*32+(lane&3)*8+(4*hi+((lane&15)>>2))*64;
  const int NT=(q0+QB)/KVBLK-t0;
  typedef __attribute__((address_space(3))) const float* lds_fptr; typedef float f32x4_t __attribute__((ext_vector_type(4)));
  const lds_fptr biasl=(lds_fptr)(shm3+LDS_BIAS)+4*hi;
  if(BIAS){ __attribute__((address_space(3))) float* bw=(__attribute__((address_space(3))) float*)(shm3+LDS_BIAS); const int nb=NT*KVBLK;
    for(int i=tid*4;i<nb;i+=NW*64*4)*(__attribute__((address_space(3))) f32x4_t*)(bw+i)=*(const f32x4_t*)(bg+i); }
  #define BIASADD(P0,P1,t) do{ if(BIAS){ const lds_fptr bp_=biasl+KVBLK*(t); _Pragma("unroll") for(int i_=0;i_<4;++i_){ \
      const f32x4_t b0_=*(const __attribute__((address_space(3))) f32x4_t*)(bp_+8*i_), b1_=*(const __attribute__((address_space(3))) f32x4_t*)(bp_+32+8*i_); \
      _Pragma("unroll") for(int j_=0;j_<4;++j_){ P0[4*i_+j_]+=b0_[j_]; P1[4*i_+j_]+=b1_[j_]; } } } }while(0)
  DMA_K(0,0);DMA_V(0,0);DMA_K(1,SLOTB);
  bf16x8 qr[4];
  #pragma unroll
  for(int d0=0;d0<4;++d0)qr[d0]=*reinterpret_cast<const bf16x8*>(&Qw[(long)r32*DMI+d0*16+hi*8]);
  float mhat=0.f,l_reg=0.f;f32x16 o[4];o[0]=f32x16{};o[1]=f32x16{};o[2]=f32x16{};o[3]=f32x16{};f32x16 negm=f32x16{};asm volatile("":"+v"(negm));
  const int qrel=wid*QBLK+r32;
  #define CMASK(P0,P1,t) do{int jb_=(t)-(NT-4); if(jb_>=0)cmask(P0,P1,jb_,qrel,hi);}while(0)
  bool resc=false;
  #define START(P0,P1) do{ const float rm=rowmax(P0,P1); resc=false; \
    { const float dl=rm; mhat=fadd_s(mhat,dl); \
      _Pragma("unroll") for(int r=0;r<16;++r){P0[r]=fsub_s(P0[r],dl);P1[r]=fsub_s(P1[r],dl);} \
      _Pragma("unroll") for(int r=0;r<16;++r)negm[r]=-mhat; asm volatile("":"+v"(negm)); } \
    _Pragma("unroll") for(int r=0;r<16;++r)P0[r]=__builtin_amdgcn_exp2f(P0[r]); }while(0)
  #define RESC() do{ if(resc){ asm volatile("s_waitcnt lgkmcnt(0)":::"memory"); \
      _Pragma("unroll") for(int d_=0;d_<4;++d_) _Pragma("unroll") for(int r=0;r<16;++r)o[d_][r]*=wsf[crow(r,hi)]; } }while(0)
  f32x16 pA0,pA1,pB0,pB1;
  int sl_prev=0,sl_cur=0,sl_next=SLOTB;
  #define ROT() do{sl_prev=sl_cur;sl_cur=sl_next;sl_next=(sl_next==(NSLOT-1)*SLOTB)?0:sl_next+SLOTB;}while(0)
  DMA_K(2,2*SLOTB);
  WAIT_BAR(3);
  qkt(pA0,pA1,Kbase,qr,negm,r32,hi);asm volatile("s_nop 15\n\ts_nop 7":"+v"(pA0),"+v"(pA1));BIASADD(pA0,pA1,0);CMASK(pA0,pA1,0);
  START(pA0,pA1);
  _Pragma("unroll") for(int r=0;r<16;++r)pA1[r]=__builtin_amdgcn_exp2f(pA1[r]);
  WAIT_BAR(0);
  DMA_K(3,0);DMA_V(1,SLOTB);
  ROT();
  kload8(kf,kp0+sl_cur);
  WAIT_BAR(3);
  s16x4 vlo[3],vhi[3]; u32x4 pw0,pw1,pw2,pw3;
  #define PKW(P,B) cvtpk_s(P[B],P[B+1])
  #define PAF(k) __builtin_bit_cast(bf16x8,pw##k)
  #define PIN(x) asm volatile("":"+v"(x))
  #define MX3(a,b,c) __builtin_fmaxf(__builtin_fmaxf((a),(b)),(c))
  #define GAPA(MF,A0,A1,A2,A3,W0,W1,PW) do{ MF; sacc+=A0; sacc+=A1; sacc+=A2; sacc+=A3; PIN(sacc); W0; W1; PIN(PW); SBAR(); }while(0)
  #define EX(v) __builtin_amdgcn_exp2f(v)
  #define GAPB(MF,X,B) do{ MF; X[B]=EX(X[B]); X[B+1]=EX(X[B+1]); PIN(X); SBAR(); }while(0)
  #define VRDW(w,i) do{ vlo[w]=vtr(vp_+(((i)>>2)*4096+((i)&3)*1024)); vhi[w]=vtr(vp_+(((i)>>2)*4096+((i)&3)*1024+512)); }while(0)
  #define VFW(w) (bf16x8){vlo[w][0],vlo[w][1],vlo[w][2],vlo[w][3],vhi[w][0],vhi[w][1],vhi[w][2],vhi[w][3]}
  #define KRD(G,j) do{ if(G){ kload2(kf,kp0+sl_next,j); SBAR(); } }while(0)
  #define PVM(a,k,w) o[a]=__builtin_amdgcn_mfma_f32_32x32x16_bf16(PAF(k),VFW(w),o[a],0,0,0)
  #define STEP(C0,C1,P0,P1,t,GK,GV,GL) do{ SBAR(); \
    const lds_cptr vp_=vp0+2*sl_prev; \
    float sacc=(P0[0]+P0[1]); \
    GAPA(C0=__builtin_amdgcn_mfma_f32_32x32x16_bf16(kf[0],qr[0],negm,0,0,0), P0[2],P0[3],P0[4],P0[5],     pw0[0]=PKW(P0,0), pw0[1]=PKW(P0,2), pw0); \
    GAPA(C1=__builtin_amdgcn_mfma_f32_32x32x16_bf16(kf[1],qr[0],negm,0,0,0), P0[6],P0[7],P0[8],P0[9],     pw0[2]=PKW(P0,4), pw0[3]=PKW(P0,6), pw0); \
    GAPA(C0=__builtin_amdgcn_mfma_f32_32x32x16_bf16(kf[2],qr[1],C0,0,0,0),   P0[10],P0[11],P0[12],P0[13], pw1[0]=PKW(P0,8), pw1[1]=PKW(P0,10), pw1); \
    GAPA(C1=__builtin_amdgcn_mfma_f32_32x32x16_bf16(kf[3],qr[1],C1,0,0,0),   P0[14],P0[15],P1[0],P1[1],   pw1[2]=PKW(P0,12),pw1[3]=PKW(P0,14), pw1); \
    GAPA(C0=__builtin_amdgcn_mfma_f32_32x32x16_bf16(kf[4],qr[2],C0,0,0,0),   P1[2],P1[3],P1[4],P1[5],     pw2[0]=PKW(P1,0), pw2[1]=PKW(P1,2), pw2); \
    GAPA(C1=__builtin_amdgcn_mfma_f32_32x32x16_bf16(kf[5],qr[2],C1,0,0,0),   P1[6],P1[7],P1[8],P1[9],     pw2[2]=PKW(P1,4), pw2[3]=PKW(P1,6), pw2); \
    VRDW(0,0); SBAR(); \
    GAPA(C0=__builtin_amdgcn_mfma_f32_32x32x16_bf16(kf[6],qr[3],C0,0,0,0),   P1[10],P1[11],P1[12],P1[13], pw3[0]=PKW(P1,8), pw3[1]=PKW(P1,10), pw3); \
    VRDW(1,4); SBAR(); \
    GAPA(C1=__builtin_amdgcn_mfma_f32_32x32x16_bf16(kf[7],qr[3],C1,0,0,0),   P1[14],P1[15],0.f,0.f,       pw3[2]=PKW(P1,12),pw3[3]=PKW(P1,14), pw3); \
    l_reg+=sacc; \
    if(GK){DMA_K((t)+3,sl_cur);} if(GV){DMA_V((t)+1,sl_next);} \
    BIASADD(C0,C1,t); CMASK(C0,C1,t); \
    { float a=MX3(C0[0],C0[1],C1[0]),b=MX3(C0[2],C0[3],C1[1]); a=MX3(a,C1[2],C1[3]); \
      _Pragma("unroll") for(int r=4;r<16;r+=4){a=MX3(a,C0[r],C0[r+1]);b=MX3(b,C0[r+2],C0[r+3]);a=MX3(a,C1[r],C1[r+1]);b=MX3(b,C1[r+2],C1[r+3]);} \
      float rm=__builtin_fmaxf(a,b); { auto rr=__builtin_amdgcn_permlane32_swap(__float_as_uint(rm),__float_as_uint(rm),false,false); rm=__builtin_fmaxf(__uint_as_float(rr[0]),__uint_as_float(rr[1])); } \
      resc=false; \
      if(__builtin_expect(__any(rm>(float)THRL),0)){ const float dl=__builtin_fmaxf(rm,0.f); mhat+=dl; \
        _Pragma("unroll") for(int r=0;r<16;++r){C0[r]-=dl;C1[r]-=dl;} \
        _Pragma("unroll") for(int r=0;r<16;++r)negm[r]=-mhat; asm volatile("":"+v"(negm)); \
        const float f=__builtin_amdgcn_exp2f(-dl); l_reg*=f; if(hi==0)wsf[r32]=f; resc=true; } } \
    SBAR(); \
    GAPB(PVM(0,0,0), C0,0);  VRDW(2,8);  SBAR(); \
    GAPB(PVM(1,0,1), C0,2);  VRDW(0,12); SBAR(); \
    KRD(GL,0); GAPB(PVM(2,0,2), C0,4);  VRDW(1,1);  SBAR(); \
    GAPB(PVM(3,0,0), C0,6);  VRDW(2,5);  SBAR(); \
    KRD(GL,1); GAPB(PVM(0,1,1), C0,8);  VRDW(0,9);  SBAR(); \
    GAPB(PVM(1,1,2), C0,10); VRDW(1,13); SBAR(); \
    KRD(GL,2); GAPB(PVM(2,1,0), C0,12); VRDW(2,2);  SBAR(); \
    GAPB(PVM(3,1,1), C0,14); VRDW(0,6);  SBAR(); \
    KRD(GL,3); GAPB(PVM(0,2,2), C1,0);  VRDW(1,10); SBAR(); \
    GAPB(PVM(1,2,0), C1,2);  VRDW(2,14); SBAR(); \
    GAPB(PVM(2,2,1), C1,4);  VRDW(0,3);  SBAR(); \
    GAPB(PVM(3,2,2), C1,6);  VRDW(1,7);  SBAR(); \
    GAPB(PVM(0,3,0), C1,8);  VRDW(2,11); SBAR(); \
    GAPB(PVM(1,3,1), C1,10); VRDW(0,15); SBAR(); \
    GAPB(PVM(2,3,2), C1,12); \
    GAPB(PVM(3,3,0), C1,14); \
    }while(0)
  int t=1;
  #undef CMASK
  #define CMASK(P0,P1,t) do{}while(0)
  for(;t+5<NT;t+=2){
    STEP(pB0,pB1,pA0,pA1,t,true,true,true);     WAIT_BAR(3); RESC(); ROT();
    STEP(pA0,pA1,pB0,pB1,t+1,true,true,true);   WAIT_BAR(3); RESC(); ROT();
  }
  #undef CMASK
  #define CMASK(P0,P1,t) do{int jb_=(t)-(NT-4); if(jb_>=0)cmask(P0,P1,jb_,qrel,hi);}while(0)
  #define ENDW(tt) do{ if((tt)+3<NT){WAIT_BAR(3);} else if((tt)+2<NT){WAIT_BAR(2);} else {WAIT_BAR(0);} }while(0)
  for(;t+1<NT;t+=2){
    STEP(pB0,pB1,pA0,pA1,t,(t+3<NT),(t+1<NT),(t+1<NT));       ENDW(t);   RESC(); ROT();
    STEP(pA0,pA1,pB0,pB1,t+1,(t+4<NT),(t+2<NT),(t+2<NT));     ENDW(t+1); RESC(); ROT();
  }
  STEP(pB0,pB1,pA0,pA1,NT-1,false,false,false); RESC();
  { float sacc=pB0[0]+pB0[1]; _Pragma("unroll") for(int r=2;r<16;++r)sacc+=pB0[r]; _Pragma("unroll") for(int r=0;r<16;++r)sacc+=pB1[r]; l_reg+=sacc;
    pw0=(u32x4){PKW(pB0,0),PKW(pB0,2),PKW(pB0,4),PKW(pB0,6)};pw1=(u32x4){PKW(pB0,8),PKW(pB0,10),PKW(pB0,12),PKW(pB0,14)};pw2=(u32x4){PKW(pB1,0),PKW(pB1,2),PKW(pB1,4),PKW(pB1,6)};pw3=(u32x4){PKW(pB1,8),PKW(pB1,10),PKW(pB1,12),PKW(pB1,14)};
    SBAR(); pv(o,vb0+2*sl_cur,PAF(0),PAF(1),PAF(2),PAF(3)); pv(o+2,vb0+2*sl_cur+8192,PAF(0),PAF(1),PAF(2),PAF(3)); }
  #undef PKW
  #undef PAF
  #undef PIN
  #undef MX3
  #undef GAPA
  #undef GAPB
  #undef VRDW
  #undef VFW
  #undef PVM
  #undef EX
  #undef KRD
  #undef STEP
  #undef ENDW
  {auto rr=__builtin_amdgcn_permlane32_swap(__float_as_uint(l_reg),__float_as_uint(l_reg),false,false);l_reg=__uint_as_float(rr[0])+__uint_as_float(rr[1]);}
  if(hi==0)wsf[32+r32]=l_reg;asm volatile("s_waitcnt lgkmcnt(0)":::"memory");
  float rli[16];
  #pragma unroll
  for(int r=0;r<16;++r)rli[r]=__builtin_amdgcn_rcpf(wsf[32+crow(r,hi)]);
  bf16*Ow=O+(rowbase+q0+wid*QBLK)*DMO;
  { bf16*stg=(bf16*)(shm+LDS_OST)+wid*2048;
    if(!comb){
    #pragma unroll
    for(int ps=0;ps<2;++ps){
      #pragma unroll
      for(int r=0;r<16;++r){const int orow=crow(r,hi);
        #pragma unroll
        for(int d0=0;d0<2;++d0)stg[orow*64+d0*32+r32]=__float2bfloat16(o[2*ps+d0][r]*rli[r]);}
      asm volatile("s_waitcnt lgkmcnt(0)":::"memory");
      #pragma unroll
      for(int i=0;i<4;++i){const int row=i*8+(lane>>3),ch=lane&7; const u32x4 v=*(const u32x4*)(stg+row*64+ch*8); ATTN_STORE16(Ow+(long)row*DMO+ps*64+ch*8,v);}
      asm volatile("s_waitcnt lgkmcnt(0)":::"memory"); }
    } else {
      __builtin_amdgcn_fence(__ATOMIC_ACQUIRE,"agent");
      const bf16*O0w=O0+(rowbase+q0+wid*QBLK)*DMO; const int ch=lane&7,rw=lane>>3;
      float dv[2][4][8]; float ssq[4]={0.f,0.f,0.f,0.f};
      #pragma unroll
      for(int ps=0;ps<2;++ps){
        #pragma unroll
        for(int r=0;r<16;++r){const int orow=crow(r,hi);
          #pragma unroll
          for(int d0=0;d0<2;++d0)stg[orow*64+d0*32+r32]=__float2bfloat16(o[2*ps+d0][r]*rli[r]);}
        asm volatile("s_waitcnt lgkmcnt(0)":::"memory");
        #pragma unroll
        for(int i=0;i<4;++i){const int row=i*8+rw; const u32x4 v1=*(const u32x4*)(stg+row*64+ch*8); const u32x4 v0=*(const u32x4*)(O0w+(long)row*DMO+ps*64+ch*8);
          #pragma unroll
          for(int c=0;c<4;++c){ const float a0=__uint_as_float(v0[c]<<16),a1=__uint_as_float(v0[c]&0xffff0000u),b0=__uint_as_float(v1[c]<<16),b1=__uint_as_float(v1[c]&0xffff0000u);
            const float e0=a0-lam*b0,e1=a1-lam*b1; dv[ps][i][2*c]=e0; dv[ps][i][2*c+1]=e1; ssq[i]+=e0*e0+e1*e1; } }
        asm volatile("s_waitcnt lgkmcnt(0)":::"memory"); }
      #pragma unroll
      for(int i=0;i<4;++i){ float s=ssq[i];
        s+=__int_as_float(__builtin_amdgcn_ds_swizzle(__float_as_int(s),(1<<10)|0x1f)); s+=__int_as_float(__builtin_amdgcn_ds_swizzle(__float_as_int(s),(2<<10)|0x1f)); s+=__int_as_float(__builtin_amdgcn_ds_swizzle(__float_as_int(s),(4<<10)|0x1f));
        ssq[i]=osc/sqrtf(s*(1.0f/128.0f)+1e-6f); }
      #pragma unroll
      for(int ps=0;ps<2;++ps){ typedef float f32x4_u __attribute__((ext_vector_type(4)));
        const f32x4_u g0=*(const f32x4_u*)(gsub+ps*64+ch*8),g1=*(const f32x4_u*)(gsub+ps*64+ch*8+4);
        #pragma unroll
        for(int i=0;i<4;++i){const int row=i*8+rw; const float rs=ssq[i]; u32x4 w;
          w.x=cvtpk_s(dv[ps][i][0]*rs*g0.x,dv[ps][i][1]*rs*g0.y); w.y=cvtpk_s(dv[ps][i][2]*rs*g0.z,dv[ps][i][3]*rs*g0.w);
          w.z=cvtpk_s(dv[ps][i][4]*rs*g1.x,dv[ps][i][5]*rs*g1.y); w.w=cvtpk_s(dv[ps][i][6]*rs*g1.z,dv[ps][i][7]*rs*g1.w);
          ATTN_STORE16(Ow+(long)row*DMO+ps*64+ch*8,w);} }
    } }
  asm volatile("s_waitcnt lgkmcnt(0)\n\ts_barrier":::"memory");
  #undef BIASADD
  #undef DMA_K
  #undef DMA_V
  #undef CMASK
  #undef START
  #undef RESC
  #undef ROT
}
constexpr int ATTN_LDS_BYTES=LDS_BYTES;
#undef SBAR
#undef WAIT_BAR
}
#include <hip/hip_cooperative_groups.h>
namespace cg = cooperative_groups;
#define GAS __attribute__((address_space(1)))
#define LAS __attribute__((address_space(3)))
typedef unsigned short bf16;
typedef unsigned v4u __attribute__((ext_vector_type(4)));
typedef unsigned v2u __attribute__((ext_vector_type(2)));
typedef float f32x4 __attribute__((ext_vector_type(4)));
constexpr int NWAVES = 8;
constexpr int BATCH = 4, SEQ = 8192, D = 1024, DEPTH = 2, M = BATCH * SEQ;
constexpr int INW = 3080, NQKV = 3072, DFF = 2816, NGU = 2 * DFF, NFOX = 8;
constexpr float EPS = 1e-6f;
constexpr size_t MiB = 1u << 20;
constexpr size_t WS_RS1 = 5 * MiB, WS_RS2 = 5 * MiB + 262144;
constexpr size_t WS_ROT = 1 * MiB, WS_LOGF = 3 * MiB, WS_CUM = 4 * MiB, WS_WIN = 6 * MiB, WS_WO = 18 * MiB, WS_WGU = 22 * MiB, WS_WD = 44 * MiB, WS_XN = 56 * MiB,
                 WS_QKV = 120 * MiB, WS_ACT = 120 * MiB, WS_Y1 = 120 * MiB, WS_OD = 312 * MiB, WS_MIX = 376 * MiB, WS_Y2 = 312 * MiB, WS_END = 440 * MiB;
constexpr int LDS_BYTES = 147456;
static_assert(attn_body::ATTN_LDS_BYTES <= 131072 && attn128::ATTN_LDS_BYTES <= 131072, "attention scratch fits");
#define LDS_WAIT() asm volatile("s_waitcnt lgkmcnt(0)" ::: "memory")
__device__ __forceinline__ unsigned f2bf(float f) { unsigned u = __builtin_bit_cast(unsigned, f); return (u + 0x7fffu + ((u >> 16) & 1u)) >> 16; }
typedef float f32x2_fr __attribute__((ext_vector_type(2))); typedef __bf16 bf16x2_fr __attribute__((ext_vector_type(2)));
__device__ __forceinline__ unsigned pk2(float lo, float hi) { const f32x2_fr v = {lo, hi}; return __builtin_bit_cast(unsigned, __builtin_convertvector(v, bf16x2_fr)); }
#define SWZ_XOR(v, m) __uint_as_float((unsigned)__builtin_amdgcn_ds_swizzle((int)__float_as_uint(v), ((m) << 10) | 0x1f))
__device__ __forceinline__ float wave_sum(float v) {
    v += SWZ_XOR(v, 1); v += SWZ_XOR(v, 2); v += SWZ_XOR(v, 4); v += SWZ_XOR(v, 8); v += SWZ_XOR(v, 16);
    const auto rr = __builtin_amdgcn_permlane32_swap(__float_as_uint(v), __float_as_uint(v), false, false);
    return __uint_as_float(rr[0]) + __uint_as_float(rr[1]);
}
__device__ __forceinline__ void transpose_item(const float* W, int ldw, int Kdim, bf16* WT, int dst_row0, int k0, int n0, LAS float* scr, int lane, const float* gk) {
#pragma unroll 8
    for (int i = 0; i < 32; ++i) { const int kk = 2 * i + (lane >> 5); scr[kk * 33 + (lane & 31)] = W[(size_t)(k0 + kk) * ldw + n0 + (lane & 31)]; }
    LDS_WAIT(); asm volatile("" ::: "memory");
    const int c = lane & 7;
    f32x4 ga = {1.f, 1.f, 1.f, 1.f}, gb = ga; if (gk) { ga = *(const f32x4*)(gk + k0 + 8 * c); gb = *(const f32x4*)(gk + k0 + 8 * c + 4); }
#pragma unroll
    for (int j = 0; j < 4; ++j) { const int n = (lane >> 3) + 8 * j; const LAS float* s = scr + (8 * c) * 33 + n;
        v4u o; o.x = pk2(s[0 * 33] * ga.x, s[1 * 33] * ga.y); o.y = pk2(s[2 * 33] * ga.z, s[3 * 33] * ga.w); o.z = pk2(s[4 * 33] * gb.x, s[5 * 33] * gb.y); o.w = pk2(s[6 * 33] * gb.z, s[7 * 33] * gb.w);
        *(GAS v4u*)(WT + (size_t)(dst_row0 + n) * Kdim + k0 + 8 * c) = o; }
    LDS_WAIT(); asm volatile("" ::: "memory");
}
__device__ __forceinline__ void load_row(const float* p, int lane, f32x4 (&v)[4]) {
    const f32x4* r = (const f32x4*)p + lane;
#pragma unroll
    for (int j = 0; j < 4; ++j) v[j] = r[64 * j];
}
__device__ __forceinline__ void load_row_bf16(const bf16* p, int lane, f32x4 (&v)[4]) {
    const v2u* r = (const v2u*)p + lane;
#pragma unroll
    for (int j = 0; j < 4; ++j) { const v2u w = r[64 * j]; v[j].x = __uint_as_float(w.x << 16); v[j].y = __uint_as_float(w.x & 0xffff0000u); v[j].z = __uint_as_float(w.y << 16); v[j].w = __uint_as_float(w.y & 0xffff0000u); }
}
__device__ __forceinline__ void store_row(float* p, int lane, const f32x4 (&v)[4]) {
    f32x4* r = (f32x4*)p + lane;
#pragma unroll
    for (int j = 0; j < 4; ++j) r[64 * j] = v[j];
}
__device__ __forceinline__ float row_rstd(const f32x4 (&v)[4]) {
    float s = 0.f;
#pragma unroll
    for (int j = 0; j < 4; ++j) s += (v[j].x * v[j].x + v[j].y * v[j].y) + (v[j].z * v[j].z + v[j].w * v[j].w);
    return 1.0f / sqrtf(wave_sum(s) * (1.0f / D) + EPS);
}
__device__ __forceinline__ void store_row_bf16(bf16* p, int lane, const f32x4 (&v)[4]) {
    v2u* o = (v2u*)p + lane;
#pragma unroll
    for (int j = 0; j < 4; ++j) { v2u w; w.x = pk2(v[j].x, v[j].y); w.y = pk2(v[j].z, v[j].w); o[64 * j] = w; }
}
constexpr int WFL_OFF = 0;
__device__ __forceinline__ void fill_forget_w(const float* win_l, LAS unsigned char* ldsl, int tid) {
    LAS float* wfl = (LAS float*)(ldsl + WFL_OFF);
    for (int idx = tid; idx < 8 * D; idx += NWAVES * 64) { const int k = idx >> 3, f = idx & 7; wfl[f * D + k] = win_l[(size_t)k * INW + NQKV + f]; }
    __syncthreads();
}
__device__ __forceinline__ void pre_norm_row(const f32x4 (&xv)[4], const f32x4 (&g)[4], bf16* xb_row, const LAS float* wfl, const float* fbias, float* logf, float* rs, int row, int lane) {
    const float rstd = row_rstd(xv); f32x4 h[4];
#pragma unroll
    for (int j = 0; j < 4; ++j) h[j] = xv[j] * rstd * g[j];
    if (xb_row) store_row_bf16(xb_row, lane, xv);
    if (lane == 0) rs[row] = rstd;
    float mine = 0.f;
#pragma unroll
    for (int f = 0; f < 8; ++f) { f32x4 a = {0.f, 0.f, 0.f, 0.f};
#pragma unroll
        for (int j = 0; j < 4; ++j) a += *(const LAS f32x4*)(wfl + f * D + 256 * j + 4 * lane) * h[j];
        const float t = wave_sum((a.x + a.y) + (a.z + a.w)); mine = (lane == f) ? t : mine; }
    if (lane < NFOX) { const float y = mine + fbias[lane]; const float e = __expf(-fabsf(y)), u = 1.0f + e, um = u - 1.0f; const float l1p = (um == 0.f) ? e : __logf(u) * (e / um); const float lf = fminf(y, 0.f) - l1p;
        const int b = row / SEQ, s = row % SEQ; logf[(size_t)(b * NFOX + lane) * SEQ + s] = lf; }
}

#define XB_TMO      128
#define XB_XCNT(j)  (256  + 64 * (j))
#define XB_XSUB(j)  (1280 + 64 * (j))
#define XB_XGEN(j)  (2304 + 64 * (j))
#define XB_TOP      3328
#define XB_TOPGEN   3392
#define XCD_BAR_WORDS 3456
#define XB_SPIN_CAP (1u << 22)

__device__ __forceinline__ unsigned xb_ld(unsigned* p)              { return __hip_atomic_load(p, __ATOMIC_RELAXED, __HIP_MEMORY_SCOPE_AGENT); }
__device__ __forceinline__ unsigned xb_add(unsigned* p, unsigned v) { return __hip_atomic_fetch_add(p, v, __ATOMIC_RELAXED, __HIP_MEMORY_SCOPE_AGENT); }
__device__ __forceinline__ unsigned xb_xcc_id() { return (unsigned)__builtin_amdgcn_s_getreg((3 << 11) | 20) & 0xFu; }
#define XB_SPIN(cond, bar) do { unsigned _sp = 0; while (cond) { __builtin_amdgcn_s_sleep(1); \
    if ((++_sp & 255u) == 0u) { if (xb_ld(&(bar)[XB_TMO])) break; if (_sp > XB_SPIN_CAP) { atomicAdd(&(bar)[XB_TMO], 1u); break; } } } } while (0)

struct XcdBarrier {
    unsigned* bar; unsigned x;
    volatile LAS unsigned* st;
};

__device__ __forceinline__ XcdBarrier xcd_barrier_post(unsigned* bar, volatile LAS unsigned* st, const int tid_in) {
    XcdBarrier b; b.bar = bar; b.x = xb_xcc_id(); b.st = st;
    if (tid_in == 0) (void)xb_add(&bar[XB_XCNT(b.x)], 1u);
    return b;
}
__device__ __forceinline__ void xcd_barrier_complete(unsigned* bar, unsigned x, unsigned& nloc, unsigned& nx) {
    const unsigned G = gridDim.x * gridDim.y * gridDim.z;
    unsigned sum, cnt, mine, sp = 0u;
    for (;;) {
        sum = 0u; cnt = 0u; mine = 0u;
#pragma unroll
        for (unsigned j = 0; j < 16; ++j) { const unsigned c = xb_ld(&bar[XB_XCNT(j)]); sum += c; cnt += (c > 0u) ? 1u : 0u; mine = (j == x) ? c : mine; }
        if (sum == G) break;
        __builtin_amdgcn_s_sleep(1);
        if ((++sp & 255u) == 0u) { if (xb_ld(&bar[XB_TMO])) break; if (sp > XB_SPIN_CAP) { atomicAdd(&bar[XB_TMO], 1u); break; } }
    }
    nloc = mine > 0u ? mine : 1u; nx = cnt > 0u ? cnt : 1u;
}

__device__ __forceinline__ void xcd_barrier(const XcdBarrier& b, const int tid_in) {
    asm volatile("s_waitcnt vmcnt(0)" ::: "memory");
    __syncthreads();
    if (tid_in == 0) {
        unsigned* bar = b.bar;
        __builtin_amdgcn_s_waitcnt(0);
        unsigned nloc = b.st[0], nx = b.st[1];
        if (nloc == 0u) { xcd_barrier_complete(bar, b.x, nloc, nx); b.st[0] = nloc; b.st[1] = nx; }
        const unsigned old = xb_add(&bar[XB_XSUB(b.x)], 1u);
        const unsigned gen = old / nloc;
        if (old + 1u == (gen + 1u) * nloc) {
            __builtin_amdgcn_fence(__ATOMIC_RELEASE, "agent");
            asm volatile("s_waitcnt vmcnt(0)" ::: "memory");
            const unsigned og = xb_add(&bar[XB_TOP], 1u);
            const unsigned tg = og / nx;
            if (og + 1u == (tg + 1u) * nx) xb_add(&bar[XB_TOPGEN], 1u);
            else XB_SPIN(xb_ld(&bar[XB_TOPGEN]) == tg, bar);
            __builtin_amdgcn_fence(__ATOMIC_ACQUIRE, "agent");
            xb_add(&bar[XB_XGEN(b.x)], 1u);
            asm volatile("s_waitcnt vmcnt(0)" ::: "memory");
        } else {
            XB_SPIN(xb_ld(&bar[XB_XGEN(b.x)]) == gen, bar);
            __builtin_amdgcn_fence(__ATOMIC_ACQUIRE, "agent");
            asm volatile("s_waitcnt vmcnt(0)" ::: "memory");
        }
    }
    __syncthreads();
}

constexpr size_t WS_CTL = 0, CTL_ZERO_BYTES = 65536; constexpr int CW_BAR = 4096;
constexpr int MISC_OFF = 131072 + 320;
struct Args { const void* in[17]; float* out; unsigned char* ws; };
typedef const __attribute__((address_space(4))) Args* KArgs;
#define KA() ([]() __attribute__((always_inline)) { KArgs p_ = (KArgs)__builtin_amdgcn_kernarg_segment_ptr(); asm volatile("" : "+s"(p_)); return p_; }())
#define IN_F(A, k) ((const float*)(A)->in[k])

__global__ void __launch_bounds__(NWAVES * 64, 2) hymba_fwd(Args args_unused) {
    extern __shared__ __attribute__((aligned(16))) unsigned char lds[];
    cg::grid_group grid = cg::this_grid();
#define TID_NOW() ({ unsigned ones_ = ~0u; asm volatile("" : "+s"(ones_)); (wave0 << 6) | (int)__builtin_amdgcn_mbcnt_hi(ones_, __builtin_amdgcn_mbcnt_lo(ones_, 0u)); })
    const int wave0 = __builtin_amdgcn_readfirstlane((int)threadIdx.x >> 6);
#define PH_IDS() int tid = TID_NOW(); asm volatile("" : "+v"(tid)); const int lane = tid & 63, wave = __builtin_amdgcn_readfirstlane(tid >> 6); int bx = blockIdx.x; asm volatile("" : "+s"(bx)); \
    const int G = gridDim.x, vcu = (G % 8 == 0) ? (bx % 8) * (G / 8) + bx / 8 : bx, gw = vcu * NWAVES + wave, NGW = G * NWAVES; (void)lane; (void)gw; (void)NGW; (void)vcu
#define BARRIER() do { KArgs Ab_ = KA(); XcdBarrier b_; b_.bar = (unsigned*)(Ab_->ws + WS_CTL) + CW_BAR; b_.x = xb_xcc_id(); b_.st = (volatile LAS unsigned*)(ldsl + MISC_OFF) + 8; int t_ = TID_NOW(); asm volatile("" : "+v"(t_)); xcd_barrier(b_, t_); } while (0)
    LAS unsigned char* ldsl = (LAS unsigned char*)lds;
    { const int t_ = TID_NOW(); for (int u = t_; u < (LDS_BYTES - 131072) / 4; u += NWAVES * 64) ((LAS unsigned*)(ldsl + 131072))[u] = 0u;
      __syncthreads();
      (void)xcd_barrier_post((unsigned*)(KA()->ws + WS_CTL) + CW_BAR, (volatile LAS unsigned*)(ldsl + MISC_OFF) + 8, t_); }

    {
        KArgs A = KA(); PH_IDS(); unsigned char* ws = A->ws;
        const float* attn_pre_g = IN_F(A, 2); const float* ffn_pre_g = IN_F(A, 12); const float* w_in = IN_F(A, 3); const float* w_out = IN_F(A, 10); const float* w_gate = IN_F(A, 13); const float* w_up = IN_F(A, 14); const float* w_down = IN_F(A, 15);
        bf16* WIN_T = (bf16*)(ws + WS_WIN); bf16* WO_T = (bf16*)(ws + WS_WO); bf16* WGU_T = (bf16*)(ws + WS_WGU); bf16* WD_T = (bf16*)(ws + WS_WD);
        LAS float* scr = (LAS float*)(ldsl + wave * 16384);
        constexpr int I_IN = 16 * (NQKV / 32), I_O = 16 * (D / 32), I_G = 16 * (DFF / 32), I_D = (DFF / 64) * (D / 32), I_L = I_IN + I_O + 2 * I_G + I_D;
        for (int it = gw; it < DEPTH * I_L; it += NGW) {
            const int l = it / I_L; int r = it % I_L;
            if (r < I_IN) { const int nb = NQKV / 32; transpose_item(w_in + (size_t)l * D * INW, INW, D, WIN_T + (size_t)l * NQKV * D, 32 * (r % nb), 64 * (r / nb), 32 * (r % nb), scr, lane, attn_pre_g + l * D); continue; } r -= I_IN;
            if (r < I_O) { const int nb = D / 32; transpose_item(w_out + (size_t)l * D * D, D, D, WO_T + (size_t)l * D * D, 32 * (r % nb), 64 * (r / nb), 32 * (r % nb), scr, lane, nullptr); continue; } r -= I_O;
            if (r < 2 * I_G) { const int up = r >= I_G; if (up) r -= I_G; const int nb = DFF / 32, n0 = 32 * (r % nb);
                transpose_item((up ? w_up : w_gate) + (size_t)l * D * DFF, DFF, D, WGU_T + (size_t)l * NGU * D, (n0 / 128) * 256 + up * 128 + (n0 % 128), 64 * (r / nb), n0, scr, lane, ffn_pre_g + l * D); continue; } r -= 2 * I_G;
            { const int nb = D / 32; transpose_item(w_down + (size_t)l * DFF * D, D, DFF, WD_T + (size_t)l * D * DFF, 32 * (r % nb), 64 * (r / nb), 32 * (r % nb), scr, lane, nullptr); }
        }
    }
    {
        KArgs A = KA(); PH_IDS(); const int* positions = (const int*)A->in[1]; float* ROT = (float*)(A->ws + WS_ROT);
        for (int e = bx * (NWAVES * 64) + tid; e < M * 8; e += G * NWAVES * 64) {
            const int row = e >> 3, i = e & 7;
            float fr = 1.000000000e+00f;
            fr = (i == 1) ? 1.939227581e-01f : fr; fr = (i == 2) ? 3.760603070e-02f : fr; fr = (i == 3) ? 7.292665076e-03f : fr; fr = (i == 4) ? 1.414213446e-03f : fr;
            fr = (i == 5) ? 2.742481884e-04f : fr; fr = (i == 6) ? 5.318296462e-05f : fr; fr = (i == 7) ? 1.031338525e-05f : fr;
            const float ang = (float)positions[row] * fr;
            const double xd = (double)ang, kq = rint(xd * 0.63661977236758134308), rr = fma(-kq, 6.123233995736766e-17, fma(-kq, 1.5707963267948966, xd)), r2 = rr * rr;
            const double sn = rr * (1.0 + r2 * (-1.0 / 6 + r2 * (1.0 / 120 + r2 * (-1.0 / 5040 + r2 * (1.0 / 362880 + r2 * (-1.0 / 39916800))))));
            const double cs = 1.0 + r2 * (-0.5 + r2 * (1.0 / 24 + r2 * (-1.0 / 720 + r2 * (1.0 / 40320 + r2 * (-1.0 / 3628800 + r2 * (1.0 / 479001600))))));
            const int q4 = (int)kq & 3;
            const double c = (q4 == 0) ? cs : (q4 == 1) ? -sn : (q4 == 2) ? -cs : sn, s = (q4 == 0) ? sn : (q4 == 1) ? cs : (q4 == 2) ? -sn : -cs;
            ROT[(size_t)row * 16 + i] = (float)c; ROT[(size_t)row * 16 + 8 + i] = (float)s;
        }
    }
    {
        KArgs A = KA(); PH_IDS(); const float* x_in = IN_F(A, 0); bf16* XN = (bf16*)(A->ws + WS_XN); float* LOGF = (float*)(A->ws + WS_LOGF); const float* fbias = IN_F(A, 4);
        __syncthreads();
        fill_forget_w(IN_F(A, 3), ldsl, tid);
        f32x4 g[4]; load_row(IN_F(A, 2), lane, g);
        {
            f32x4 xv[4]; load_row(x_in + (size_t)gw * D, lane, xv);
            for (int m = gw; m < M; m += NGW) { f32x4 xn[4]; const int mn = (m + NGW < M) ? m + NGW : m; load_row(x_in + (size_t)mn * D, lane, xn);
                pre_norm_row(xv, g, XN + (size_t)m * D, (const LAS float*)(ldsl + WFL_OFF), fbias, LOGF, (float*)(A->ws + WS_RS1), m, lane);
#pragma unroll
                for (int j = 0; j < 4; ++j) xv[j] = xn[j]; } }
    }
    grid.sync();

#pragma unroll 1
    for (int l = 0; l < DEPTH; ++l) {
        {
            KArgs A = KA(); PH_IDS(); const float* LOGF = (const float*)(A->ws + WS_LOGF); float* CUM = (float*)(A->ws + WS_CUM);
            for (int ch = bx; ch < BATCH * NFOX; ch += G) {
                LAS float* wt = (LAS float*)ldsl;
                const f32x4* src = (const f32x4*)(LOGF + (size_t)ch * SEQ + tid * 16); f32x4 v[4]; float run = 0.f;
#pragma unroll
                for (int j = 0; j < 4; ++j) { v[j] = src[j]; v[j].x += run; v[j].y += v[j].x; v[j].z += v[j].y; v[j].w += v[j].z; run = v[j].w; }
                float inc = run;
#pragma unroll
                for (int o = 1; o < 64; o <<= 1) { const float t = __uint_as_float((unsigned)__builtin_amdgcn_ds_bpermute(((lane - o) & 63) << 2, (int)__float_as_uint(inc))); if (lane >= o) inc += t; }
                if (lane == 63) wt[wave] = inc;
                __syncthreads();
                float off = inc - run;
                for (int w = 0; w < wave; ++w) off += wt[w];
                f32x4* dst = (f32x4*)(CUM + (size_t)ch * SEQ + tid * 16);
#pragma unroll
                for (int j = 0; j < 4; ++j) dst[j] = (v[j] + off) * -1.4426950408889634f;
                __syncthreads();
            }
        }
        {
            KArgs A = KA(); PH_IDS(); unsigned char* ws = A->ws;
            pg8::Gemm g{(const bf16*)(ws + WS_XN), (const bf16*)(ws + WS_WIN) + (size_t)l * NQKV * D, M, NQKV, D}; pg8::StaticOrder S; S.init(M, NQKV, G, bx);
            pg8::EpiQKV E{(bf16*)(ws + WS_QKV), (const float*)(ws + WS_ROT), (const float*)(ws + WS_RS1)};
            pg8::gemm_phase<pg8::EpiQKV, pg8::StaticOrder, PG8_ALIGN, PG8_SP2>(ldsl, g, S, E, tid);
        }
        BARRIER();
        {
            KArgs A = KA(); PH_IDS(); unsigned char* ws = A->ws;
            const float lam_init = 0.8f - 0.6f * __expf(-0.3f * (float)l);
            const float e1 = __expf(wave_sum(IN_F(A, 5)[l * 64 + lane] * IN_F(A, 6)[l * 64 + lane])), e2 = __expf(wave_sum(IN_F(A, 7)[l * 64 + lane] * IN_F(A, 8)[l * 64 + lane]));
            const float lam = __uint_as_float((unsigned)__builtin_amdgcn_readfirstlane((int)__float_as_uint(e1 - e2 + lam_init))), osc = __uint_as_float((unsigned)__builtin_amdgcn_readfirstlane((int)__float_as_uint(1.0f - lam_init)));
            const float* gsub = IN_F(A, 9) + l * 128;
            unsigned* qcnt = (unsigned*)(ws + WS_CTL) + 64 * (1 + 8 * l);
            volatile LAS unsigned* qs = (volatile LAS unsigned*)(ldsl + MISC_OFF) + 16;
            const attn_body::bf16* Qb = (const attn_body::bf16*)(ws + WS_QKV);
            int k = 0;
            while (k < 8) {
                const int x = (bx + k) & 7;
                if (tid == 0) *qs = __hip_atomic_fetch_add(qcnt + 64 * x, 1u, __ATOMIC_RELAXED, __HIP_MEMORY_SCOPE_AGENT);
                __syncthreads();
                const unsigned e = (unsigned)__builtin_amdgcn_readfirstlane(*qs);
                __syncthreads();
                if (e >= 192u) { ++k; continue; }
                const int qb = (e < 64u) ? 31 - (int)(e >> 1) : 31 - (int)((e - 64u) >> 2), j = (e < 64u) ? (int)(e & 1u) : 2 + (int)((e - 64u) & 3u);
                if (j < 2) { const int idx = 2 * x + j, b = idx >> 2, h = idx & 3;
#pragma unroll 1
                    for (int mp = 0; mp < 2; ++mp) { const int hm = 2 * h + mp;
                        attn128::attn_unit<8, false>(b, qb, (const attn128::bf16*)Qb + hm * 64, (const attn128::bf16*)Qb + 512 + hm * 64, (const attn128::bf16*)Qb + 1024 + h * 128,
                            (mp ? (attn128::bf16*)(ws + WS_MIX) : (attn128::bf16*)(ws + WS_OD)) + h * 128, nullptr, (char*)lds, tid, mp != 0, (const attn128::bf16*)(ws + WS_OD) + h * 128, lam, osc, gsub); }
                } else { const int b = j - 2, f = (x - 2 * b) & 7;
                    attn_body::attn_unit<8, true>(b, qb, Qb + 1536 + f * 64, Qb + 2048 + f * 64, Qb + 2560 + f * 64, (attn_body::bf16*)(ws + WS_MIX) + 512 + f * 64, (const float*)(ws + WS_CUM) + (size_t)(b * NFOX + f) * SEQ, (char*)lds, tid); }
            }
        }
        BARRIER();
        {
            KArgs A = KA(); PH_IDS(); unsigned char* ws = A->ws;
            pg8::Gemm g{(const bf16*)(ws + WS_MIX), (const bf16*)(ws + WS_WO) + (size_t)l * D * D, M, D, D}; pg8::StaticOrder S; S.init(M, D, G, bx);
            pg8::EpiY E{(bf16*)(ws + WS_Y1), D};
            pg8::gemm_phase<pg8::EpiY, pg8::StaticOrder, PG8_ALIGN, PG8_SP2>(ldsl, g, S, E, tid);
        }
        BARRIER();
        {
            KArgs A = KA(); PH_IDS(); const bf16* Y1 = (const bf16*)(A->ws + WS_Y1); bf16* XB = (bf16*)(A->ws + WS_XN); float* RS2 = (float*)(A->ws + WS_RS2); const float* x_in = IN_F(A, 0);
            f32x4 gp[4]; load_row(IN_F(A, 11) + l * D, lane, gp);
            f32x4 y[4], xv[4];
            load_row_bf16(Y1 + (size_t)gw * D, lane, y); if (l == 0) load_row(x_in + (size_t)gw * D, lane, xv); else load_row_bf16(XB + (size_t)gw * D, lane, xv);
            for (int m = gw; m < M; m += NGW) { f32x4 yn[4], xn[4];
                const int mn = (m + NGW < M) ? m + NGW : m;
                load_row_bf16(Y1 + (size_t)mn * D, lane, yn); if (l == 0) load_row(x_in + (size_t)mn * D, lane, xn); else load_row_bf16(XB + (size_t)mn * D, lane, xn);
                const float ry = row_rstd(y);
#pragma unroll
                for (int j = 0; j < 4; ++j) xv[j] += y[j] * ry * gp[j];
                store_row_bf16(XB + (size_t)m * D, lane, xv);
                const float rx = row_rstd(xv);
                if (lane == 0) RS2[m] = rx;
#pragma unroll
                for (int j = 0; j < 4; ++j) { y[j] = yn[j]; xv[j] = xn[j]; }
            }
        }
        BARRIER();
        {
            KArgs A = KA(); PH_IDS(); unsigned char* ws = A->ws;
            pg8::Gemm g{(const bf16*)(ws + WS_XN), (const bf16*)(ws + WS_WGU) + (size_t)l * NGU * D, M, NGU, D}; pg8::StaticOrder S; S.init(M, NGU, G, bx);
            pg8::EpiSwiGLU E{(bf16*)(ws + WS_ACT), DFF, (const float*)(ws + WS_RS2)};
            pg8::gemm_phase<pg8::EpiSwiGLU, pg8::StaticOrder, PG8_ALIGN, PG8_SP2>(ldsl, g, S, E, tid);
        }
        BARRIER();
        {
            KArgs A = KA(); PH_IDS(); unsigned char* ws = A->ws;
            pg8::Gemm g{(const bf16*)(ws + WS_ACT), (const bf16*)(ws + WS_WD) + (size_t)l * D * DFF, M, D, DFF}; pg8::StaticOrder S; S.init(M, D, G, bx);
            pg8::EpiY E{(bf16*)(ws + WS_Y2), D};
            pg8::gemm_phase<pg8::EpiY, pg8::StaticOrder, PG8_ALIGN, PG8_SP2>(ldsl, g, S, E, tid);
        }
        BARRIER();
        {
            KArgs A = KA(); PH_IDS(); const bf16* Y2 = (const bf16*)(A->ws + WS_Y2); bf16* XB = (bf16*)(A->ws + WS_XN);
            f32x4 gp[4]; load_row(IN_F(A, 16) + l * D, lane, gp);
            if (l + 1 < DEPTH) {
                float* LOGF = (float*)(A->ws + WS_LOGF); float* RS1 = (float*)(A->ws + WS_RS1); const float* fbias = IN_F(A, 4) + (l + 1) * NFOX;
                fill_forget_w(IN_F(A, 3) + (size_t)(l + 1) * D * INW, ldsl, tid);
                f32x4 g[4]; load_row(IN_F(A, 2) + (l + 1) * D, lane, g);
                f32x4 y[4], xv[4];
                load_row_bf16(Y2 + (size_t)gw * D, lane, y); load_row_bf16(XB + (size_t)gw * D, lane, xv);
                for (int m = gw; m < M; m += NGW) { f32x4 yn[4], xn[4];
                    const int mn = (m + NGW < M) ? m + NGW : m;
                    load_row_bf16(Y2 + (size_t)mn * D, lane, yn); load_row_bf16(XB + (size_t)mn * D, lane, xn);
                    const float ry = row_rstd(y);
#pragma unroll
                    for (int j = 0; j < 4; ++j) xv[j] += y[j] * ry * gp[j];
                    pre_norm_row(xv, g, XB + (size_t)m * D, (const LAS float*)(ldsl + WFL_OFF), fbias, LOGF, RS1, m, lane);
#pragma unroll
                    for (int j = 0; j < 4; ++j) { y[j] = yn[j]; xv[j] = xn[j]; }
                }
                BARRIER();
            } else {
                float* xout = A->out;
                f32x4 y[4], xv[4];
                load_row_bf16(Y2 + (size_t)gw * D, lane, y); load_row_bf16(XB + (size_t)gw * D, lane, xv);
                for (int m = gw; m < M; m += NGW) { f32x4 yn[4], xn[4];
                    const int mn = (m + NGW < M) ? m + NGW : m;
                    load_row_bf16(Y2 + (size_t)mn * D, lane, yn); load_row_bf16(XB + (size_t)mn * D, lane, xn);
                    const float ry = row_rstd(y);
#pragma unroll
                    for (int j = 0; j < 4; ++j) xv[j] += y[j] * ry * gp[j];
                    store_row(xout + (size_t)m * D, lane, xv);
#pragma unroll
                    for (int j = 0; j < 4; ++j) { y[j] = yn[j]; xv[j] = xn[j]; }
                }
            }
        }
    }
}

extern "C" void kernel_launch(void* const* d_in, const int* in_sizes, int n_in, void* d_out, int out_size, void* d_ws, size_t ws_size, hipStream_t stream) {
    static int grid = 0;
    if (grid == 0) {
        if (n_in != 17 || in_sizes[0] != M * D || out_size != M * D || ws_size < WS_END) { fprintf(stderr, "kernel_launch: shape/workspace mismatch (n_in %d in0 %d out %d ws %zu)\n", n_in, n_in > 0 ? in_sizes[0] : -1, out_size, ws_size); grid = -1; return; }
        int dev = 0, cus = 0, per_cu = 0;
        if (hipGetDevice(&dev) != hipSuccess || hipDeviceGetAttribute(&cus, hipDeviceAttributeMultiprocessorCount, dev) != hipSuccess) { grid = -1; return; }
        if (hipFuncSetAttribute((const void*)hymba_fwd, hipFuncAttributeMaxDynamicSharedMemorySize, LDS_BYTES) != hipSuccess) { fprintf(stderr, "kernel_launch: hipFuncSetAttribute failed\n"); grid = -1; return; }
        if (hipOccupancyMaxActiveBlocksPerMultiprocessor(&per_cu, (const void*)hymba_fwd, NWAVES * 64, LDS_BYTES) != hipSuccess || per_cu < 1) { fprintf(stderr, "kernel_launch: occupancy query says %d\n", per_cu); per_cu = 1; }
        (void)hipGetLastError();
        grid = cus;
    }
    if (grid < 0) return;
    if (hipMemsetAsync((char*)d_ws + WS_CTL, 0, CTL_ZERO_BYTES, stream) != hipSuccess) { fprintf(stderr, "kernel_launch: hipMemsetAsync failed\n"); return; }
    Args a{};
    for (int i = 0; i < 17; ++i) a.in[i] = d_in[i];
    a.out = (float*)d_out; a.ws = (unsigned char*)d_ws;
    void* kargs[] = {&a};
    const hipError_t le = hipLaunchCooperativeKernel((const void*)hymba_fwd, dim3(grid), dim3(NWAVES * 64), kargs, LDS_BYTES, stream);
    if (le != hipSuccess) fprintf(stderr, "kernel_launch: cooperative launch failed: %s (grid %d)\n", hipGetErrorName(le), grid);
}
```
